# Optimizing an MI355X kernel written in HIP

```python
import math
import jax
import jax.numpy as jnp
from jax import lax
import numpy as np

D_MODEL = 1024
BATCH = 2
SEQ = 8192
DEPTH = 1
DEC_BATCH = 32
DEC_SEQ = 8
PAST_LEN = 8192
PAGE_SIZE = 128

ATT_GROUPS = ((128, 1), (512, 4), (2048, 16))
N_GROUPS = 3
ATT_HEADS = 4
ATT_DH = 128
ATT_W = ATT_HEADS * ATT_DH
Q_ATT = N_GROUPS * ATT_W
BAND_BLK = 128
REL_BUCKETS = 32
REL_MAX_DIST = 2048
HG_HEADS = 4
HG_DK = 128
HG_DV = 128
HG_W = HG_HEADS * HG_DK
HG_VW = HG_HEADS * HG_DV
HG_CHUNK = 64
MEM_TOKENS = 256
MEM_HEADS = 4
MEM_DH = 128
MEM_W = MEM_HEADS * MEM_DH
D_FF = 4 * D_MODEL
CONV_W = 3
NORM_EPS = 1e-6
NEG_INF = -1e30
IN_SPLITS = (Q_ATT, Q_ATT, Q_ATT, HG_W, HG_W, HG_VW, HG_VW, MEM_W, D_MODEL, D_MODEL, D_MODEL)
IN_COLS = 3 * Q_ATT + 2 * HG_W + 2 * HG_VW + MEM_W + 3 * D_MODEL

kernel_name = "hybrid_dilated_hgrn2_memory_decoder_step"


def rms_norm(x, gain):
    xf = x.astype(jnp.float32)
    y = xf * lax.rsqrt(jnp.mean(xf * xf, axis=-1, keepdims=True) + NORM_EPS)
    return (y * gain.astype(jnp.float32)).astype(x.dtype)


def rel_bucket(dist):
    max_exact = REL_BUCKETS // 2
    d = jnp.maximum(dist, 1).astype(jnp.float32)
    large = max_exact + (jnp.log(d / max_exact) / math.log(REL_MAX_DIST / max_exact)
                         * (REL_BUCKETS - max_exact)).astype(jnp.int32)
    large = jnp.minimum(large, REL_BUCKETS - 1)
    return jnp.where(dist < max_exact, dist, large)


def group_lag_bias(rel_bias, g):
    window, dil = ATT_GROUPS[g]
    dist = jnp.arange(window // dil + 1, dtype=jnp.int32) * dil
    table = rel_bias[rel_bucket(dist)].astype(jnp.float32)
    return table[:, g * ATT_HEADS:(g + 1) * ATT_HEADS].T


def masked_softmax_parts(logits, valid):
    logits = jnp.where(valid, logits, NEG_INF)
    m = jnp.max(logits, axis=-1, keepdims=True)
    p = jnp.exp(logits - m)
    s = jnp.sum(p, axis=-1, keepdims=True)
    return p / s, s, m


def dilated_group_prompt(q, k, v, bias_lag, window, dil):
    B, S, H, Dh = q.shape
    n_lags = window // dil
    span = dil * BAND_BLK
    s_pad = -(-S // span) * span
    L = s_pad // dil
    nb = L // BAND_BLK

    def to_blocks(t):
        t = jnp.pad(t.astype(jnp.float32), ((0, 0), (0, s_pad - S), (0, 0), (0, 0)))
        t = t.reshape(B, L, dil, H, Dh).transpose(0, 2, 3, 1, 4)
        return t.reshape(B, dil, H, nb, BAND_BLK, Dh)

    def with_prev(t):
        prev = jnp.pad(t, ((0, 0), (0, 0), (0, 0), (1, 0), (0, 0), (0, 0)))[:, :, :, :-1]
        return jnp.concatenate([prev, t], axis=4)

    qb = to_blocks(q)
    kb = with_prev(to_blocks(k))
    vb = with_prev(to_blocks(v))
    qi = jnp.arange(BAND_BLK)[:, None]
    kj = jnp.arange(2 * BAND_BLK)[None, :]
    lag = BAND_BLK + qi - kj
    in_band = (lag >= 0) & (lag <= n_lags)
    blk = jnp.arange(nb)[:, None, None]
    valid = in_band[None] & ((blk > 0) | (kj >= BAND_BLK)[None])
    bias = bias_lag[:, jnp.clip(lag, 0, n_lags)]
    logits = (jnp.einsum('brhnqd,brhnkd->brhnqk', qb, kb) / math.sqrt(Dh)
              + bias[None, None, :, None])
    p, s, m = masked_softmax_parts(logits, valid[None, None, None])
    o = jnp.einsum('brhnqk,brhnkd->brhnqd', p, vb)
    lse = (m + jnp.log(s))[..., 0]
    o = o.reshape(B, dil, H, L, Dh).transpose(0, 3, 1, 2, 4).reshape(B, s_pad, H, Dh)[:, :S]
    lse = lse.reshape(B, dil, H, L).transpose(0, 3, 1, 2).reshape(B, s_pad, H)[:, :S]
    return o, lse


def dilated_group_sample(q, k_ctx, v_ctx, bias_lag, window, dil, n_past):
    T, Dh = q.shape[1], q.shape[3]
    n_lags = window // dil
    idx = n_past + jnp.arange(T)[:, None] - dil * jnp.arange(n_lags + 1)[None, :]
    valid = idx >= 0
    idx = jnp.maximum(idx, 0)
    kg = k_ctx.astype(jnp.float32)[:, idx]
    vg = v_ctx.astype(jnp.float32)[:, idx]
    logits = (jnp.einsum('bthd,btjhd->bhtj', q.astype(jnp.float32), kg) / math.sqrt(Dh)
              + bias_lag[:, None, :])
    p, s, m = masked_softmax_parts(logits, valid[None, None])
    o = jnp.einsum('bhtj,btjhd->bthd', p, vg)
    lse = (m + jnp.log(s))[..., 0].transpose(0, 2, 1)
    return o, lse


def dilated_attention(q, k, v, bias_lags, win_bufs):
    outs, lses, new_bufs = [], [], []
    for g, (window, dil) in enumerate(ATT_GROUPS):
        qg, kg, vg = q[:, :, g], k[:, :, g], v[:, :, g]
        if win_bufs is None:
            o, lse = dilated_group_prompt(qg, kg, vg, bias_lags[g], window, dil)
            kv = jnp.stack([kg, vg], axis=2)[:, -min(window, qg.shape[1]):]
        else:
            buf = win_bufs[g]
            n_past = buf.shape[1]
            k_ctx = jnp.concatenate([buf[:, :, 0].astype(kg.dtype), kg], axis=1)
            v_ctx = jnp.concatenate([buf[:, :, 1].astype(vg.dtype), vg], axis=1)
            o, lse = dilated_group_sample(qg, k_ctx, v_ctx, bias_lags[g], window, dil, n_past)
            kv = jnp.stack([k_ctx, v_ctx], axis=2)[:, -n_past:]
        outs.append(o)
        lses.append(lse)
        new_bufs.append(kv)
    w = jax.nn.softmax(jnp.stack(lses), axis=0)
    o = jnp.einsum('gbth,gbthd->bthd', w, jnp.stack(outs))
    return o, new_bufs


def hgrn2_recurrence(q, f_logit, i, lb, state0):
    f32 = jnp.float32
    B, T, H, Dk = q.shape
    Dv = i.shape[-1]
    f = lb + (1.0 - lb) * jax.nn.sigmoid(f_logit.astype(f32))
    g = jnp.log(f)
    k = 1.0 - f
    C = min(HG_CHUNK, T)
    t_pad = -(-T // C) * C
    n = t_pad // C

    def chunks(t):
        t = jnp.pad(t.astype(f32), ((0, 0), (0, t_pad - T), (0, 0), (0, 0)))
        return t.reshape(B, n, C, H, t.shape[-1]).transpose(1, 0, 3, 2, 4)

    causal = (jnp.arange(C)[:, None] >= jnp.arange(C)[None, :])[:, :, None]

    def step(S, inp):
        qc, gc, kc, vc = inp
        G = jnp.cumsum(gc, axis=2)
        o_inter = jnp.einsum('bhtk,bhkv->bhtv', qc * jnp.exp(G), S)
        diff = G[:, :, :, None, :] - G[:, :, None, :, :]
        decay = jnp.where(causal, jnp.exp(jnp.minimum(diff, 0.0)), 0.0)
        scores = jnp.einsum('bhtk,bhsk,bhtsk->bhts', qc, kc, decay)
        o_intra = jnp.einsum('bhts,bhsv->bhtv', scores, vc)
        G_end = G[:, :, -1:, :]
        S_new = (jnp.exp(G_end[:, :, 0, :, None]) * S
                 + jnp.einsum('bhsk,bhsv->bhkv', kc * jnp.exp(G_end - G), vc))
        return S_new, o_inter + o_intra

    S_fin, o = lax.scan(step, state0.astype(f32), (chunks(q), chunks(g), chunks(k), chunks(i)))
    o = o.transpose(1, 0, 3, 2, 4).reshape(B, t_pad, H, Dv)[:, :T]
    return o, S_fin


def memory_attention(q, mem_k, mem_v):
    logits = jnp.einsum('bthd,bmhd->bhtm', q.astype(jnp.float32), mem_k.astype(jnp.float32)) / math.sqrt(MEM_DH)
    p = jax.nn.softmax(logits, axis=-1)
    return jnp.einsum('bhtm,bmhd->bthd', p, mem_v.astype(jnp.float32))


def memory_kv(mem, gain, w_kv):
    B, M, _ = mem.shape
    return (rms_norm(mem, gain) @ w_kv).reshape(B, M, 2, MEM_HEADS, MEM_DH)


def token_mixer(h, win_bufs, hg_state0, mem_k, mem_v, bias_lags, lb,
                w_in, b_in, hg_norm, w_br_att, w_br_hg, w_br_mem, w_out):
    B, T, _ = h.shape
    dt = h.dtype
    offsets = np.cumsum(IN_SPLITS)[:-1].tolist()
    proj = h @ w_in + b_in
    q_a, k_a, v_a, hq, hf, hi, hgate, mq, ga, gh, gm = jnp.split(proj, offsets, axis=-1)
    att_shape = (B, T, N_GROUPS, ATT_HEADS, ATT_DH)
    att_o, new_win = dilated_attention(q_a.reshape(att_shape), k_a.reshape(att_shape),
                                       v_a.reshape(att_shape), bias_lags, win_bufs)
    hg_o, hg_state = hgrn2_recurrence(hq.reshape(B, T, HG_HEADS, HG_DK), hf.reshape(B, T, HG_HEADS, HG_DK),
                                      hi.reshape(B, T, HG_HEADS, HG_DV), lb.reshape(HG_HEADS, HG_DK), hg_state0)
    hg_o = rms_norm(hg_o, hg_norm) * jax.nn.sigmoid(hgate.reshape(B, T, HG_HEADS, HG_DV).astype(jnp.float32))
    mem_o = memory_attention(mq.reshape(B, T, MEM_HEADS, MEM_DH), mem_k, mem_v)
    merged = (jax.nn.sigmoid(ga) * (att_o.reshape(B, T, ATT_W).astype(dt) @ w_br_att)
              + jax.nn.sigmoid(gh) * (hg_o.reshape(B, T, HG_VW).astype(dt) @ w_br_hg)
              + jax.nn.sigmoid(gm) * (mem_o.reshape(B, T, MEM_W).astype(dt) @ w_br_mem))
    return merged @ w_out, new_win, hg_state


def conv_ffn(h, conv_buf, w_a, w_b, conv_w, conv_b, w_d):
    T = h.shape[1]
    a = h @ w_a
    ctx = jnp.concatenate([conv_buf.astype(a.dtype), a], axis=1)
    c = conv_b
    for j in range(CONV_W):
        c = c + ctx[:, j:j + T] * conv_w[j]
    y = (jax.nn.silu(c) * (h @ w_b)) @ w_d
    return y, ctx[:, -(CONV_W - 1):]


def decoder_layer(x, win_bufs, hg_state0, conv_buf0, mem_k, mem_v, bias_lags, lb,
                  norm_mix_pre, norm_mix_post, w_in, b_in, hg_norm, w_br_att, w_br_hg, w_br_mem, w_out,
                  norm_ffn_pre, norm_ffn_post, w_ffn_a, w_ffn_b, ffn_conv_w, ffn_conv_b, w_ffn_d):
    mix, new_win, hg_state = token_mixer(rms_norm(x, norm_mix_pre), win_bufs, hg_state0, mem_k, mem_v,
                                         bias_lags, lb, w_in, b_in, hg_norm, w_br_att, w_br_hg, w_br_mem, w_out)
    x = x + rms_norm(mix, norm_mix_post)
    f, conv_buf = conv_ffn(rms_norm(x, norm_ffn_pre), conv_buf0, w_ffn_a, w_ffn_b, ffn_conv_w, ffn_conv_b, w_ffn_d)
    x = x + rms_norm(f, norm_ffn_post)
    return x, new_win, hg_state, conv_buf


def setup_inputs(seed: int = 0) -> dict:
    key = jax.random.key(seed)
    keys = iter(jax.random.split(key, 40))

    def nrm(shape, scale=1.0):
        return jax.random.normal(next(keys), shape, jnp.float32) * scale

    def gain(shape):
        return 1.0 + nrm(shape, 0.05)

    win_lens = [min(w, PAST_LEN) for w, _ in ATT_GROUPS]
    return {
        'x_prompt': nrm((BATCH, SEQ, D_MODEL)),
        'x_sample': nrm((DEC_BATCH, DEC_SEQ, D_MODEL)),
        'mem_prompt': nrm((BATCH, MEM_TOKENS, D_MODEL)),
        'cache_win1_kv': nrm((DEPTH, DEC_BATCH, win_lens[0], 2, ATT_HEADS, ATT_DH)),
        'cache_win2_kv': nrm((DEPTH, DEC_BATCH, win_lens[1], 2, ATT_HEADS, ATT_DH)),
        'cache_win3_kv': nrm((DEPTH, DEC_BATCH, win_lens[2], 2, ATT_HEADS, ATT_DH)),
        'cache_mem_kv': nrm((DEPTH, DEC_BATCH, MEM_TOKENS, 2, MEM_HEADS, MEM_DH)),
        'state_hgrn': nrm((DEPTH, DEC_BATCH, HG_HEADS, HG_DK, HG_DV), 0.5),
        'state_ffn_conv': nrm((DEPTH, DEC_BATCH, CONV_W - 1, D_FF)),
        'rel_bias': nrm((REL_BUCKETS, N_GROUPS * ATT_HEADS), 0.5),
        'hg_lb_logits': nrm((DEPTH + 1, HG_W), 0.5),
        'norm_mix_pre': gain((DEPTH, D_MODEL)),
        'norm_mix_post': gain((DEPTH, D_MODEL)),
        'w_in': nrm((DEPTH, D_MODEL, IN_COLS), D_MODEL ** -0.5),
        'b_in': nrm((DEPTH, IN_COLS), 0.02),
        'hg_norm': gain((DEPTH, HG_DV)),
        'mem_norm': gain((DEPTH, D_MODEL)),
        'w_mem_kv': nrm((DEPTH, D_MODEL, 2 * MEM_W), D_MODEL ** -0.5),
        'w_br_att': nrm((DEPTH, ATT_W, D_MODEL), ATT_W ** -0.5),
        'w_br_hg': nrm((DEPTH, HG_VW, D_MODEL), HG_VW ** -0.5),
        'w_br_mem': nrm((DEPTH, MEM_W, D_MODEL), MEM_W ** -0.5),
        'w_out': nrm((DEPTH, D_MODEL, D_MODEL), D_MODEL ** -0.5),
        'norm_ffn_pre': gain((DEPTH, D_MODEL)),
        'norm_ffn_post': gain((DEPTH, D_MODEL)),
        'w_ffn_a': nrm((DEPTH, D_MODEL, D_FF), D_MODEL ** -0.5),
        'w_ffn_b': nrm((DEPTH, D_MODEL, D_FF), D_MODEL ** -0.5),
        'ffn_conv_w': nrm((DEPTH, CONV_W, D_FF), CONV_W ** -0.5),
        'ffn_conv_b': nrm((DEPTH, D_FF), 0.02),
        'w_ffn_d': nrm((DEPTH, D_FF, D_MODEL), D_FF ** -0.5),
    }


def reference(x_prompt, x_sample, mem_prompt, cache_win1_kv, cache_win2_kv, cache_win3_kv, cache_mem_kv,
              state_hgrn, state_ffn_conv, rel_bias, hg_lb_logits, norm_mix_pre, norm_mix_post, w_in, b_in,
              hg_norm, mem_norm, w_mem_kv, w_br_att, w_br_hg, w_br_mem, w_out, norm_ffn_pre, norm_ffn_post,
              w_ffn_a, w_ffn_b, ffn_conv_w, ffn_conv_b, w_ffn_d):
    f32 = jnp.float32
    bias_lags = [group_lag_bias(rel_bias, g) for g in range(N_GROUPS)]
    lower_bounds = jnp.cumsum(jax.nn.softmax(hg_lb_logits.astype(f32), axis=0), axis=0)
    B = x_prompt.shape[0]
    xp, xs = x_prompt, x_sample
    p_win = [[] for _ in range(N_GROUPS)]
    s_win = [[] for _ in range(N_GROUPS)]
    p_hg, p_conv, p_mem, s_hg, s_conv = [], [], [], [], []
    for layer in range(DEPTH):
        lw = (norm_mix_pre[layer], norm_mix_post[layer], w_in[layer], b_in[layer], hg_norm[layer],
              w_br_att[layer], w_br_hg[layer], w_br_mem[layer], w_out[layer], norm_ffn_pre[layer],
              norm_ffn_post[layer], w_ffn_a[layer], w_ffn_b[layer], ffn_conv_w[layer], ffn_conv_b[layer],
              w_ffn_d[layer])
        lb = lower_bounds[layer]
        mem_kv = memory_kv(mem_prompt, mem_norm[layer], w_mem_kv[layer])
        xp, win_p, hg_p, conv_p = decoder_layer(
            xp, None, jnp.zeros((B, HG_HEADS, HG_DK, HG_DV), f32),
            jnp.zeros((B, CONV_W - 1, D_FF), xp.dtype), mem_kv[:, :, 0], mem_kv[:, :, 1], bias_lags, lb, *lw)
        win_bufs = (cache_win1_kv[layer], cache_win2_kv[layer], cache_win3_kv[layer])
        xs, win_s, hg_s, conv_s = decoder_layer(
            xs, win_bufs, state_hgrn[layer], state_ffn_conv[layer],
            cache_mem_kv[layer][:, :, 0], cache_mem_kv[layer][:, :, 1], bias_lags, lb, *lw)
        for g in range(N_GROUPS):
            p_win[g].append(win_p[g])
            s_win[g].append(win_s[g])
        p_hg.append(hg_p.astype(x_prompt.dtype))
        p_conv.append(conv_p)
        p_mem.append(mem_kv)
        s_hg.append(hg_s.astype(x_sample.dtype))
        s_conv.append(conv_s)
    return (xp, xs,
            jnp.stack(p_win[0]), jnp.stack(p_win[1]), jnp.stack(p_win[2]),
            jnp.stack(p_hg), jnp.stack(p_conv), jnp.stack(p_mem),
            jnp.stack(s_win[0]), jnp.stack(s_win[1]), jnp.stack(s_win[2]),
            jnp.stack(s_hg), jnp.stack(s_conv))
```

```cpp
#include <hip/hip_runtime.h>
#include <cstdio>
#include <cstdint>

#ifndef MIX1_SEL
#define MIX1_SEL 63
#endif
#ifndef MK_ONE_LAUNCH
#define MK_ONE_LAUNCH 0
#endif

namespace {
typedef unsigned short bf16_t;
typedef short bf16x8 __attribute__((ext_vector_type(8)));
typedef float f32x4 __attribute__((ext_vector_type(4)));
typedef float f32x2 __attribute__((ext_vector_type(2)));
typedef unsigned u32x4 __attribute__((ext_vector_type(4)));
typedef unsigned u32x2 __attribute__((ext_vector_type(2)));

constexpr int NTHR = 512, NWAVES = 8;
constexpr int D = 1024, SEQ = 8192, NB = 2, MP = NB * SEQ, SBATCH = 32, STOK = 8, MS = SBATCH * STOK, MT = MP + MS;
constexpr int NIN = 10240, DFF = 4096;
constexpr int C_Q = 0, C_K = 1536, C_V = 3072, C_HQ = 4608, C_HF = 5120, C_HI = 5632, C_HG = 6144, C_MQ = 6656, C_GA = 7168, C_GH = 8192, C_GM = 9216;
constexpr float EPS = 1e-6f;

constexpr size_t O_YP = 0, O_YS = 16777216, O_PW1 = 17039360, O_PW2 = 17301504, O_PW3 = 18350080, O_PHG = 22544384, O_PCONV = 22675456, O_PMEM = 22691840,
                 O_SW1 = 23216128, O_SW2 = 27410432, O_SW3 = 44187648, O_SHG = 111296512, O_SCONV = 113393664, O_END = 113655808;

constexpr size_t MiB = 1u << 20;
constexpr size_t WS_CTL = 0, CTL_BYTES = 1 * MiB;
constexpr size_t WS_TAB = 1 * MiB;
constexpr size_t WS_WIN_T = 2 * MiB;
constexpr size_t WS_WMEM_T = 22 * MiB;
constexpr size_t WS_WBR_T = 24 * MiB;
constexpr size_t WS_WOUT_T = 27 * MiB;
constexpr size_t WS_WAB_T = 29 * MiB;
constexpr size_t WS_WD_T = 45 * MiB;
constexpr size_t WS_XN = 54 * MiB;
constexpr size_t WS_MEMN = 87 * MiB;
constexpr size_t WS_MEMKV = 88 * MiB;
constexpr size_t WS_PROJ = 90 * MiB;
constexpr size_t WS_ATTO = 416 * MiB;
constexpr size_t WS_LSE = 465 * MiB;
constexpr size_t WS_ABR = 466 * MiB;
constexpr size_t WS_HQT = 515 * MiB;
constexpr size_t WS_OINTRA = 531 * MiB;
constexpr size_t WS_U = 563 * MiB;
constexpr size_t WS_DC = 627 * MiB;
constexpr size_t WS_S0 = 628 * MiB;
constexpr size_t WS_MERGED = 692 * MiB;
constexpr size_t WS_MIX = 725 * MiB;
constexpr size_t WS_H = 790 * MiB;
constexpr size_t WS_AB = WS_PROJ;
constexpr size_t WS_END = 920 * MiB;

constexpr int LDS_BYTES = 155648;

struct Params { const float* in[29]; float* out; unsigned char* ws; int ph_lo, ph_hi; };

__device__ __forceinline__ unsigned f2bf(float f) { unsigned u = __float_as_uint(f); return (u + 0x7fffu + ((u >> 16) & 1u)) >> 16; }
__device__ __forceinline__ float bf2f(unsigned h) { return __uint_as_float(h << 16); }
__device__ __forceinline__ unsigned pk2(float lo, float hi) { return f2bf(lo) | (f2bf(hi) << 16); }
__device__ __forceinline__ float wave_sum(float v) {
#pragma unroll
    for (int o = 1; o < 64; o <<= 1) v += __shfl_xor(v, o);
    return v;
}
__device__ __forceinline__ float sigmoidf_(float x) { return 1.0f / (1.0f + __expf(-x)); }
#define LDS_WAIT() asm volatile("s_waitcnt lgkmcnt(0)" ::: "memory")

#define XB_TMO      128
#define XB_XCNT(j)  (256  + 64 * (j))
#define XB_XSUB(j)  (1280 + 64 * (j))
#define XB_XGEN(j)  (2304 + 64 * (j))
#define XB_TOP      3328
#define XB_TOPGEN   3392
#define XB_SPIN_CAP (1u << 22)
__device__ __forceinline__ unsigned xb_ld(unsigned* p)              { return __hip_atomic_load(p, __ATOMIC_RELAXED, __HIP_MEMORY_SCOPE_AGENT); }
__device__ __forceinline__ unsigned xb_add(unsigned* p, unsigned v) { return __hip_atomic_fetch_add(p, v, __ATOMIC_RELAXED, __HIP_MEMORY_SCOPE_AGENT); }
__device__ __forceinline__ unsigned xb_xcc_id() { return (unsigned)__builtin_amdgcn_s_getreg((3 << 11) | 20) & 0xFu; }
#define XB_SPIN(cond, bar) do { unsigned _sp = 0; while (cond) { __builtin_amdgcn_s_sleep(1); \
    if ((++_sp & 255u) == 0u) { if (xb_ld(&(bar)[XB_TMO])) break; if (_sp > XB_SPIN_CAP) { atomicAdd(&(bar)[XB_TMO], 1u); break; } } } } while (0)
struct XcdBarrier { unsigned* bar; unsigned x; volatile unsigned* st; };
__device__ __forceinline__ XcdBarrier xcd_barrier_post(unsigned* bar, volatile unsigned* st) {
    XcdBarrier b; b.bar = bar; b.x = xb_xcc_id(); b.st = st;
    if (threadIdx.x == 0) (void)xb_add(&bar[XB_XCNT(b.x)], 1u);
    return b;
}
__device__ __forceinline__ void xcd_barrier_complete(unsigned* bar, unsigned x, unsigned& nloc, unsigned& nx) {
    const unsigned G = gridDim.x;
    unsigned sum, cnt, mine, sp = 0u;
    for (;;) {
        sum = 0u; cnt = 0u; mine = 0u;
#pragma unroll
        for (unsigned j = 0; j < 16; ++j) { const unsigned c = xb_ld(&bar[XB_XCNT(j)]); sum += c; cnt += (c > 0u) ? 1u : 0u; mine = (j == x) ? c : mine; }
        if (sum == G) break;
        __builtin_amdgcn_s_sleep(1);
        if ((++sp & 255u) == 0u) { if (xb_ld(&bar[XB_TMO])) break; if (sp > XB_SPIN_CAP) { atomicAdd(&bar[XB_TMO], 1u); break; } }
    }
    nloc = mine > 0u ? mine : 1u; nx = cnt > 0u ? cnt : 1u;
}
__device__ __forceinline__ void xcd_barrier(const XcdBarrier& b) {
    asm volatile("s_waitcnt vmcnt(0)" ::: "memory");
    __syncthreads();
    if (threadIdx.x == 0) {
        unsigned* bar = b.bar;
        __builtin_amdgcn_s_waitcnt(0);
        unsigned nloc = b.st[0], nx = b.st[1];
        if (nloc == 0u) { xcd_barrier_complete(bar, b.x, nloc, nx); b.st[0] = nloc; b.st[1] = nx; }
        const unsigned old = xb_add(&bar[XB_XSUB(b.x)], 1u);
        const unsigned gen = old / nloc;
        if (old + 1u == (gen + 1u) * nloc) {
            __builtin_amdgcn_fence(__ATOMIC_RELEASE, "agent");
            asm volatile("s_waitcnt vmcnt(0)" ::: "memory");
            const unsigned og = xb_add(&bar[XB_TOP], 1u);
            const unsigned tg = og / nx;
            if (og + 1u == (tg + 1u) * nx) xb_add(&bar[XB_TOPGEN], 1u);
            else XB_SPIN(xb_ld(&bar[XB_TOPGEN]) == tg, bar);
            __builtin_amdgcn_fence(__ATOMIC_ACQUIRE, "agent");
            xb_add(&bar[XB_XGEN(b.x)], 1u);
            asm volatile("s_waitcnt vmcnt(0)" ::: "memory");
        } else {
            XB_SPIN(xb_ld(&bar[XB_XGEN(b.x)]) == gen, bar);
            __builtin_amdgcn_fence(__ATOMIC_ACQUIRE, "agent");
            asm volatile("s_waitcnt vmcnt(0)" ::: "memory");
        }
    }
    __syncthreads();
}

__device__ __forceinline__ int dest_row(int n, int kind, int row_off) { return kind == 0 ? row_off + n : ((n >> 7) * 256 + (n & 127) + (kind == 2 ? 128 : 0)); }
__device__ __forceinline__ void transpose_item(const float* __restrict__ W, int K, int N, bf16_t* __restrict__ WT, int kind, int row_off, float* scr, int item, int lane) {
    const int nblk = N / 32, kb = item / nblk, nb = item % nblk, k0 = 64 * kb, n0 = 32 * nb;
#pragma unroll 8
    for (int i = 0; i < 32; ++i) { const int kk = 2 * i + (lane >> 5); scr[kk * 33 + (lane & 31)] = W[(size_t)(k0 + kk) * N + n0 + (lane & 31)]; }
    LDS_WAIT();
    const int c = lane & 7;
#pragma unroll
    for (int j = 0; j < 4; ++j) { const int n = (lane >> 3) + 8 * j; const float* s = scr + (8 * c) * 33 + n;
        u32x4 o; o.x = pk2(s[0 * 33], s[1 * 33]); o.y = pk2(s[2 * 33], s[3 * 33]); o.z = pk2(s[4 * 33], s[5 * 33]); o.w = pk2(s[6 * 33], s[7 * 33]);
        *(u32x4*)(WT + (size_t)dest_row(n0 + n, kind, row_off) * K + k0 + 8 * c) = o; }
    LDS_WAIT();
}
__device__ __forceinline__ void rms_row_bf16(const float* __restrict__ xr, const float* __restrict__ gain, bf16_t* __restrict__ orow, int lane) {
    f32x4 v[4]; float s = 0.f;
#pragma unroll
    for (int j = 0; j < 4; ++j) { v[j] = ((const f32x4*)xr)[lane + 64 * j]; s += (v[j].x * v[j].x + v[j].y * v[j].y) + (v[j].z * v[j].z + v[j].w * v[j].w); }
    const float r = rsqrtf(wave_sum(s) * (1.0f / 1024.0f) + EPS);
#pragma unroll
    for (int j = 0; j < 4; ++j) { const f32x4 g = ((const f32x4*)gain)[lane + 64 * j];
        u32x2 o; o.x = pk2(v[j].x * r * g.x, v[j].y * r * g.y); o.y = pk2(v[j].z * r * g.z, v[j].w * r * g.w);
        ((u32x2*)orow)[lane + 64 * j] = o; }
}
__device__ __forceinline__ void phase_prep(const Params& P, unsigned char* lds) {
    const int tid = threadIdx.x, lane = tid & 63, wave = tid >> 6;
    const int gw = blockIdx.x * NWAVES + wave, NGW = gridDim.x * NWAVES;
    unsigned char* ws = P.ws;
    float* scr = (float*)lds + wave * (64 * 33);
    {
        constexpr int I_IN = 16 * 320, I_MEM = 16 * 32, I_BR = 8 * 32, I_OUT = 16 * 32, I_A = 16 * 128, I_D = 64 * 32;
        constexpr int NIT = I_IN + I_MEM + 3 * I_BR + I_OUT + 2 * I_A + I_D;
        for (int it = gw; it < NIT; it += NGW) {
            int r = it;
            if (r < I_IN) { transpose_item(P.in[13], 1024, NIN, (bf16_t*)(ws + WS_WIN_T), 0, 0, scr, r, lane); continue; } r -= I_IN;
            if (r < I_MEM) { transpose_item(P.in[17], 1024, 1024, (bf16_t*)(ws + WS_WMEM_T), 0, 0, scr, r, lane); continue; } r -= I_MEM;
            if (r < I_BR) { transpose_item(P.in[18], 512, 1024, (bf16_t*)(ws + WS_WBR_T), 0, 0, scr, r, lane); continue; } r -= I_BR;
            if (r < I_BR) { transpose_item(P.in[19], 512, 1024, (bf16_t*)(ws + WS_WBR_T), 0, 1024, scr, r, lane); continue; } r -= I_BR;
            if (r < I_BR) { transpose_item(P.in[20], 512, 1024, (bf16_t*)(ws + WS_WBR_T), 0, 2048, scr, r, lane); continue; } r -= I_BR;
            if (r < I_OUT) { transpose_item(P.in[21], 1024, 1024, (bf16_t*)(ws + WS_WOUT_T), 0, 0, scr, r, lane); continue; } r -= I_OUT;
            if (r < I_A) { transpose_item(P.in[24], 1024, DFF, (bf16_t*)(ws + WS_WAB_T), 1, 0, scr, r, lane); continue; } r -= I_A;
            if (r < I_A) { transpose_item(P.in[25], 1024, DFF, (bf16_t*)(ws + WS_WAB_T), 2, 0, scr, r, lane); continue; } r -= I_A;
            transpose_item(P.in[28], DFF, 1024, (bf16_t*)(ws + WS_WD_T), 0, 0, scr, r, lane);
        }
    }
    {
        bf16_t* XN = (bf16_t*)(ws + WS_XN); bf16_t* MEMN = (bf16_t*)(ws + WS_MEMN);
        for (int m = gw; m < MT + 512; m += NGW) {
            if (m < MP) rms_row_bf16(P.in[0] + (size_t)m * D, P.in[11], XN + (size_t)m * D, lane);
            else if (m < MT) rms_row_bf16(P.in[1] + (size_t)(m - MP) * D, P.in[11], XN + (size_t)m * D, lane);
            else rms_row_bf16(P.in[2] + (size_t)(m - MT) * D, P.in[16], MEMN + (size_t)(m - MT) * D, lane);
        }
    }
    {
        constexpr int R1 = 32 * 120, R2 = 32 * 504, R3 = 32 * 2040;
        for (int r = gw; r < R1 + R2 + R3; r += NGW) {
            int q = r, W; const float* src; float* dst;
            if (q < R1) { W = 128; src = P.in[3]; dst = P.out + O_SW1; }
            else if (q < R1 + R2) { q -= R1; W = 512; src = P.in[4]; dst = P.out + O_SW2; }
            else { q -= R1 + R2; W = 2048; src = P.in[5]; dst = P.out + O_SW3; }
            const int b = q / (W - 8), i = q % (W - 8);
            const f32x4* s4 = (const f32x4*)(src + ((size_t)b * W + i + 8) * 1024); f32x4* d4 = (f32x4*)(dst + ((size_t)b * W + i) * 1024);
            f32x4 t0 = s4[lane], t1 = s4[lane + 64], t2 = s4[lane + 128], t3 = s4[lane + 192];
            d4[lane] = t0; d4[lane + 64] = t1; d4[lane + 128] = t2; d4[lane + 192] = t3;
        }
    }
    if (blockIdx.x == 0) {
        float* BT = (float*)(ws + WS_TAB); float* LB = BT + 3 * 4 * 132;
        const float* rel_bias = P.in[9];
        for (int e = tid; e < 3 * 4 * 129; e += NTHR) {
            const int g = e / (4 * 129), h = (e / 129) % 4, j = e % 129;
            const int dil = g == 0 ? 1 : (g == 1 ? 4 : 16);
            const int dist = j * dil; int bucket;
            if (dist < 16) bucket = dist;
            else { const float d = (float)dist; int large = 16 + (int)(logf(d / 16.0f) / logf(128.0f) * 16.0f); bucket = large < 31 ? large : 31; }
            BT[(g * 4 + h) * 132 + j] = rel_bias[bucket * 12 + g * 4 + h];
        }
        for (int e = tid; e < 512; e += NTHR) { const float l0 = P.in[10][e], l1 = P.in[10][512 + e]; LB[e] = 1.0f / (1.0f + expf(l1 - l0)); }
    }
}

template <class Epi>
__device__ __forceinline__ void sgemm_unit(const bf16_t* __restrict__ A, int lda, const bf16_t* __restrict__ Bt, int ldb, int K, int row0, int col0, float* red, const Epi& epi) {
    const int tid = threadIdx.x, lane = tid & 63, wave = tid >> 6, kq = wave >> 1, ch = wave & 1, fr = lane & 15, fq = lane >> 4;
    f32x4 acc[4][2];
#pragma unroll
    for (int i = 0; i < 4; ++i)
#pragma unroll
        for (int j = 0; j < 2; ++j) acc[i][j] = (f32x4){0.f, 0.f, 0.f, 0.f};
    const int kbeg = kq * (K >> 2), kend = kbeg + (K >> 2);
    const bf16_t* ap = A + (size_t)(row0 + fr) * lda + fq * 8;
    const bf16_t* bp = Bt + (size_t)(col0 + ch * 32 + fr) * ldb + fq * 8;
#pragma unroll 2
    for (int k = kbeg; k < kend; k += 32) {
        bf16x8 a[4], b[2];
#pragma unroll
        for (int i = 0; i < 4; ++i) a[i] = *(const bf16x8*)(ap + (size_t)i * 16 * lda + k);
#pragma unroll
        for (int j = 0; j < 2; ++j) b[j] = *(const bf16x8*)(bp + (size_t)j * 16 * ldb + k);
#pragma unroll
        for (int i = 0; i < 4; ++i)
#pragma unroll
            for (int j = 0; j < 2; ++j) acc[i][j] = __builtin_amdgcn_mfma_f32_16x16x32_bf16(a[i], b[j], acc[i][j], 0, 0, 0);
    }
    __syncthreads();
#pragma unroll
    for (int i = 0; i < 4; ++i)
#pragma unroll
        for (int j = 0; j < 2; ++j)
#pragma unroll
            for (int r = 0; r < 4; ++r) red[(kq * 64 + i * 16 + 4 * fq + r) * 65 + ch * 32 + j * 16 + fr] = acc[i][j][r];
    __syncthreads();
    const int row = tid >> 3, c8 = (tid & 7) * 8;
    float v[8];
#pragma unroll
    for (int e = 0; e < 8; ++e) v[e] = (red[(0 * 64 + row) * 65 + c8 + e] + red[(1 * 64 + row) * 65 + c8 + e]) + (red[(2 * 64 + row) * 65 + c8 + e] + red[(3 * 64 + row) * 65 + c8 + e]);
    epi(row0 + row, col0 + c8, v);
}
__device__ __forceinline__ void store_bf16x8(bf16_t* p, const float* v) { u32x4 o; o.x = pk2(v[0], v[1]); o.y = pk2(v[2], v[3]); o.z = pk2(v[4], v[5]); o.w = pk2(v[6], v[7]); *(u32x4*)p = o; }
__device__ __forceinline__ void store_f32x8(float* p, const float* v) { ((f32x4*)p)[0] = (f32x4){v[0], v[1], v[2], v[3]}; ((f32x4*)p)[1] = (f32x4){v[4], v[5], v[6], v[7]}; }
__device__ __forceinline__ void load_bf16x8(const bf16_t* p, float* v) { const u32x4 w = *(const u32x4*)p;
    v[0] = bf2f(w.x & 0xffffu); v[1] = bf2f(w.x >> 16); v[2] = bf2f(w.y & 0xffffu); v[3] = bf2f(w.y >> 16); v[4] = bf2f(w.z & 0xffffu); v[5] = bf2f(w.z >> 16); v[6] = bf2f(w.w & 0xffffu); v[7] = bf2f(w.w >> 16); }

__device__ __forceinline__ void phase_inproj(const Params& P, unsigned char* lds) {
    float* red = (float*)lds; unsigned char* ws = P.ws;
    const bf16_t* XN = (const bf16_t*)(ws + WS_XN); const bf16_t* WT = (const bf16_t*)(ws + WS_WIN_T); bf16_t* PROJ = (bf16_t*)(ws + WS_PROJ);
    const float* bias = P.in[14]; float* out = P.out;
    constexpr int NU_IN = (MT / 64) * (NIN / 64), NU_MEM = 8 * 16;
    for (int u = blockIdx.x; u < NU_IN + NU_MEM; u += gridDim.x) {
        if (u < NU_IN) {
            const int tr = u % (MT / 64), tc = u / (MT / 64);
            sgemm_unit(XN, D, WT, D, D, tr * 64, tc * 64, red, [&](int row, int col, float* v) {
#pragma unroll
                for (int e = 0; e < 8; ++e) v[e] += bias[col + e];
                store_bf16x8(PROJ + (size_t)row * NIN + col, v);
                if (col >= C_K && col < C_HQ) {
                    const int kv = col - C_K, which = kv / 1536, rem = kv % 1536, g = rem >> 9, hd = rem & 511;
                    const int W = g == 0 ? 128 : (g == 1 ? 512 : 2048);
                    if (row < MP) { const int b = row >> 13, t = row & 8191;
                        if (t >= SEQ - W) { float* pw = out + (g == 0 ? O_PW1 : (g == 1 ? O_PW2 : O_PW3)); store_f32x8(pw + (((size_t)b * W + (t - (SEQ - W))) * 2 + which) * 512 + hd, v); } }
                    else { const int sb = (row - MP) >> 3, st = (row - MP) & 7; float* sw = out + (g == 0 ? O_SW1 : (g == 1 ? O_SW2 : O_SW3));
                        store_f32x8(sw + (((size_t)sb * W + (W - 8 + st)) * 2 + which) * 512 + hd, v); }
                }
            });
        } else {
            const int q = u - NU_IN, tr = q % 8, tc = q / 8;
            bf16_t* MEMKV = (bf16_t*)(ws + WS_MEMKV);
            sgemm_unit((const bf16_t*)(ws + WS_MEMN), D, (const bf16_t*)(ws + WS_WMEM_T), D, D, tr * 64, tc * 64, red, [&](int row, int col, float* v) {
                store_f32x8(out + O_PMEM + (size_t)row * 1024 + col, v); store_bf16x8(MEMKV + (size_t)row * 1024 + col, v); });
        }
    }
}

struct AttnUnit {
    const bf16_t* q; long q_rs; const bf16_t* k; long k_rs; const bf16_t* v; long v_rs; int k_valid_from;
    bf16_t* o; long o_rs; float* lse; long lse_rs; const float* bias;
};
__device__ __forceinline__ void attn_unit(const AttnUnit& U, unsigned char* lds) {
    bf16_t* Ks = (bf16_t*)lds;
    bf16_t* Vt = (bf16_t*)(lds + 69632);
    float* btab = (float*)(lds + 69632 + 67584);
    const int tid = threadIdx.x, lane = tid & 63, wave = tid >> 6, fr = lane & 15, fq = lane >> 4;
    __syncthreads();
#pragma unroll
    for (int it = 0; it < 8; ++it) { const int idx = tid + NTHR * it, j = idx >> 4, c = idx & 15;
        u32x4 kv = (u32x4){0u, 0u, 0u, 0u}, vv = (u32x4){0u, 0u, 0u, 0u};
        if (j >= U.k_valid_from) { kv = *(const u32x4*)(U.k + (long)j * U.k_rs + c * 8); vv = *(const u32x4*)(U.v + (long)j * U.v_rs + c * 8); }
        *(u32x4*)(Ks + j * 136 + c * 8) = kv;
        bf16_t* vt = Vt + (c * 8) * 264 + j;
        vt[0 * 264] = (bf16_t)(vv.x & 0xffffu); vt[1 * 264] = (bf16_t)(vv.x >> 16); vt[2 * 264] = (bf16_t)(vv.y & 0xffffu); vt[3 * 264] = (bf16_t)(vv.y >> 16);
        vt[4 * 264] = (bf16_t)(vv.z & 0xffffu); vt[5 * 264] = (bf16_t)(vv.z >> 16); vt[6 * 264] = (bf16_t)(vv.w & 0xffffu); vt[7 * 264] = (bf16_t)(vv.w >> 16); }
    if (U.bias && tid < 129) btab[tid] = U.bias[tid];
    bf16x8 qa[4];
    { const bf16_t* qp = U.q + (long)(wave * 16 + fr) * U.q_rs + fq * 8;
#pragma unroll
      for (int kk = 0; kk < 4; ++kk) qa[kk] = *(const bf16x8*)(qp + kk * 32); }
    __syncthreads();
    f32x4 s[16];
#pragma unroll
    for (int kb = 0; kb < 16; ++kb) { s[kb] = (f32x4){0.f, 0.f, 0.f, 0.f};
#pragma unroll
        for (int kk = 0; kk < 4; ++kk) { const bf16x8 kf = *(const bf16x8*)(Ks + (kb * 16 + fr) * 136 + kk * 32 + fq * 8); s[kb] = __builtin_amdgcn_mfma_f32_16x16x32_bf16(qa[kk], kf, s[kb], 0, 0, 0); } }
    const float scale = 0.08838834764831845f;
    float mx[4] = {-3.0e38f, -3.0e38f, -3.0e38f, -3.0e38f};
    const bool banded = U.bias != nullptr; const int vfrom = U.k_valid_from;
#pragma unroll
    for (int kb = 0; kb < 16; ++kb)
#pragma unroll
        for (int r = 0; r < 4; ++r) { float x = s[kb][r] * scale;
            if (banded) { const int qi = wave * 16 + 4 * fq + r, kj = kb * 16 + fr, lag = 128 + qi - kj; const bool ok = lag >= 0 && lag <= 128 && kj >= vfrom; x = ok ? x + btab[ok ? lag : 0] : -1.0e30f; }
            s[kb][r] = x; mx[r] = fmaxf(mx[r], x); }
#pragma unroll
    for (int r = 0; r < 4; ++r) { mx[r] = fmaxf(mx[r], __shfl_xor(mx[r], 1)); mx[r] = fmaxf(mx[r], __shfl_xor(mx[r], 2)); mx[r] = fmaxf(mx[r], __shfl_xor(mx[r], 4)); mx[r] = fmaxf(mx[r], __shfl_xor(mx[r], 8)); }
    float sum[4] = {0.f, 0.f, 0.f, 0.f};
#pragma unroll
    for (int kb = 0; kb < 16; ++kb)
#pragma unroll
        for (int r = 0; r < 4; ++r) { const float p = __expf(s[kb][r] - mx[r]); s[kb][r] = p; sum[r] += p; }
#pragma unroll
    for (int r = 0; r < 4; ++r) { sum[r] += __shfl_xor(sum[r], 1); sum[r] += __shfl_xor(sum[r], 2); sum[r] += __shfl_xor(sum[r], 4); sum[r] += __shfl_xor(sum[r], 8); }
    __syncthreads();
    bf16_t* Ps = Ks + wave * (16 * 264);
#pragma unroll
    for (int kb = 0; kb < 16; ++kb)
#pragma unroll
        for (int r = 0; r < 4; ++r) Ps[(4 * fq + r) * 264 + kb * 16 + fr] = (bf16_t)f2bf(s[kb][r]);
    LDS_WAIT();
    f32x4 o[8];
#pragma unroll
    for (int db = 0; db < 8; ++db) o[db] = (f32x4){0.f, 0.f, 0.f, 0.f};
#pragma unroll
    for (int ks = 0; ks < 8; ++ks) { const bf16x8 pf = *(const bf16x8*)(Ps + fr * 264 + ks * 32 + fq * 8);
#pragma unroll
        for (int db = 0; db < 8; ++db) { const bf16x8 vf = *(const bf16x8*)(Vt + (db * 16 + fr) * 264 + ks * 32 + fq * 8); o[db] = __builtin_amdgcn_mfma_f32_16x16x32_bf16(pf, vf, o[db], 0, 0, 0); } }
#pragma unroll
    for (int r = 0; r < 4; ++r) { const float inv = 1.0f / sum[r]; const int qi = wave * 16 + 4 * fq + r; bf16_t* op = U.o + (long)qi * U.o_rs + fr;
#pragma unroll
        for (int db = 0; db < 8; ++db) op[db * 16] = (bf16_t)f2bf(o[db][r] * inv);
        if (U.lse && fr == 0) U.lse[(long)qi * U.lse_rs] = mx[r] + __logf(sum[r]); }
}

template <class KeyPtr, class ValPtr>
__device__ __forceinline__ void sample_attn_item(const bf16_t* qrow0  , int nk, const float* biastab  , KeyPtr kptr, ValPtr vptr,
                                                 bf16_t* orow0, long o_rs, float* lse0, long lse_rs, unsigned char* lds) {
    float* qs = (float*)lds;
    float* ps = qs + 1024;
    float* st = ps + 8 * 260;
    const int tid = threadIdx.x, lane = tid & 63, wave = tid >> 6;
    __syncthreads();
    for (int idx = tid; idx < 1024; idx += NTHR) { const int t = idx >> 7, d = idx & 127; qs[idx] = bf2f(qrow0[(long)t * NIN + d]) * 0.08838834764831845f; }
    __syncthreads();
    for (int idx = tid; idx < 8 * nk; idx += NTHR) { const int t = idx / nk, j = idx - t * nk; const f32x4* kp = (const f32x4*)kptr(t, j); const f32x4* qp = (const f32x4*)(qs + t * 128);
        float acc = 0.f;
#pragma unroll 8
        for (int d = 0; d < 32; ++d) { const f32x4 a = kp[d], b = qp[d]; acc += (a.x * b.x + a.y * b.y) + (a.z * b.z + a.w * b.w); }
        ps[t * 260 + j] = acc + (biastab ? biastab[j] : 0.f); }
    __syncthreads();
    { const int t = wave; float m = -3.0e38f;
      for (int j = lane; j < nk; j += 64) m = fmaxf(m, ps[t * 260 + j]);
#pragma unroll
      for (int o = 1; o < 64; o <<= 1) m = fmaxf(m, __shfl_xor(m, o));
      float s = 0.f;
      for (int j = lane; j < nk; j += 64) { const float p = __expf(ps[t * 260 + j] - m); ps[t * 260 + j] = p; s += p; }
      s = wave_sum(s);
      if (lane == 0) { st[t] = 1.0f / s; if (lse0) lse0[(long)t * lse_rs] = m + __logf(s); } }
    __syncthreads();
    { const int t = wave; f32x2 acc = (f32x2){0.f, 0.f};
      for (int j = 0; j < nk; ++j) { const float p = ps[t * 260 + j]; const f32x2 vv = ((const f32x2*)vptr(t, j))[lane]; acc.x += p * vv.x; acc.y += p * vv.y; }
      const float inv = st[t];
      *(unsigned*)(orow0 + (long)t * o_rs + 2 * lane) = pk2(acc.x * inv, acc.y * inv); }
}

__device__ __forceinline__ void sample_hgrn_item(const Params& P, int sb, int h, unsigned char* lds) {
    float* fs = (float*)lds;
    float* ks = fs + 1024;
    float* qs = ks + 1024;
    float* is_ = qs + 1024;
    float* part = is_ + 1024;
    float* osq = part + 512;
    const int tid = threadIdx.x, lane = tid & 63, wave = tid >> 6;
    const bf16_t* PROJ = (const bf16_t*)(P.ws + WS_PROJ); const float* LB = (const float*)(P.ws + WS_TAB) + 3 * 4 * 132;
    __syncthreads();
    for (int idx = tid; idx < 1024; idx += NTHR) { const int t = idx >> 7, k = idx & 127; const bf16_t* pr = PROJ + (size_t)(MP + sb * 8 + t) * NIN + h * 128 + k;
        const float lb = LB[h * 128 + k]; const float f = lb + (1.0f - lb) * sigmoidf_(bf2f(pr[C_HF]));
        fs[idx] = f; ks[idx] = 1.0f - f; qs[idx] = bf2f(pr[C_HQ]); is_[idx] = bf2f(pr[C_HI]); }
    const int v = tid & 127, kq = tid >> 7;
    const float* s_in = P.in[7] + ((size_t)(sb * 4 + h) * 128) * 128; float* s_out = P.out + O_SHG + ((size_t)(sb * 4 + h) * 128) * 128;
    float S[32];
#pragma unroll
    for (int i = 0; i < 32; ++i) S[i] = s_in[(size_t)(kq * 32 + i) * 128 + v];
    __syncthreads();
    const float gain = P.in[15][v];
    for (int t = 0; t < 8; ++t) {
        const float iv = is_[t * 128 + v]; float po = 0.f;
#pragma unroll
        for (int i = 0; i < 32; ++i) { const int k = kq * 32 + i; S[i] = fs[t * 128 + k] * S[i] + ks[t * 128 + k] * iv; po += S[i] * qs[t * 128 + k]; }
        part[kq * 128 + v] = po;
        __syncthreads();
        if (tid < 128) { const float o = (part[v] + part[128 + v]) + (part[256 + v] + part[384 + v]);
            const float ss = wave_sum(o * o); if (lane == 0) osq[wave] = ss;
            part[v] = o; }
        __syncthreads();
        if (tid < 128) { const float o = part[v]; const float r = rsqrtf((osq[0] + osq[1]) * (1.0f / 128.0f) + EPS);
            const size_t row = (size_t)(MP + sb * 8 + t); const float gate = sigmoidf_(bf2f(PROJ[row * NIN + C_HG + h * 128 + v]));
            ((bf16_t*)(P.ws + WS_ABR))[((size_t)1 * MT + row) * 512 + h * 128 + v] = (bf16_t)f2bf(o * r * gain * gate); }
        __syncthreads();
    }
#pragma unroll
    for (int i = 0; i < 32; ++i) s_out[(size_t)(kq * 32 + i) * 128 + v] = S[i];
}

__device__ __forceinline__ void hgrn_local_unit(const Params& P, int bh, int c, unsigned char* lds) {
    float* Gs = (float*)lds;
    float* Qs = Gs + 8192;
    float* Kk = Qs + 8192;
    float* Vs = Kk + 8192;
    float* Sc = Vs + 8192;
    const int tid = threadIdx.x, lane = tid & 63;
    const int b = bh >> 2, h = bh & 3; const size_t row0 = (size_t)b * SEQ + (size_t)c * 64;
    const bf16_t* PROJ = (const bf16_t*)(P.ws + WS_PROJ); const float* LB = (const float*)(P.ws + WS_TAB) + 3 * 4 * 132;
    __syncthreads();
    for (int idx = tid; idx < 8192; idx += NTHR) { const int t = idx >> 7, k = idx & 127; const bf16_t* pr = PROJ + (row0 + t) * NIN + h * 128 + k;
        const float lb = LB[h * 128 + k]; const float f = lb + (1.0f - lb) * sigmoidf_(bf2f(pr[C_HF]));
        Gs[idx] = logf(f); Kk[idx] = 1.0f - f; Qs[idx] = bf2f(pr[C_HQ]); Vs[idx] = bf2f(pr[C_HI]); }
    __syncthreads();
    if (tid < 128) { float a = 0.f; for (int t = 0; t < 64; ++t) { a += Gs[t * 128 + tid]; Gs[t * 128 + tid] = a; } }
    __syncthreads();
    { bf16_t* HQT = (bf16_t*)(P.ws + WS_HQT);
      for (int idx = tid; idx < 8192; idx += NTHR) { const int t = idx >> 7, k = idx & 127; HQT[(row0 + t) * 512 + h * 128 + k] = (bf16_t)f2bf(Qs[idx] * __expf(Gs[idx])); }
      if (tid < 128) ((float*)(P.ws + WS_DC))[((size_t)bh * 128 + c) * 128 + tid] = __expf(Gs[63 * 128 + tid]); }
    { const int t = tid >> 3, sub = tid & 7;
      for (int s = sub; s < 64; s += 8) { float acc = 0.f;
          if (s <= t) { for (int kk = 0; kk < 128; ++kk) { const int k = (kk + lane) & 127; acc += Qs[t * 128 + k] * Kk[s * 128 + k] * __expf(Gs[t * 128 + k] - Gs[s * 128 + k]); } }
          Sc[t * 64 + s] = acc; } }
    __syncthreads();
    { const int t = tid >> 3, v0 = (tid & 7) * 16; f32x4 o[4];
#pragma unroll
      for (int i = 0; i < 4; ++i) o[i] = (f32x4){0.f, 0.f, 0.f, 0.f};
      for (int s = 0; s <= t; ++s) { const float p = Sc[t * 64 + s]; const f32x4* vp = (const f32x4*)(Vs + s * 128 + v0);
#pragma unroll
          for (int i = 0; i < 4; ++i) o[i] += p * vp[i]; }
      f32x4* op = (f32x4*)((float*)(P.ws + WS_OINTRA) + (row0 + t) * 512 + h * 128 + v0);
#pragma unroll
      for (int i = 0; i < 4; ++i) op[i] = o[i]; }
    for (int idx = tid; idx < 8192; idx += NTHR) { const int k = idx & 127; Kk[idx] = Kk[idx] * __expf(Gs[63 * 128 + k] - Gs[idx]); }
    __syncthreads();
    { const int k = tid >> 2, v0 = (tid & 3) * 32; f32x4 u[8];
#pragma unroll
      for (int i = 0; i < 8; ++i) u[i] = (f32x4){0.f, 0.f, 0.f, 0.f};
      for (int s = 0; s < 64; ++s) { const float kt = Kk[s * 128 + k]; const f32x4* vp = (const f32x4*)(Vs + s * 128 + v0);
#pragma unroll
          for (int i = 0; i < 8; ++i) u[i] += kt * vp[i]; }
      f32x4* up = (f32x4*)((float*)(P.ws + WS_U) + ((size_t)bh * 128 + c) * 16384 + k * 128 + v0);
#pragma unroll
      for (int i = 0; i < 8; ++i) up[i] = u[i]; }
}

__device__ __forceinline__ void phase_mix1(const Params& P, unsigned char* lds) {
    unsigned char* ws = P.ws; bf16_t* PROJ = (bf16_t*)(ws + WS_PROJ);
    const float* BT = (const float*)(ws + WS_TAB);
    constexpr int N_DIL = 3 * 2 * 4 * 64, N_MEM = 2 * 4 * 64, N_HL = 8 * 128, N_SA = 32 * 3 * 4, N_SM = 32 * 4, N_SH = 32 * 4;
    constexpr int NTOT = N_DIL + N_MEM + N_HL + N_SA + N_SM + N_SH;
    for (int it = blockIdx.x; it < NTOT; it += gridDim.x) {
        int r = it;
        if (r < N_DIL + N_MEM) {
            AttnUnit U;
            if (r < N_DIL) {
                const int g = r / 512, b = (r >> 8) & 1, h = (r >> 6) & 3, rb = r & 63;
                const int dil = g == 0 ? 1 : (g == 1 ? 4 : 16); const int nbper = 64 / dil; const int res = rb / nbper, n = rb % nbper;
                const long base = (long)b * SEQ + (long)n * 128 * dil + res; const long kbase = base - (long)128 * dil;
                U.q = PROJ + base * NIN + C_Q + g * 512 + h * 128; U.q_rs = (long)dil * NIN;
                U.k = PROJ + kbase * NIN + C_K + g * 512 + h * 128; U.k_rs = (long)dil * NIN; U.v = PROJ + kbase * NIN + C_V + g * 512 + h * 128; U.v_rs = (long)dil * NIN;
                U.k_valid_from = n == 0 ? 128 : 0;
                U.o = (bf16_t*)(ws + WS_ATTO) + ((long)g * MT + base) * 512 + h * 128; U.o_rs = (long)dil * 512;
                U.lse = (float*)(ws + WS_LSE) + ((long)g * MT + base) * 4 + h; U.lse_rs = (long)dil * 4; U.bias = BT + (g * 4 + h) * 132;
            } else {
                const int q = r - N_DIL; const int b = q >> 8, h = (q >> 6) & 3, n = q & 63; const long base = (long)b * SEQ + (long)n * 128;
                const bf16_t* MEMKV = (const bf16_t*)(ws + WS_MEMKV);
                U.q = PROJ + base * NIN + C_MQ + h * 128; U.q_rs = NIN; U.k = MEMKV + (long)b * 256 * 1024 + h * 128; U.k_rs = 1024; U.v = U.k + 512; U.v_rs = 1024; U.k_valid_from = 0;
                U.o = (bf16_t*)(ws + WS_ABR) + ((long)2 * MT + base) * 512 + h * 128; U.o_rs = 512; U.lse = nullptr; U.lse_rs = 0; U.bias = nullptr;
            }
            if (MIX1_SEL & 1) attn_unit(U, lds);
            continue; }
        r -= N_DIL + N_MEM;
        if (r < N_HL) { if (MIX1_SEL & 4) hgrn_local_unit(P, r >> 7, r & 127, lds); continue; }
        r -= N_HL;
        if (r < N_SA + N_SM) {
            int sb, g, h;
            if (r < N_SA) { sb = r / 12; g = (r / 4) % 3; h = r & 3; } else { const int q = r - N_SA; sb = q >> 2; g = 3; h = q & 3; }
            const int W = g == 0 ? 128 : (g == 1 ? 512 : (g == 2 ? 2048 : 256)), dil = g == 0 ? 1 : (g == 1 ? 4 : (g == 2 ? 16 : -1));
            const float* cache = (g == 0 ? P.in[3] : (g == 1 ? P.in[4] : (g == 2 ? P.in[5] : P.in[6]))) + (size_t)sb * W * 1024 + h * 128;
            const float* neu = P.out + (g == 0 ? O_SW1 : (g == 1 ? O_SW2 : O_SW3)) + ((size_t)sb * W + (W - 8)) * 1024 + h * 128;
            const long row0 = MP + sb * 8;
            const int tq = g < 3 ? 1 : 0, base_idx = g < 3 ? W : 0;
            auto kp = [&](int t, int j) { const int idx = base_idx + tq * t - dil * j; return idx < W ? cache + (size_t)idx * 1024 : neu + (size_t)(idx - W) * 1024; };
            bf16_t* op = g < 3 ? (bf16_t*)(ws + WS_ATTO) + ((long)g * MT + row0) * 512 + h * 128 : (bf16_t*)(ws + WS_ABR) + ((long)2 * MT + row0) * 512 + h * 128;
            if (MIX1_SEL & 8) sample_attn_item(PROJ + row0 * NIN + (g < 3 ? C_Q + g * 512 : C_MQ) + h * 128, g < 3 ? 129 : 256, g < 3 ? BT + (g * 4 + h) * 132 : nullptr,
                kp, [&](int t, int j) { return kp(t, j) + 512; }, op, 512, g < 3 ? (float*)(ws + WS_LSE) + ((long)g * MT + row0) * 4 + h : nullptr, 4, lds);
            continue; }
        r -= N_SA;
        r -= N_SM;
        if (MIX1_SEL & 32) sample_hgrn_item(P, r >> 2, r & 3, lds);
    }
}

__device__ __forceinline__ void phase_scan(const Params& P) {
    const float* U = (const float*)(P.ws + WS_U); const float* DC = (const float*)(P.ws + WS_DC); float* S0 = (float*)(P.ws + WS_S0);
    for (int e = blockIdx.x * NTHR + threadIdx.x; e < 8 * 16384; e += gridDim.x * NTHR) {
        const int bh = e >> 14, kv = e & 16383, k = kv >> 7; float S = 0.f;
        for (int c = 0; c < 128; ++c) { const size_t o = ((size_t)bh * 128 + c) * 16384 + kv; S0[o] = S; S = DC[((size_t)bh * 128 + c) * 128 + k] * S + U[o]; }
        P.out[O_PHG + (size_t)bh * 16384 + kv] = S;
    }
}

__device__ __forceinline__ void hgrn_final_unit(const Params& P, int bh, int c, unsigned char* lds) {
    float* Ss = (float*)lds;
    float* Qt = Ss + 16384;
    const int tid = threadIdx.x; const int b = bh >> 2, h = bh & 3; const size_t row0 = (size_t)b * SEQ + (size_t)c * 64;
    __syncthreads();
    { const f32x4* s4 = (const f32x4*)((const float*)(P.ws + WS_S0) + ((size_t)bh * 128 + c) * 16384);
      for (int idx = tid; idx < 4096; idx += NTHR) ((f32x4*)Ss)[idx] = s4[idx];
      const bf16_t* HQT = (const bf16_t*)(P.ws + WS_HQT);
      for (int idx = tid; idx < 1024; idx += NTHR) { const int t = idx >> 4, c8 = (idx & 15) * 8; float v[8]; load_bf16x8(HQT + (row0 + t) * 512 + h * 128 + c8, v);
#pragma unroll
          for (int e = 0; e < 8; ++e) Qt[t * 128 + c8 + e] = v[e]; } }
    __syncthreads();
    const int t = tid >> 3, v0 = (tid & 7) * 16; const size_t row = row0 + t;
    f32x4 o[4];
    { const f32x4* oi = (const f32x4*)((const float*)(P.ws + WS_OINTRA) + row * 512 + h * 128 + v0);
#pragma unroll
      for (int i = 0; i < 4; ++i) o[i] = oi[i]; }
    for (int k = 0; k < 128; ++k) { const float q = Qt[t * 128 + k]; const f32x4* sp = (const f32x4*)(Ss + k * 128 + v0);
#pragma unroll
        for (int i = 0; i < 4; ++i) o[i] += q * sp[i]; }
    float ss = 0.f;
#pragma unroll
    for (int i = 0; i < 4; ++i) ss += (o[i].x * o[i].x + o[i].y * o[i].y) + (o[i].z * o[i].z + o[i].w * o[i].w);
    ss += __shfl_xor(ss, 1); ss += __shfl_xor(ss, 2); ss += __shfl_xor(ss, 4);
    const float r = rsqrtf(ss * (1.0f / 128.0f) + EPS);
    const float* gain = P.in[15] + v0; const bf16_t* gp = (const bf16_t*)(P.ws + WS_PROJ) + row * NIN + C_HG + h * 128 + v0;
    float gt[16]; load_bf16x8(gp, gt); load_bf16x8(gp + 8, gt + 8);
    float res[16];
#pragma unroll
    for (int i = 0; i < 4; ++i) { res[4 * i + 0] = o[i].x * r * gain[4 * i + 0] * sigmoidf_(gt[4 * i + 0]); res[4 * i + 1] = o[i].y * r * gain[4 * i + 1] * sigmoidf_(gt[4 * i + 1]);
        res[4 * i + 2] = o[i].z * r * gain[4 * i + 2] * sigmoidf_(gt[4 * i + 2]); res[4 * i + 3] = o[i].w * r * gain[4 * i + 3] * sigmoidf_(gt[4 * i + 3]); }
    bf16_t* op = (bf16_t*)(P.ws + WS_ABR) + ((size_t)1 * MT + row) * 512 + h * 128 + v0;
    store_bf16x8(op, res); store_bf16x8(op + 8, res + 8);
}
__device__ __forceinline__ void phase_mix2(const Params& P, unsigned char* lds) {
    for (int it = blockIdx.x; it < 1024; it += gridDim.x) hgrn_final_unit(P, it >> 7, it & 127, lds);
    const int lane = threadIdx.x & 63, wave = threadIdx.x >> 6; const int gw = blockIdx.x * NWAVES + wave, NGW = gridDim.x * NWAVES;
    const bf16_t* ATTO = (const bf16_t*)(P.ws + WS_ATTO); const float* LSE = (const float*)(P.ws + WS_LSE); bf16_t* ABR = (bf16_t*)(P.ws + WS_ABR);
    for (int row = gw; row < MT; row += NGW) {
        const int h = lane >> 4; const float l0 = LSE[((size_t)0 * MT + row) * 4 + h], l1 = LSE[((size_t)1 * MT + row) * 4 + h], l2 = LSE[((size_t)2 * MT + row) * 4 + h];
        const float m = fmaxf(l0, fmaxf(l1, l2)); float w0 = __expf(l0 - m), w1 = __expf(l1 - m), w2 = __expf(l2 - m); const float inv = 1.0f / (w0 + w1 + w2); w0 *= inv; w1 *= inv; w2 *= inv;
        float a[8], b2[8], c2[8], o[8];
        load_bf16x8(ATTO + ((size_t)0 * MT + row) * 512 + lane * 8, a); load_bf16x8(ATTO + ((size_t)1 * MT + row) * 512 + lane * 8, b2); load_bf16x8(ATTO + ((size_t)2 * MT + row) * 512 + lane * 8, c2);
#pragma unroll
        for (int e = 0; e < 8; ++e) o[e] = w0 * a[e] + w1 * b2[e] + w2 * c2[e];
        store_bf16x8(ABR + (size_t)row * 512 + lane * 8, o);
    }
}

__device__ __forceinline__ void phase_branch(const Params& P, unsigned char* lds) {
    float* red = (float*)lds; unsigned char* ws = P.ws;
    const bf16_t* ABR = (const bf16_t*)(ws + WS_ABR); const bf16_t* WBR = (const bf16_t*)(ws + WS_WBR_T); const bf16_t* PROJ = (const bf16_t*)(ws + WS_PROJ); bf16_t* MERGED = (bf16_t*)(ws + WS_MERGED);
    constexpr int NU = (MT / 64) * 16;
    for (int u = blockIdx.x; u < NU; u += gridDim.x) {
        const int tr = u % (MT / 64), tc = u / (MT / 64);
        float msum[8] = {0.f, 0.f, 0.f, 0.f, 0.f, 0.f, 0.f, 0.f};
#pragma unroll
        for (int br = 0; br < 3; ++br) {
            sgemm_unit(ABR + (size_t)br * MT * 512, 512, WBR + (size_t)br * 1024 * 512, 512, 512, tr * 64, tc * 64, red, [&](int row, int col, float* v) {
                float g[8]; load_bf16x8(PROJ + (size_t)row * NIN + (br == 0 ? C_GA : (br == 1 ? C_GH : C_GM)) + col, g);
#pragma unroll
                for (int e = 0; e < 8; ++e) msum[e] += sigmoidf_(g[e]) * v[e];
                if (br == 2) store_bf16x8(MERGED + (size_t)row * 1024 + col, msum); });
        }
    }
}
__device__ __forceinline__ void phase_gemm_f32(const bf16_t* A, const bf16_t* Bt, int K, float* C, unsigned char* lds) {
    float* red = (float*)lds; constexpr int NU = (MT / 64) * 16;
    for (int u = blockIdx.x; u < NU; u += gridDim.x) { const int tr = u % (MT / 64), tc = u / (MT / 64);
        sgemm_unit(A, K, Bt, K, K, tr * 64, tc * 64, red, [&](int row, int col, float* v) { store_f32x8(C + (size_t)row * 1024 + col, v); }); }
}
__device__ __forceinline__ void phase_ffn_up(const Params& P, unsigned char* lds) {
    float* red = (float*)lds; const bf16_t* XN = (const bf16_t*)(P.ws + WS_XN); const bf16_t* W = (const bf16_t*)(P.ws + WS_WAB_T); bf16_t* AB = (bf16_t*)(P.ws + WS_AB);
    constexpr int NU = (MT / 64) * 128;
    for (int u = blockIdx.x; u < NU; u += gridDim.x) { const int tr = u % (MT / 64), tc = u / (MT / 64);
        sgemm_unit(XN, D, W, D, D, tr * 64, tc * 64, red, [&](int row, int col, float* v) { store_bf16x8(AB + (size_t)row * 8192 + col, v); }); }
}
__device__ __forceinline__ void phase_mid_norm(const Params& P) {
    const int lane = threadIdx.x & 63, wave = threadIdx.x >> 6; const int gw = blockIdx.x * NWAVES + wave, NGW = gridDim.x * NWAVES;
    const float* MIX = (const float*)(P.ws + WS_MIX); bf16_t* XN = (bf16_t*)(P.ws + WS_XN);
    for (int row = gw; row < MT; row += NGW) {
        const float* xr = row < MP ? P.in[0] + (size_t)row * D : P.in[1] + (size_t)(row - MP) * D; float* yr = P.out + (size_t)row * D;
        f32x4 m[4], x[4]; float s = 0.f;
#pragma unroll
        for (int j = 0; j < 4; ++j) { m[j] = ((const f32x4*)(MIX + (size_t)row * D))[lane + 64 * j]; s += (m[j].x * m[j].x + m[j].y * m[j].y) + (m[j].z * m[j].z + m[j].w * m[j].w); }
        const float r = rsqrtf(wave_sum(s) * (1.0f / 1024.0f) + EPS); float s2 = 0.f;
#pragma unroll
        for (int j = 0; j < 4; ++j) { const f32x4 g = ((const f32x4*)P.in[12])[lane + 64 * j]; x[j] = ((const f32x4*)xr)[lane + 64 * j] + m[j] * r * g; ((f32x4*)yr)[lane + 64 * j] = x[j];
            s2 += (x[j].x * x[j].x + x[j].y * x[j].y) + (x[j].z * x[j].z + x[j].w * x[j].w); }
        const float r2 = rsqrtf(wave_sum(s2) * (1.0f / 1024.0f) + EPS);
#pragma unroll
        for (int j = 0; j < 4; ++j) { const f32x4 g = ((const f32x4*)P.in[22])[lane + 64 * j]; u32x2 o; o.x = pk2(x[j].x * r2 * g.x, x[j].y * r2 * g.y); o.y = pk2(x[j].z * r2 * g.z, x[j].w * r2 * g.w);
            ((u32x2*)(XN + (size_t)row * D))[lane + 64 * j] = o; }
    }
}
__device__ __forceinline__ void phase_ffn_gate(const Params& P) {
    const bf16_t* AB = (const bf16_t*)(P.ws + WS_AB); bf16_t* H = (bf16_t*)(P.ws + WS_H);
    const float* cw = P.in[26]; const float* cb = P.in[27]; const float* cbuf = P.in[8];
    for (size_t idx = (size_t)blockIdx.x * NTHR + threadIdx.x; idx < (size_t)MT * 512; idx += (size_t)gridDim.x * NTHR) {
        const int row = (int)(idx >> 9), n = (int)(idx & 511) * 8; const int cofs = (n >> 7) * 256 + (n & 127);
        float a[8], b[8], a1[8], a2[8];
        load_bf16x8(AB + (size_t)row * 8192 + cofs, a); load_bf16x8(AB + (size_t)row * 8192 + cofs + 128, b);
        if (row < MP) { const int t = row & 8191;
            if (t >= 1) load_bf16x8(AB + (size_t)(row - 1) * 8192 + cofs, a1); else { for (int e = 0; e < 8; ++e) a1[e] = 0.f; }
            if (t >= 2) load_bf16x8(AB + (size_t)(row - 2) * 8192 + cofs, a2); else { for (int e = 0; e < 8; ++e) a2[e] = 0.f; }
            if (t >= SEQ - 2) store_f32x8(P.out + O_PCONV + ((size_t)(row >> 13) * 2 + (t - (SEQ - 2))) * DFF + n, a);
        } else { const int sb = (row - MP) >> 3, st = (row - MP) & 7; const float* cbb = cbuf + (size_t)sb * 2 * DFF + n;
            if (st >= 1) load_bf16x8(AB + (size_t)(row - 1) * 8192 + cofs, a1); else { for (int e = 0; e < 8; ++e) a1[e] = cbb[DFF + e]; }
            if (st >= 2) load_bf16x8(AB + (size_t)(row - 2) * 8192 + cofs, a2); else { for (int e = 0; e < 8; ++e) a2[e] = cbb[(st == 0 ? 0 : DFF) + e]; }
            if (st >= 6) store_f32x8(P.out + O_SCONV + ((size_t)sb * 2 + (st - 6)) * DFF + n, a);
        }
        float o[8];
#pragma unroll
        for (int e = 0; e < 8; ++e) { const float c = cb[n + e] + a2[e] * cw[n + e] + a1[e] * cw[DFF + n + e] + a[e] * cw[2 * DFF + n + e]; o[e] = c * sigmoidf_(c) * b[e]; }
        store_bf16x8(H + (size_t)row * DFF + n, o);
    }
}
__device__ __forceinline__ void phase_final_norm(const Params& P) {
    const int lane = threadIdx.x & 63, wave = threadIdx.x >> 6; const int gw = blockIdx.x * NWAVES + wave, NGW = gridDim.x * NWAVES;
    const float* Fm = (const float*)(P.ws + WS_MIX);
    for (int row = gw; row < MT; row += NGW) {
        float* yr = P.out + (size_t)row * D; f32x4 m[4]; float s = 0.f;
#pragma unroll
        for (int j = 0; j < 4; ++j) { m[j] = ((const f32x4*)(Fm + (size_t)row * D))[lane + 64 * j]; s += (m[j].x * m[j].x + m[j].y * m[j].y) + (m[j].z * m[j].z + m[j].w * m[j].w); }
        const float r = rsqrtf(wave_sum(s) * (1.0f / 1024.0f) + EPS);
#pragma unroll
        for (int j = 0; j < 4; ++j) { const f32x4 g = ((const f32x4*)P.in[23])[lane + 64 * j]; ((f32x4*)yr)[lane + 64 * j] = ((const f32x4*)yr)[lane + 64 * j] + m[j] * r * g; }
    }
}

constexpr int NPHASE = 12;
__global__ void __launch_bounds__(NTHR, 2) mega_fwd(Params P) {
    extern __shared__ __attribute__((aligned(16))) unsigned char lds[];
    volatile unsigned* MISC = (volatile unsigned*)(lds + LDS_BYTES - 64);
    if (threadIdx.x < 16) MISC[threadIdx.x] = 0u;
    __syncthreads();
    XcdBarrier bar; bar.bar = (unsigned*)(P.ws + WS_CTL) + 4096; bar.x = 0; bar.st = nullptr;
    const bool multi = (P.ph_hi - P.ph_lo) > 1;
    if (multi) bar = xcd_barrier_post((unsigned*)(P.ws + WS_CTL) + 4096, MISC);
    const int lo = P.ph_lo, hi = P.ph_hi;
#define IN(k) (lo <= (k) && (k) < hi)
#define SEAM(k) do { if (IN(k) && IN((k) + 1)) xcd_barrier(bar); } while (0)
    if (IN(0)) phase_prep(P, lds);
    SEAM(0);
    if (IN(1)) phase_inproj(P, lds);
    SEAM(1);
    if (IN(2)) phase_mix1(P, lds);
    SEAM(2);
    if (IN(3)) phase_scan(P);
    SEAM(3);
    if (IN(4)) phase_mix2(P, lds);
    SEAM(4);
    if (IN(5)) phase_branch(P, lds);
    SEAM(5);
    if (IN(6)) phase_gemm_f32((const bf16_t*)(P.ws + WS_MERGED), (const bf16_t*)(P.ws + WS_WOUT_T), 1024, (float*)(P.ws + WS_MIX), lds);
    SEAM(6);
    if (IN(7)) phase_mid_norm(P);
    SEAM(7);
    if (IN(8)) phase_ffn_up(P, lds);
    SEAM(8);
    if (IN(9)) phase_ffn_gate(P);
    SEAM(9);
    if (IN(10)) phase_gemm_f32((const bf16_t*)(P.ws + WS_H), (const bf16_t*)(P.ws + WS_WD_T), 4096, (float*)(P.ws + WS_MIX), lds);
    SEAM(10);
    if (IN(11)) phase_final_norm(P);
#undef IN
#undef SEAM
}
}

extern "C" void kernel_launch(void* const* d_in, const int* in_sizes, int n_in, void* d_out, int out_size, void* d_ws, size_t ws_size, hipStream_t stream) {
    static int ready = 0;
    if (ready == 0) {
        if (n_in != 29 || (size_t)out_size != O_END || ws_size < WS_END) { fprintf(stderr, "kernel_launch: unexpected shapes (n_in %d out %d ws %zu)\n", n_in, out_size, ws_size); ready = -1; return; }
        if (hipFuncSetAttribute((const void*)mega_fwd, hipFuncAttributeMaxDynamicSharedMemorySize, LDS_BYTES) != hipSuccess) { fprintf(stderr, "kernel_launch: hipFuncSetAttribute failed\n"); ready = -1; return; }
        ready = 1;
    }
    if (ready < 0) return;
    (void)hipMemsetAsync((char*)d_ws + WS_CTL, 0, CTL_BYTES, stream);
    Params p{};
    for (int i = 0; i < 29; ++i) p.in[i] = (const float*)d_in[i];
    p.out = (float*)d_out; p.ws = (unsigned char*)d_ws;
#if MK_ONE_LAUNCH
    p.ph_lo = 0; p.ph_hi = NPHASE;
    hipLaunchKernelGGL(mega_fwd, dim3(256), dim3(NTHR), LDS_BYTES, stream, p);
#else
    for (int ph = 0; ph < NPHASE; ++ph) { p.ph_lo = ph; p.ph_hi = ph + 1; hipLaunchKernelGGL(mega_fwd, dim3(256), dim3(NTHR), LDS_BYTES, stream, p); }
#endif
}
```

```cpp
#include <hip/hip_runtime.h>
#include <cstdio>
#include <cstdint>

#ifndef MIX1_SEL
#define MIX1_SEL 63
#endif
#ifndef MK_ONE_LAUNCH
#define MK_ONE_LAUNCH 1
#endif

namespace {
typedef unsigned short bf16_t;
typedef short bf16x8 __attribute__((ext_vector_type(8)));
typedef float f32x4 __attribute__((ext_vector_type(4)));
typedef float f32x2 __attribute__((ext_vector_type(2)));
typedef unsigned u32x4 __attribute__((ext_vector_type(4)));
typedef unsigned u32x2 __attribute__((ext_vector_type(2)));

constexpr int NTHR = 512, NWAVES = 8;
constexpr int D = 1024, SEQ = 8192, NB = 2, MP = NB * SEQ, SBATCH = 32, STOK = 8, MS = SBATCH * STOK, MT = MP + MS;
constexpr int NIN = 10240, DFF = 4096;
constexpr int C_Q = 0, C_K = 1536, C_V = 3072, C_HQ = 4608, C_HF = 5120, C_HI = 5632, C_HG = 6144, C_MQ = 6656, C_GA = 7168, C_GH = 8192, C_GM = 9216;
constexpr float EPS = 1e-6f;

constexpr size_t O_YP = 0, O_YS = 16777216, O_PW1 = 17039360, O_PW2 = 17301504, O_PW3 = 18350080, O_PHG = 22544384, O_PCONV = 22675456, O_PMEM = 22691840,
                 O_SW1 = 23216128, O_SW2 = 27410432, O_SW3 = 44187648, O_SHG = 111296512, O_SCONV = 113393664, O_END = 113655808;

constexpr size_t MiB = 1u << 20;
constexpr size_t WS_CTL = 0, CTL_BYTES = 1 * MiB;
constexpr size_t WS_TAB = 1 * MiB;
constexpr size_t WS_WIN_T = 2 * MiB;
constexpr size_t WS_WMEM_T = 22 * MiB;
constexpr size_t WS_WBR_T = 24 * MiB;
constexpr size_t WS_WOUT_T = 27 * MiB;
constexpr size_t WS_WAB_T = 29 * MiB;
constexpr size_t WS_WD_T = 45 * MiB;
constexpr size_t WS_XN = 54 * MiB;
constexpr size_t WS_MEMN = 87 * MiB;
constexpr size_t WS_MEMKV = 88 * MiB;
constexpr size_t WS_PROJ = 90 * MiB;
constexpr size_t WS_ATTO = 416 * MiB;
constexpr size_t WS_LSE = 465 * MiB;
constexpr size_t WS_ABR = 466 * MiB;
constexpr size_t WS_HQT = 515 * MiB;
constexpr size_t WS_OINTRA = 531 * MiB;
constexpr size_t WS_U = 563 * MiB;
constexpr size_t WS_DC = 627 * MiB;
constexpr size_t WS_S0 = 628 * MiB;
constexpr size_t WS_MERGED = 692 * MiB;
constexpr size_t WS_MIX = 725 * MiB;
constexpr size_t WS_H = 790 * MiB;
constexpr size_t WS_AB = WS_PROJ;
constexpr size_t WS_END = 920 * MiB;

constexpr int LDS_BYTES = 155648;

struct Params { const float* in[29]; float* out; unsigned char* ws; int ph_lo, ph_hi; };

__device__ __forceinline__ unsigned f2bf(float f) { unsigned u = __float_as_uint(f); return (u + 0x7fffu + ((u >> 16) & 1u)) >> 16; }
__device__ __forceinline__ float bf2f(unsigned h) { return __uint_as_float(h << 16); }
__device__ __forceinline__ unsigned pk2(float lo, float hi) { return f2bf(lo) | (f2bf(hi) << 16); }
__device__ __forceinline__ float wave_sum(float v) {
#pragma unroll
    for (int o = 1; o < 64; o <<= 1) v += __shfl_xor(v, o);
    return v;
}
__device__ __forceinline__ float sigmoidf_(float x) { return 1.0f / (1.0f + __expf(-x)); }
#define LDS_WAIT() asm volatile("s_waitcnt lgkmcnt(0)" ::: "memory")

#define XB_TMO      128
#define XB_XCNT(j)  (256  + 64 * (j))
#define XB_XSUB(j)  (1280 + 64 * (j))
#define XB_XGEN(j)  (2304 + 64 * (j))
#define XB_TOP      3328
#define XB_TOPGEN   3392
#define XB_SPIN_CAP (1u << 22)
__device__ __forceinline__ unsigned xb_ld(unsigned* p)              { return __hip_atomic_load(p, __ATOMIC_RELAXED, __HIP_MEMORY_SCOPE_AGENT); }
__device__ __forceinline__ unsigned xb_add(unsigned* p, unsigned v) { return __hip_atomic_fetch_add(p, v, __ATOMIC_RELAXED, __HIP_MEMORY_SCOPE_AGENT); }
__device__ __forceinline__ unsigned xb_xcc_id() { return (unsigned)__builtin_amdgcn_s_getreg((3 << 11) | 20) & 0xFu; }
#define XB_SPIN(cond, bar) do { unsigned _sp = 0; while (cond) { __builtin_amdgcn_s_sleep(1); \
    if ((++_sp & 255u) == 0u) { if (xb_ld(&(bar)[XB_TMO])) break; if (_sp > XB_SPIN_CAP) { atomicAdd(&(bar)[XB_TMO], 1u); break; } } } } while (0)
struct XcdBarrier { unsigned* bar; unsigned x; volatile unsigned* st; };
__device__ __forceinline__ XcdBarrier xcd_barrier_post(unsigned* bar, volatile unsigned* st) {
    XcdBarrier b; b.bar = bar; b.x = xb_xcc_id(); b.st = st;
    if (threadIdx.x == 0) (void)xb_add(&bar[XB_XCNT(b.x)], 1u);
    return b;
}
__device__ __forceinline__ void xcd_barrier_complete(unsigned* bar, unsigned x, unsigned& nloc, unsigned& nx) {
    const unsigned G = gridDim.x;
    unsigned sum, cnt, mine, sp = 0u;
    for (;;) {
        sum = 0u; cnt = 0u; mine = 0u;
#pragma unroll
        for (unsigned j = 0; j < 16; ++j) { const unsigned c = xb_ld(&bar[XB_XCNT(j)]); sum += c; cnt += (c > 0u) ? 1u : 0u; mine = (j == x) ? c : mine; }
        if (sum == G) break;
        __builtin_amdgcn_s_sleep(1);
        if ((++sp & 255u) == 0u) { if (xb_ld(&bar[XB_TMO])) break; if (sp > XB_SPIN_CAP) { atomicAdd(&bar[XB_TMO], 1u); break; } }
    }
    nloc = mine > 0u ? mine : 1u; nx = cnt > 0u ? cnt : 1u;
}
__device__ __forceinline__ void xcd_barrier(const XcdBarrier& b) {
    asm volatile("s_waitcnt vmcnt(0)" ::: "memory");
    __syncthreads();
    if (threadIdx.x == 0) {
        unsigned* bar = b.bar;
        __builtin_amdgcn_s_waitcnt(0);
        unsigned nloc = b.st[0], nx = b.st[1];
        if (nloc == 0u) { xcd_barrier_complete(bar, b.x, nloc, nx); b.st[0] = nloc; b.st[1] = nx; }
        const unsigned old = xb_add(&bar[XB_XSUB(b.x)], 1u);
        const unsigned gen = old / nloc;
        if (old + 1u == (gen + 1u) * nloc) {
            __builtin_amdgcn_fence(__ATOMIC_RELEASE, "agent");
            asm volatile("s_waitcnt vmcnt(0)" ::: "memory");
            const unsigned og = xb_add(&bar[XB_TOP], 1u);
            const unsigned tg = og / nx;
            if (og + 1u == (tg + 1u) * nx) xb_add(&bar[XB_TOPGEN], 1u);
            else XB_SPIN(xb_ld(&bar[XB_TOPGEN]) == tg, bar);
            __builtin_amdgcn_fence(__ATOMIC_ACQUIRE, "agent");
            xb_add(&bar[XB_XGEN(b.x)], 1u);
            asm volatile("s_waitcnt vmcnt(0)" ::: "memory");
        } else {
            XB_SPIN(xb_ld(&bar[XB_XGEN(b.x)]) == gen, bar);
            __builtin_amdgcn_fence(__ATOMIC_ACQUIRE, "agent");
            asm volatile("s_waitcnt vmcnt(0)" ::: "memory");
        }
    }
    __syncthreads();
}

__device__ __forceinline__ int dest_row(int n, int kind, int row_off) { return kind == 0 ? row_off + n : ((n >> 7) * 256 + (n & 127) + (kind == 2 ? 128 : 0)); }
__device__ __forceinline__ void transpose_item(const float* __restrict__ W, int K, int N, bf16_t* __restrict__ WT, int kind, int row_off, float* scr, int item, int lane) {
    const int nblk = N / 32, kb = item / nblk, nb = item % nblk, k0 = 64 * kb, n0 = 32 * nb;
#pragma unroll 8
    for (int i = 0; i < 32; ++i) { const int kk = 2 * i + (lane >> 5); scr[kk * 33 + (lane & 31)] = W[(size_t)(k0 + kk) * N + n0 + (lane & 31)]; }
    LDS_WAIT();
    const int c = lane & 7;
#pragma unroll
    for (int j = 0; j < 4; ++j) { const int n = (lane >> 3) + 8 * j; const float* s = scr + (8 * c) * 33 + n;
        u32x4 o; o.x = pk2(s[0 * 33], s[1 * 33]); o.y = pk2(s[2 * 33], s[3 * 33]); o.z = pk2(s[4 * 33], s[5 * 33]); o.w = pk2(s[6 * 33], s[7 * 33]);
        *(u32x4*)(WT + (size_t)dest_row(n0 + n, kind, row_off) * K + k0 + 8 * c) = o; }
    LDS_WAIT();
}
__device__ __forceinline__ void rms_row_bf16(const float* __restrict__ xr, const float* __restrict__ gain, bf16_t* __restrict__ orow, int lane) {
    f32x4 v[4]; float s = 0.f;
#pragma unroll
    for (int j = 0; j < 4; ++j) { v[j] = ((const f32x4*)xr)[lane + 64 * j]; s += (v[j].x * v[j].x + v[j].y * v[j].y) + (v[j].z * v[j].z + v[j].w * v[j].w); }
    const float r = rsqrtf(wave_sum(s) * (1.0f / 1024.0f) + EPS);
#pragma unroll
    for (int j = 0; j < 4; ++j) { const f32x4 g = ((const f32x4*)gain)[lane + 64 * j];
        u32x2 o; o.x = pk2(v[j].x * r * g.x, v[j].y * r * g.y); o.y = pk2(v[j].z * r * g.z, v[j].w * r * g.w);
        ((u32x2*)orow)[lane + 64 * j] = o; }
}
__device__ __forceinline__ void phase_prep(const Params& P, unsigned char* lds) {
    const int tid = threadIdx.x, lane = tid & 63, wave = tid >> 6;
    const int gw = blockIdx.x * NWAVES + wave, NGW = gridDim.x * NWAVES;
    unsigned char* ws = P.ws;
    float* scr = (float*)lds + wave * (64 * 33);
    {
        constexpr int I_IN = 16 * 320, I_MEM = 16 * 32, I_BR = 8 * 32, I_OUT = 16 * 32, I_A = 16 * 128, I_D = 64 * 32;
        constexpr int NIT = I_IN + I_MEM + 3 * I_BR + I_OUT + 2 * I_A + I_D;
        for (int it = gw; it < NIT; it += NGW) {
            int r = it;
            if (r < I_IN) { transpose_item(P.in[13], 1024, NIN, (bf16_t*)(ws + WS_WIN_T), 0, 0, scr, r, lane); continue; } r -= I_IN;
            if (r < I_MEM) { transpose_item(P.in[17], 1024, 1024, (bf16_t*)(ws + WS_WMEM_T), 0, 0, scr, r, lane); continue; } r -= I_MEM;
            if (r < I_BR) { transpose_item(P.in[18], 512, 1024, (bf16_t*)(ws + WS_WBR_T), 0, 0, scr, r, lane); continue; } r -= I_BR;
            if (r < I_BR) { transpose_item(P.in[19], 512, 1024, (bf16_t*)(ws + WS_WBR_T), 0, 1024, scr, r, lane); continue; } r -= I_BR;
            if (r < I_BR) { transpose_item(P.in[20], 512, 1024, (bf16_t*)(ws + WS_WBR_T), 0, 2048, scr, r, lane); continue; } r -= I_BR;
            if (r < I_OUT) { transpose_item(P.in[21], 1024, 1024, (bf16_t*)(ws + WS_WOUT_T), 0, 0, scr, r, lane); continue; } r -= I_OUT;
            if (r < I_A) { transpose_item(P.in[24], 1024, DFF, (bf16_t*)(ws + WS_WAB_T), 1, 0, scr, r, lane); continue; } r -= I_A;
            if (r < I_A) { transpose_item(P.in[25], 1024, DFF, (bf16_t*)(ws + WS_WAB_T), 2, 0, scr, r, lane); continue; } r -= I_A;
            transpose_item(P.in[28], DFF, 1024, (bf16_t*)(ws + WS_WD_T), 0, 0, scr, r, lane);
        }
    }
    {
        bf16_t* XN = (bf16_t*)(ws + WS_XN); bf16_t* MEMN = (bf16_t*)(ws + WS_MEMN);
        for (int m = gw; m < MT + 512; m += NGW) {
            if (m < MP) rms_row_bf16(P.in[0] + (size_t)m * D, P.in[11], XN + (size_t)m * D, lane);
            else if (m < MT) rms_row_bf16(P.in[1] + (size_t)(m - MP) * D, P.in[11], XN + (size_t)m * D, lane);
            else rms_row_bf16(P.in[2] + (size_t)(m - MT) * D, P.in[16], MEMN + (size_t)(m - MT) * D, lane);
        }
    }
    {
        constexpr int R1 = 32 * 120, R2 = 32 * 504, R3 = 32 * 2040;
        for (int r = gw; r < R1 + R2 + R3; r += NGW) {
            int q = r, W; const float* src; float* dst;
            if (q < R1) { W = 128; src = P.in[3]; dst = P.out + O_SW1; }
            else if (q < R1 + R2) { q -= R1; W = 512; src = P.in[4]; dst = P.out + O_SW2; }
            else { q -= R1 + R2; W = 2048; src = P.in[5]; dst = P.out + O_SW3; }
            const int b = q / (W - 8), i = q % (W - 8);
            const f32x4* s4 = (const f32x4*)(src + ((size_t)b * W + i + 8) * 1024); f32x4* d4 = (f32x4*)(dst + ((size_t)b * W + i) * 1024);
            f32x4 t0 = s4[lane], t1 = s4[lane + 64], t2 = s4[lane + 128], t3 = s4[lane + 192];
            d4[lane] = t0; d4[lane + 64] = t1; d4[lane + 128] = t2; d4[lane + 192] = t3;
        }
    }
    if (blockIdx.x == 0) {
        float* BT = (float*)(ws + WS_TAB); float* LB = BT + 3 * 4 * 132;
        const float* rel_bias = P.in[9];
        for (int e = tid; e < 3 * 4 * 129; e += NTHR) {
            const int g = e / (4 * 129), h = (e / 129) % 4, j = e % 129;
            const int dil = g == 0 ? 1 : (g == 1 ? 4 : 16);
            const int dist = j * dil; int bucket;
            if (dist < 16) bucket = dist;
            else { const float d = (float)dist; int large = 16 + (int)(logf(d / 16.0f) / logf(128.0f) * 16.0f); bucket = large < 31 ? large : 31; }
            BT[(g * 4 + h) * 132 + j] = rel_bias[bucket * 12 + g * 4 + h];
        }
        for (int e = tid; e < 512; e += NTHR) { const float l0 = P.in[10][e], l1 = P.in[10][512 + e]; LB[e] = 1.0f / (1.0f + expf(l1 - l0)); }
    }
}

template <class Epi>
__device__ __forceinline__ void sgemm_unit(const bf16_t* __restrict__ A, int lda, const bf16_t* __restrict__ Bt, int ldb, int K, int row0, int col0, float* red, const Epi& epi) {
    const int tid = threadIdx.x, lane = tid & 63, wave = tid >> 6, kq = wave >> 1, ch = wave & 1, fr = lane & 15, fq = lane >> 4;
    f32x4 acc[4][2];
#pragma unroll
    for (int i = 0; i < 4; ++i)
#pragma unroll
        for (int j = 0; j < 2; ++j) acc[i][j] = (f32x4){0.f, 0.f, 0.f, 0.f};
    const int kbeg = kq * (K >> 2), kend = kbeg + (K >> 2);
    const bf16_t* ap = A + (size_t)(row0 + fr) * lda + fq * 8;
    const bf16_t* bp = Bt + (size_t)(col0 + ch * 32 + fr) * ldb + fq * 8;
#pragma unroll 2
    for (int k = kbeg; k < kend; k += 32) {
        bf16x8 a[4], b[2];
#pragma unroll
        for (int i = 0; i < 4; ++i) a[i] = *(const bf16x8*)(ap + (size_t)i * 16 * lda + k);
#pragma unroll
        for (int j = 0; j < 2; ++j) b[j] = *(const bf16x8*)(bp + (size_t)j * 16 * ldb + k);
#pragma unroll
        for (int i = 0; i < 4; ++i)
#pragma unroll
            for (int j = 0; j < 2; ++j) acc[i][j] = __builtin_amdgcn_mfma_f32_16x16x32_bf16(a[i], b[j], acc[i][j], 0, 0, 0);
    }
    __syncthreads();
#pragma unroll
    for (int i = 0; i < 4; ++i)
#pragma unroll
        for (int j = 0; j < 2; ++j)
#pragma unroll
            for (int r = 0; r < 4; ++r) red[(kq * 64 + i * 16 + 4 * fq + r) * 65 + ch * 32 + j * 16 + fr] = acc[i][j][r];
    __syncthreads();
    const int row = tid >> 3, c8 = (tid & 7) * 8;
    float v[8];
#pragma unroll
    for (int e = 0; e < 8; ++e) v[e] = (red[(0 * 64 + row) * 65 + c8 + e] + red[(1 * 64 + row) * 65 + c8 + e]) + (red[(2 * 64 + row) * 65 + c8 + e] + red[(3 * 64 + row) * 65 + c8 + e]);
    epi(row0 + row, col0 + c8, v);
}
__device__ __forceinline__ void store_bf16x8(bf16_t* p, const float* v) { u32x4 o; o.x = pk2(v[0], v[1]); o.y = pk2(v[2], v[3]); o.z = pk2(v[4], v[5]); o.w = pk2(v[6], v[7]); *(u32x4*)p = o; }
__device__ __forceinline__ void store_f32x8(float* p, const float* v) { ((f32x4*)p)[0] = (f32x4){v[0], v[1], v[2], v[3]}; ((f32x4*)p)[1] = (f32x4){v[4], v[5], v[6], v[7]}; }
__device__ __forceinline__ void load_bf16x8(const bf16_t* p, float* v) { const u32x4 w = *(const u32x4*)p;
    v[0] = bf2f(w.x & 0xffffu); v[1] = bf2f(w.x >> 16); v[2] = bf2f(w.y & 0xffffu); v[3] = bf2f(w.y >> 16); v[4] = bf2f(w.z & 0xffffu); v[5] = bf2f(w.z >> 16); v[6] = bf2f(w.w & 0xffffu); v[7] = bf2f(w.w >> 16); }

__device__ __forceinline__ void phase_inproj(const Params& P, unsigned char* lds) {
    float* red = (float*)lds; unsigned char* ws = P.ws;
    const bf16_t* XN = (const bf16_t*)(ws + WS_XN); const bf16_t* WT = (const bf16_t*)(ws + WS_WIN_T); bf16_t* PROJ = (bf16_t*)(ws + WS_PROJ);
    const float* bias = P.in[14]; float* out = P.out;
    constexpr int NU_IN = (MT / 64) * (NIN / 64), NU_MEM = 8 * 16;
    for (int u = blockIdx.x; u < NU_IN + NU_MEM; u += gridDim.x) {
        if (u < NU_IN) {
            const int tr = u % (MT / 64), tc = u / (MT / 64);
            sgemm_unit(XN, D, WT, D, D, tr * 64, tc * 64, red, [&](int row, int col, float* v) {
#pragma unroll
                for (int e = 0; e < 8; ++e) v[e] += bias[col + e];
                store_bf16x8(PROJ + (size_t)row * NIN + col, v);
                if (col >= C_K && col < C_HQ) {
                    const int kv = col - C_K, which = kv / 1536, rem = kv % 1536, g = rem >> 9, hd = rem & 511;
                    const int W = g == 0 ? 128 : (g == 1 ? 512 : 2048);
                    if (row < MP) { const int b = row >> 13, t = row & 8191;
                        if (t >= SEQ - W) { float* pw = out + (g == 0 ? O_PW1 : (g == 1 ? O_PW2 : O_PW3)); store_f32x8(pw + (((size_t)b * W + (t - (SEQ - W))) * 2 + which) * 512 + hd, v); } }
                    else { const int sb = (row - MP) >> 3, st = (row - MP) & 7; float* sw = out + (g == 0 ? O_SW1 : (g == 1 ? O_SW2 : O_SW3));
                        store_f32x8(sw + (((size_t)sb * W + (W - 8 + st)) * 2 + which) * 512 + hd, v); }
                }
            });
        } else {
            const int q = u - NU_IN, tr = q % 8, tc = q / 8;
            bf16_t* MEMKV = (bf16_t*)(ws + WS_MEMKV);
            sgemm_unit((const bf16_t*)(ws + WS_MEMN), D, (const bf16_t*)(ws + WS_WMEM_T), D, D, tr * 64, tc * 64, red, [&](int row, int col, float* v) {
                store_f32x8(out + O_PMEM + (size_t)row * 1024 + col, v); store_bf16x8(MEMKV + (size_t)row * 1024 + col, v); });
        }
    }
}

struct AttnUnit {
    const bf16_t* q; long q_rs; const bf16_t* k; long k_rs; const bf16_t* v; long v_rs; int k_valid_from;
    bf16_t* o; long o_rs; float* lse; long lse_rs; const float* bias;
};
__device__ __forceinline__ void attn_unit(const AttnUnit& U, unsigned char* lds) {
    bf16_t* Ks = (bf16_t*)lds;
    bf16_t* Vt = (bf16_t*)(lds + 69632);
    float* btab = (float*)(lds + 69632 + 67584);
    const int tid = threadIdx.x, lane = tid & 63, wave = tid >> 6, fr = lane & 15, fq = lane >> 4;
    __syncthreads();
#pragma unroll
    for (int it = 0; it < 8; ++it) { const int idx = tid + NTHR * it, j = idx >> 4, c = idx & 15;
        u32x4 kv = (u32x4){0u, 0u, 0u, 0u}, vv = (u32x4){0u, 0u, 0u, 0u};
        if (j >= U.k_valid_from) { kv = *(const u32x4*)(U.k + (long)j * U.k_rs + c * 8); vv = *(const u32x4*)(U.v + (long)j * U.v_rs + c * 8); }
        *(u32x4*)(Ks + j * 136 + c * 8) = kv;
        bf16_t* vt = Vt + (c * 8) * 264 + j;
        vt[0 * 264] = (bf16_t)(vv.x & 0xffffu); vt[1 * 264] = (bf16_t)(vv.x >> 16); vt[2 * 264] = (bf16_t)(vv.y & 0xffffu); vt[3 * 264] = (bf16_t)(vv.y >> 16);
        vt[4 * 264] = (bf16_t)(vv.z & 0xffffu); vt[5 * 264] = (bf16_t)(vv.z >> 16); vt[6 * 264] = (bf16_t)(vv.w & 0xffffu); vt[7 * 264] = (bf16_t)(vv.w >> 16); }
    if (U.bias && tid < 129) btab[tid] = U.bias[tid];
    bf16x8 qa[4];
    { const bf16_t* qp = U.q + (long)(wave * 16 + fr) * U.q_rs + fq * 8;
#pragma unroll
      for (int kk = 0; kk < 4; ++kk) qa[kk] = *(const bf16x8*)(qp + kk * 32); }
    __syncthreads();
    f32x4 s[16];
#pragma unroll
    for (int kb = 0; kb < 16; ++kb) { s[kb] = (f32x4){0.f, 0.f, 0.f, 0.f};
#pragma unroll
        for (int kk = 0; kk < 4; ++kk) { const bf16x8 kf = *(const bf16x8*)(Ks + (kb * 16 + fr) * 136 + kk * 32 + fq * 8); s[kb] = __builtin_amdgcn_mfma_f32_16x16x32_bf16(qa[kk], kf, s[kb], 0, 0, 0); } }
    const float scale = 0.08838834764831845f;
    float mx[4] = {-3.0e38f, -3.0e38f, -3.0e38f, -3.0e38f};
    const bool banded = U.bias != nullptr; const int vfrom = U.k_valid_from;
#pragma unroll
    for (int kb = 0; kb < 16; ++kb)
#pragma unroll
        for (int r = 0; r < 4; ++r) { float x = s[kb][r] * scale;
            if (banded) { const int qi = wave * 16 + 4 * fq + r, kj = kb * 16 + fr, lag = 128 + qi - kj; const bool ok = lag >= 0 && lag <= 128 && kj >= vfrom; x = ok ? x + btab[ok ? lag : 0] : -1.0e30f; }
            s[kb][r] = x; mx[r] = fmaxf(mx[r], x); }
#pragma unroll
    for (int r = 0; r < 4; ++r) { mx[r] = fmaxf(mx[r], __shfl_xor(mx[r], 1)); mx[r] = fmaxf(mx[r], __shfl_xor(mx[r], 2)); mx[r] = fmaxf(mx[r], __shfl_xor(mx[r], 4)); mx[r] = fmaxf(mx[r], __shfl_xor(mx[r], 8)); }
    float sum[4] = {0.f, 0.f, 0.f, 0.f};
#pragma unroll
    for (int kb = 0; kb < 16; ++kb)
#pragma unroll
        for (int r = 0; r < 4; ++r) { const float p = __expf(s[kb][r] - mx[r]); s[kb][r] = p; sum[r] += p; }
#pragma unroll
    for (int r = 0; r < 4; ++r) { sum[r] += __shfl_xor(sum[r], 1); sum[r] += __shfl_xor(sum[r], 2); sum[r] += __shfl_xor(sum[r], 4); sum[r] += __shfl_xor(sum[r], 8); }
    __syncthreads();
    bf16_t* Ps = Ks + wave * (16 * 264);
#pragma unroll
    for (int kb = 0; kb < 16; ++kb)
#pragma unroll
        for (int r = 0; r < 4; ++r) Ps[(4 * fq + r) * 264 + kb * 16 + fr] = (bf16_t)f2bf(s[kb][r]);
    LDS_WAIT();
    f32x4 o[8];
#pragma unroll
    for (int db = 0; db < 8; ++db) o[db] = (f32x4){0.f, 0.f, 0.f, 0.f};
#pragma unroll
    for (int ks = 0; ks < 8; ++ks) { const bf16x8 pf = *(const bf16x8*)(Ps + fr * 264 + ks * 32 + fq * 8);
#pragma unroll
        for (int db = 0; db < 8; ++db) { const bf16x8 vf = *(const bf16x8*)(Vt + (db * 16 + fr) * 264 + ks * 32 + fq * 8); o[db] = __builtin_amdgcn_mfma_f32_16x16x32_bf16(pf, vf, o[db], 0, 0, 0); } }
#pragma unroll
    for (int r = 0; r < 4; ++r) { const float inv = 1.0f / sum[r]; const int qi = wave * 16 + 4 * fq + r; bf16_t* op = U.o + (long)qi * U.o_rs + fr;
#pragma unroll
        for (int db = 0; db < 8; ++db) op[db * 16] = (bf16_t)f2bf(o[db][r] * inv);
        if (U.lse && fr == 0) U.lse[(long)qi * U.lse_rs] = mx[r] + __logf(sum[r]); }
}

template <class KeyPtr, class ValPtr>
__device__ __forceinline__ void sample_attn_item(const bf16_t* qrow0  , int nk, const float* biastab  , KeyPtr kptr, ValPtr vptr,
                                                 bf16_t* orow0, long o_rs, float* lse0, long lse_rs, unsigned char* lds) {
    float* qs = (float*)lds;
    float* ps = qs + 1024;
    float* st = ps + 8 * 260;
    const int tid = threadIdx.x, lane = tid & 63, wave = tid >> 6;
    __syncthreads();
    for (int idx = tid; idx < 1024; idx += NTHR) { const int t = idx >> 7, d = idx & 127; qs[idx] = bf2f(qrow0[(long)t * NIN + d]) * 0.08838834764831845f; }
    __syncthreads();
    for (int idx = tid; idx < 8 * nk; idx += NTHR) { const int t = idx / nk, j = idx - t * nk; const f32x4* kp = (const f32x4*)kptr(t, j); const f32x4* qp = (const f32x4*)(qs + t * 128);
        float acc = 0.f;
#pragma unroll 8
        for (int d = 0; d < 32; ++d) { const f32x4 a = kp[d], b = qp[d]; acc += (a.x * b.x + a.y * b.y) + (a.z * b.z + a.w * b.w); }
        ps[t * 260 + j] = acc + (biastab ? biastab[j] : 0.f); }
    __syncthreads();
    { const int t = wave; float m = -3.0e38f;
      for (int j = lane; j < nk; j += 64) m = fmaxf(m, ps[t * 260 + j]);
#pragma unroll
      for (int o = 1; o < 64; o <<= 1) m = fmaxf(m, __shfl_xor(m, o));
      float s = 0.f;
      for (int j = lane; j < nk; j += 64) { const float p = __expf(ps[t * 260 + j] - m); ps[t * 260 + j] = p; s += p; }
      s = wave_sum(s);
      if (lane == 0) { st[t] = 1.0f / s; if (lse0) lse0[(long)t * lse_rs] = m + __logf(s); } }
    __syncthreads();
    { const int t = wave; f32x2 acc = (f32x2){0.f, 0.f};
      for (int j = 0; j < nk; ++j) { const float p = ps[t * 260 + j]; const f32x2 vv = ((const f32x2*)vptr(t, j))[lane]; acc.x += p * vv.x; acc.y += p * vv.y; }
      const float inv = st[t];
      *(unsigned*)(orow0 + (long)t * o_rs + 2 * lane) = pk2(acc.x * inv, acc.y * inv); }
}

__device__ __forceinline__ void sample_hgrn_item(const Params& P, int sb, int h, unsigned char* lds) {
    float* fs = (float*)lds;
    float* ks = fs + 1024;
    float* qs = ks + 1024;
    float* is_ = qs + 1024;
    float* part = is_ + 1024;
    float* osq = part + 512;
    const int tid = threadIdx.x, lane = tid & 63, wave = tid >> 6;
    const bf16_t* PROJ = (const bf16_t*)(P.ws + WS_PROJ); const float* LB = (const float*)(P.ws + WS_TAB) + 3 * 4 * 132;
    __syncthreads();
    for (int idx = tid; idx < 1024; idx += NTHR) { const int t = idx >> 7, k = idx & 127; const bf16_t* pr = PROJ + (size_t)(MP + sb * 8 + t) * NIN + h * 128 + k;
        const float lb = LB[h * 128 + k]; const float f = lb + (1.0f - lb) * sigmoidf_(bf2f(pr[C_HF]));
        fs[idx] = f; ks[idx] = 1.0f - f; qs[idx] = bf2f(pr[C_HQ]); is_[idx] = bf2f(pr[C_HI]); }
    const int v = tid & 127, kq = tid >> 7;
    const float* s_in = P.in[7] + ((size_t)(sb * 4 + h) * 128) * 128; float* s_out = P.out + O_SHG + ((size_t)(sb * 4 + h) * 128) * 128;
    float S[32];
#pragma unroll
    for (int i = 0; i < 32; ++i) S[i] = s_in[(size_t)(kq * 32 + i) * 128 + v];
    __syncthreads();
    const float gain = P.in[15][v];
    for (int t = 0; t < 8; ++t) {
        const float iv = is_[t * 128 + v]; float po = 0.f;
#pragma unroll
        for (int i = 0; i < 32; ++i) { const int k = kq * 32 + i; S[i] = fs[t * 128 + k] * S[i] + ks[t * 128 + k] * iv; po += S[i] * qs[t * 128 + k]; }
        part[kq * 128 + v] = po;
        __syncthreads();
        if (tid < 128) { const float o = (part[v] + part[128 + v]) + (part[256 + v] + part[384 + v]);
            const float ss = wave_sum(o * o); if (lane == 0) osq[wave] = ss;
            part[v] = o; }
        __syncthreads();
        if (tid < 128) { const float o = part[v]; const float r = rsqrtf((osq[0] + osq[1]) * (1.0f / 128.0f) + EPS);
            const size_t row = (size_t)(MP + sb * 8 + t); const float gate = sigmoidf_(bf2f(PROJ[row * NIN + C_HG + h * 128 + v]));
            ((bf16_t*)(P.ws + WS_ABR))[((size_t)1 * MT + row) * 512 + h * 128 + v] = (bf16_t)f2bf(o * r * gain * gate); }
        __syncthreads();
    }
#pragma unroll
    for (int i = 0; i < 32; ++i) s_out[(size_t)(kq * 32 + i) * 128 + v] = S[i];
}

__device__ __forceinline__ void hgrn_local_unit(const Params& P, int bh, int c, unsigned char* lds) {
    float* Gs = (float*)lds;
    float* Qs = Gs + 8192;
    float* Kk = Qs + 8192;
    float* Vs = Kk + 8192;
    float* Sc = Vs + 8192;
    const int tid = threadIdx.x, lane = tid & 63;
    const int b = bh >> 2, h = bh & 3; const size_t row0 = (size_t)b * SEQ + (size_t)c * 64;
    const bf16_t* PROJ = (const bf16_t*)(P.ws + WS_PROJ); const float* LB = (const float*)(P.ws + WS_TAB) + 3 * 4 * 132;
    __syncthreads();
    for (int idx = tid; idx < 8192; idx += NTHR) { const int t = idx >> 7, k = idx & 127; const bf16_t* pr = PROJ + (row0 + t) * NIN + h * 128 + k;
        const float lb = LB[h * 128 + k]; const float f = lb + (1.0f - lb) * sigmoidf_(bf2f(pr[C_HF]));
        Gs[idx] = logf(f); Kk[idx] = 1.0f - f; Qs[idx] = bf2f(pr[C_HQ]); Vs[idx] = bf2f(pr[C_HI]); }
    __syncthreads();
    if (tid < 128) { float a = 0.f; for (int t = 0; t < 64; ++t) { a += Gs[t * 128 + tid]; Gs[t * 128 + tid] = a; } }
    __syncthreads();
    { bf16_t* HQT = (bf16_t*)(P.ws + WS_HQT);
      for (int idx = tid; idx < 8192; idx += NTHR) { const int t = idx >> 7, k = idx & 127; HQT[(row0 + t) * 512 + h * 128 + k] = (bf16_t)f2bf(Qs[idx] * __expf(Gs[idx])); }
      if (tid < 128) ((float*)(P.ws + WS_DC))[((size_t)bh * 128 + c) * 128 + tid] = __expf(Gs[63 * 128 + tid]); }
    { const int t = tid >> 3, sub = tid & 7;
      for (int s = sub; s < 64; s += 8) { float acc = 0.f;
          if (s <= t) { for (int kk = 0; kk < 128; ++kk) { const int k = (kk + lane) & 127; acc += Qs[t * 128 + k] * Kk[s * 128 + k] * __expf(Gs[t * 128 + k] - Gs[s * 128 + k]); } }
          Sc[t * 64 + s] = acc; } }
    __syncthreads();
    { const int t = tid >> 3, v0 = (tid & 7) * 16; f32x4 o[4];
#pragma unroll
      for (int i = 0; i < 4; ++i) o[i] = (f32x4){0.f, 0.f, 0.f, 0.f};
      for (int s = 0; s <= t; ++s) { const float p = Sc[t * 64 + s]; const f32x4* vp = (const f32x4*)(Vs + s * 128 + v0);
#pragma unroll
          for (int i = 0; i < 4; ++i) o[i] += p * vp[i]; }
      f32x4* op = (f32x4*)((float*)(P.ws + WS_OINTRA) + (row0 + t) * 512 + h * 128 + v0);
#pragma unroll
      for (int i = 0; i < 4; ++i) op[i] = o[i]; }
    for (int idx = tid; idx < 8192; idx += NTHR) { const int k = idx & 127; Kk[idx] = Kk[idx] * __expf(Gs[63 * 128 + k] - Gs[idx]); }
    __syncthreads();
    { const int k = tid >> 2, v0 = (tid & 3) * 32; f32x4 u[8];
#pragma unroll
      for (int i = 0; i < 8; ++i) u[i] = (f32x4){0.f, 0.f, 0.f, 0.f};
      for (int s = 0; s < 64; ++s) { const float kt = Kk[s * 128 + k]; const f32x4* vp = (const f32x4*)(Vs + s * 128 + v0);
#pragma unroll
          for (int i = 0; i < 8; ++i) u[i] += kt * vp[i]; }
      f32x4* up = (f32x4*)((float*)(P.ws + WS_U) + ((size_t)bh * 128 + c) * 16384 + k * 128 + v0);
#pragma unroll
      for (int i = 0; i < 8; ++i) up[i] = u[i]; }
}

__device__ __forceinline__ void phase_mix1(const Params& P, unsigned char* lds) {
    unsigned char* ws = P.ws; bf16_t* PROJ = (bf16_t*)(ws + WS_PROJ);
    const float* BT = (const float*)(ws + WS_TAB);
    constexpr int N_DIL = 3 * 2 * 4 * 64, N_MEM = 2 * 4 * 64, N_HL = 8 * 128, N_SA = 32 * 3 * 4, N_SM = 32 * 4, N_SH = 32 * 4;
    constexpr int NTOT = N_DIL + N_MEM + N_HL + N_SA + N_SM + N_SH;
    for (int it = blockIdx.x; it < NTOT; it += gridDim.x) {
        int r = it;
        if (r < N_DIL + N_MEM) {
            AttnUnit U;
            if (r < N_DIL) {
                const int g = r / 512, b = (r >> 8) & 1, h = (r >> 6) & 3, rb = r & 63;
                const int dil = g == 0 ? 1 : (g == 1 ? 4 : 16); const int nbper = 64 / dil; const int res = rb / nbper, n = rb % nbper;
                const long base = (long)b * SEQ + (long)n * 128 * dil + res; const long kbase = base - (long)128 * dil;
                U.q = PROJ + base * NIN + C_Q + g * 512 + h * 128; U.q_rs = (long)dil * NIN;
                U.k = PROJ + kbase * NIN + C_K + g * 512 + h * 128; U.k_rs = (long)dil * NIN; U.v = PROJ + kbase * NIN + C_V + g * 512 + h * 128; U.v_rs = (long)dil * NIN;
                U.k_valid_from = n == 0 ? 128 : 0;
                U.o = (bf16_t*)(ws + WS_ATTO) + ((long)g * MT + base) * 512 + h * 128; U.o_rs = (long)dil * 512;
                U.lse = (float*)(ws + WS_LSE) + ((long)g * MT + base) * 4 + h; U.lse_rs = (long)dil * 4; U.bias = BT + (g * 4 + h) * 132;
            } else {
                const int q = r - N_DIL; const int b = q >> 8, h = (q >> 6) & 3, n = q & 63; const long base = (long)b * SEQ + (long)n * 128;
                const bf16_t* MEMKV = (const bf16_t*)(ws + WS_MEMKV);
                U.q = PROJ + base * NIN + C_MQ + h * 128; U.q_rs = NIN; U.k = MEMKV + (long)b * 256 * 1024 + h * 128; U.k_rs = 1024; U.v = U.k + 512; U.v_rs = 1024; U.k_valid_from = 0;
                U.o = (bf16_t*)(ws + WS_ABR) + ((long)2 * MT + base) * 512 + h * 128; U.o_rs = 512; U.lse = nullptr; U.lse_rs = 0; U.bias = nullptr;
            }
            if (MIX1_SEL & 1) attn_unit(U, lds);
            continue; }
        r -= N_DIL + N_MEM;
        if (r < N_HL) { if (MIX1_SEL & 4) hgrn_local_unit(P, r >> 7, r & 127, lds); continue; }
        r -= N_HL;
        if (r < N_SA + N_SM) {
            int sb, g, h;
            if (r < N_SA) { sb = r / 12; g = (r / 4) % 3; h = r & 3; } else { const int q = r - N_SA; sb = q >> 2; g = 3; h = q & 3; }
            const int W = g == 0 ? 128 : (g == 1 ? 512 : (g == 2 ? 2048 : 256)), dil = g == 0 ? 1 : (g == 1 ? 4 : (g == 2 ? 16 : -1));
            const float* cache = (g == 0 ? P.in[3] : (g == 1 ? P.in[4] : (g == 2 ? P.in[5] : P.in[6]))) + (size_t)sb * W * 1024 + h * 128;
            const float* neu = P.out + (g == 0 ? O_SW1 : (g == 1 ? O_SW2 : O_SW3)) + ((size_t)sb * W + (W - 8)) * 1024 + h * 128;
            const long row0 = MP + sb * 8;
            const int tq = g < 3 ? 1 : 0, base_idx = g < 3 ? W : 0;
            auto kp = [&](int t, int j) { const int idx = base_idx + tq * t - dil * j; return idx < W ? cache + (size_t)idx * 1024 : neu + (size_t)(idx - W) * 1024; };
            bf16_t* op = g < 3 ? (bf16_t*)(ws + WS_ATTO) + ((long)g * MT + row0) * 512 + h * 128 : (bf16_t*)(ws + WS_ABR) + ((long)2 * MT + row0) * 512 + h * 128;
            if (MIX1_SEL & 8) sample_attn_item(PROJ + row0 * NIN + (g < 3 ? C_Q + g * 512 : C_MQ) + h * 128, g < 3 ? 129 : 256, g < 3 ? BT + (g * 4 + h) * 132 : nullptr,
                kp, [&](int t, int j) { return kp(t, j) + 512; }, op, 512, g < 3 ? (float*)(ws + WS_LSE) + ((long)g * MT + row0) * 4 + h : nullptr, 4, lds);
            continue; }
        r -= N_SA;
        r -= N_SM;
        if (MIX1_SEL & 32) sample_hgrn_item(P, r >> 2, r & 3, lds);
    }
}

__device__ __forceinline__ void phase_scan(const Params& P) {
    const float* U = (const float*)(P.ws + WS_U); const float* DC = (const float*)(P.ws + WS_DC); float* S0 = (float*)(P.ws + WS_S0);
    for (int e = blockIdx.x * NTHR + threadIdx.x; e < 8 * 16384; e += gridDim.x * NTHR) {
        const int bh = e >> 14, kv = e & 16383, k = kv >> 7; float S = 0.f;
        for (int c = 0; c < 128; ++c) { const size_t o = ((size_t)bh * 128 + c) * 16384 + kv; S0[o] = S; S = DC[((size_t)bh * 128 + c) * 128 + k] * S + U[o]; }
        P.out[O_PHG + (size_t)bh * 16384 + kv] = S;
    }
}

__device__ __forceinline__ void hgrn_final_unit(const Params& P, int bh, int c, unsigned char* lds) {
    float* Ss = (float*)lds;
    float* Qt = Ss + 16384;
    const int tid = threadIdx.x; const int b = bh >> 2, h = bh & 3; const size_t row0 = (size_t)b * SEQ + (size_t)c * 64;
    __syncthreads();
    { const f32x4* s4 = (const f32x4*)((const float*)(P.ws + WS_S0) + ((size_t)bh * 128 + c) * 16384);
      for (int idx = tid; idx < 4096; idx += NTHR) ((f32x4*)Ss)[idx] = s4[idx];
      const bf16_t* HQT = (const bf16_t*)(P.ws + WS_HQT);
      for (int idx = tid; idx < 1024; idx += NTHR) { const int t = idx >> 4, c8 = (idx & 15) * 8; float v[8]; load_bf16x8(HQT + (row0 + t) * 512 + h * 128 + c8, v);
#pragma unroll
          for (int e = 0; e < 8; ++e) Qt[t * 128 + c8 + e] = v[e]; } }
    __syncthreads();
    const int t = tid >> 3, v0 = (tid & 7) * 16; const size_t row = row0 + t;
    f32x4 o[4];
    { const f32x4* oi = (const f32x4*)((const float*)(P.ws + WS_OINTRA) + row * 512 + h * 128 + v0);
#pragma unroll
      for (int i = 0; i < 4; ++i) o[i] = oi[i]; }
    for (int k = 0; k < 128; ++k) { const float q = Qt[t * 128 + k]; const f32x4* sp = (const f32x4*)(Ss + k * 128 + v0);
#pragma unroll
        for (int i = 0; i < 4; ++i) o[i] += q * sp[i]; }
    float ss = 0.f;
#pragma unroll
    for (int i = 0; i < 4; ++i) ss += (o[i].x * o[i].x + o[i].y * o[i].y) + (o[i].z * o[i].z + o[i].w * o[i].w);
    ss += __shfl_xor(ss, 1); ss += __shfl_xor(ss, 2); ss += __shfl_xor(ss, 4);
    const float r = rsqrtf(ss * (1.0f / 128.0f) + EPS);
    const float* gain = P.in[15] + v0; const bf16_t* gp = (const bf16_t*)(P.ws + WS_PROJ) + row * NIN + C_HG + h * 128 + v0;
    float gt[16]; load_bf16x8(gp, gt); load_bf16x8(gp + 8, gt + 8);
    float res[16];
#pragma unroll
    for (int i = 0; i < 4; ++i) { res[4 * i + 0] = o[i].x * r * gain[4 * i + 0] * sigmoidf_(gt[4 * i + 0]); res[4 * i + 1] = o[i].y * r * gain[4 * i + 1] * sigmoidf_(gt[4 * i + 1]);
        res[4 * i + 2] = o[i].z * r * gain[4 * i + 2] * sigmoidf_(gt[4 * i + 2]); res[4 * i + 3] = o[i].w * r * gain[4 * i + 3] * sigmoidf_(gt[4 * i + 3]); }
    bf16_t* op = (bf16_t*)(P.ws + WS_ABR) + ((size_t)1 * MT + row) * 512 + h * 128 + v0;
    store_bf16x8(op, res); store_bf16x8(op + 8, res + 8);
}
__device__ __forceinline__ void phase_mix2(const Params& P, unsigned char* lds) {
    for (int it = blockIdx.x; it < 1024; it += gridDim.x) hgrn_final_unit(P, it >> 7, it & 127, lds);
    const int lane = threadIdx.x & 63, wave = threadIdx.x >> 6; const int gw = blockIdx.x * NWAVES + wave, NGW = gridDim.x * NWAVES;
    const bf16_t* ATTO = (const bf16_t*)(P.ws + WS_ATTO); const float* LSE = (const float*)(P.ws + WS_LSE); bf16_t* ABR = (bf16_t*)(P.ws + WS_ABR);
    for (int row = gw; row < MT; row += NGW) {
        const int h = lane >> 4; const float l0 = LSE[((size_t)0 * MT + row) * 4 + h], l1 = LSE[((size_t)1 * MT + row) * 4 + h], l2 = LSE[((size_t)2 * MT + row) * 4 + h];
        const float m = fmaxf(l0, fmaxf(l1, l2)); float w0 = __expf(l0 - m), w1 = __expf(l1 - m), w2 = __expf(l2 - m); const float inv = 1.0f / (w0 + w1 + w2); w0 *= inv; w1 *= inv; w2 *= inv;
        float a[8], b2[8], c2[8], o[8];
        load_bf16x8(ATTO + ((size_t)0 * MT + row) * 512 + lane * 8, a); load_bf16x8(ATTO + ((size_t)1 * MT + row) * 512 + lane * 8, b2); load_bf16x8(ATTO + ((size_t)2 * MT + row) * 512 + lane * 8, c2);
#pragma unroll
        for (int e = 0; e < 8; ++e) o[e] = w0 * a[e] + w1 * b2[e] + w2 * c2[e];
        store_bf16x8(ABR + (size_t)row * 512 + lane * 8, o);
    }
}

__device__ __forceinline__ void phase_branch(const Params& P, unsigned char* lds) {
    float* red = (float*)lds; unsigned char* ws = P.ws;
    const bf16_t* ABR = (const bf16_t*)(ws + WS_ABR); const bf16_t* WBR = (const bf16_t*)(ws + WS_WBR_T); const bf16_t* PROJ = (const bf16_t*)(ws + WS_PROJ); bf16_t* MERGED = (bf16_t*)(ws + WS_MERGED);
    constexpr int NU = (MT / 64) * 16;
    for (int u = blockIdx.x; u < NU; u += gridDim.x) {
        const int tr = u % (MT / 64), tc = u / (MT / 64);
        float msum[8] = {0.f, 0.f, 0.f, 0.f, 0.f, 0.f, 0.f, 0.f};
#pragma unroll
        for (int br = 0; br < 3; ++br) {
            sgemm_unit(ABR + (size_t)br * MT * 512, 512, WBR + (size_t)br * 1024 * 512, 512, 512, tr * 64, tc * 64, red, [&](int row, int col, float* v) {
                float g[8]; load_bf16x8(PROJ + (size_t)row * NIN + (br == 0 ? C_GA : (br == 1 ? C_GH : C_GM)) + col, g);
#pragma unroll
                for (int e = 0; e < 8; ++e) msum[e] += sigmoidf_(g[e]) * v[e];
                if (br == 2) store_bf16x8(MERGED + (size_t)row * 1024 + col, msum); });
        }
    }
}
__device__ __forceinline__ void phase_gemm_f32(const bf16_t* A, const bf16_t* Bt, int K, float* C, unsigned char* lds) {
    float* red = (float*)lds; constexpr int NU = (MT / 64) * 16;
    for (int u = blockIdx.x; u < NU; u += gridDim.x) { const int tr = u % (MT / 64), tc = u / (MT / 64);
        sgemm_unit(A, K, Bt, K, K, tr * 64, tc * 64, red, [&](int row, int col, float* v) { store_f32x8(C + (size_t)row * 1024 + col, v); }); }
}
__device__ __forceinline__ void phase_ffn_up(const Params& P, unsigned char* lds) {
    float* red = (float*)lds; const bf16_t* XN = (const bf16_t*)(P.ws + WS_XN); const bf16_t* W = (const bf16_t*)(P.ws + WS_WAB_T); bf16_t* AB = (bf16_t*)(P.ws + WS_AB);
    constexpr int NU = (MT / 64) * 128;
    for (int u = blockIdx.x; u < NU; u += gridDim.x) { const int tr = u % (MT / 64), tc = u / (MT / 64);
        sgemm_unit(XN, D, W, D, D, tr * 64, tc * 64, red, [&](int row, int col, float* v) { store_bf16x8(AB + (size_t)row * 8192 + col, v); }); }
}
__device__ __forceinline__ void phase_mid_norm(const Params& P) {
    const int lane = threadIdx.x & 63, wave = threadIdx.x >> 6; const int gw = blockIdx.x * NWAVES + wave, NGW = gridDim.x * NWAVES;
    const float* MIX = (const float*)(P.ws + WS_MIX); bf16_t* XN = (bf16_t*)(P.ws + WS_XN);
    for (int row = gw; row < MT; row += NGW) {
        const float* xr = row < MP ? P.in[0] + (size_t)row * D : P.in[1] + (size_t)(row - MP) * D; float* yr = P.out + (size_t)row * D;
        f32x4 m[4], x[4]; float s = 0.f;
#pragma unroll
        for (int j = 0; j < 4; ++j) { m[j] = ((const f32x4*)(MIX + (size_t)row * D))[lane + 64 * j]; s += (m[j].x * m[j].x + m[j].y * m[j].y) + (m[j].z * m[j].z + m[j].w * m[j].w); }
        const float r = rsqrtf(wave_sum(s) * (1.0f / 1024.0f) + EPS); float s2 = 0.f;
#pragma unroll
        for (int j = 0; j < 4; ++j) { const f32x4 g = ((const f32x4*)P.in[12])[lane + 64 * j]; x[j] = ((const f32x4*)xr)[lane + 64 * j] + m[j] * r * g; ((f32x4*)yr)[lane + 64 * j] = x[j];
            s2 += (x[j].x * x[j].x + x[j].y * x[j].y) + (x[j].z * x[j].z + x[j].w * x[j].w); }
        const float r2 = rsqrtf(wave_sum(s2) * (1.0f / 1024.0f) + EPS);
#pragma unroll
        for (int j = 0; j < 4; ++j) { const f32x4 g = ((const f32x4*)P.in[22])[lane + 64 * j]; u32x2 o; o.x = pk2(x[j].x * r2 * g.x, x[j].y * r2 * g.y); o.y = pk2(x[j].z * r2 * g.z, x[j].w * r2 * g.w);
            ((u32x2*)(XN + (size_t)row * D))[lane + 64 * j] = o; }
    }
}
__device__ __forceinline__ void phase_ffn_gate(const Params& P) {
    const bf16_t* AB = (const bf16_t*)(P.ws + WS_AB); bf16_t* H = (bf16_t*)(P.ws + WS_H);
    const float* cw = P.in[26]; const float* cb = P.in[27]; const float* cbuf = P.in[8];
    for (size_t idx = (size_t)blockIdx.x * NTHR + threadIdx.x; idx < (size_t)MT * 512; idx += (size_t)gridDim.x * NTHR) {
        const int row = (int)(idx >> 9), n = (int)(idx & 511) * 8; const int cofs = (n >> 7) * 256 + (n & 127);
        float a[8], b[8], a1[8], a2[8];
        load_bf16x8(AB + (size_t)row * 8192 + cofs, a); load_bf16x8(AB + (size_t)row * 8192 + cofs + 128, b);
        if (row < MP) { const int t = row & 8191;
            if (t >= 1) load_bf16x8(AB + (size_t)(row - 1) * 8192 + cofs, a1); else { for (int e = 0; e < 8; ++e) a1[e] = 0.f; }
            if (t >= 2) load_bf16x8(AB + (size_t)(row - 2) * 8192 + cofs, a2); else { for (int e = 0; e < 8; ++e) a2[e] = 0.f; }
            if (t >= SEQ - 2) store_f32x8(P.out + O_PCONV + ((size_t)(row >> 13) * 2 + (t - (SEQ - 2))) * DFF + n, a);
        } else { const int sb = (row - MP) >> 3, st = (row - MP) & 7; const float* cbb = cbuf + (size_t)sb * 2 * DFF + n;
            if (st >= 1) load_bf16x8(AB + (size_t)(row - 1) * 8192 + cofs, a1); else { for (int e = 0; e < 8; ++e) a1[e] = cbb[DFF + e]; }
            if (st >= 2) load_bf16x8(AB + (size_t)(row - 2) * 8192 + cofs, a2); else { for (int e = 0; e < 8; ++e) a2[e] = cbb[(st == 0 ? 0 : DFF) + e]; }
            if (st >= 6) store_f32x8(P.out + O_SCONV + ((size_t)sb * 2 + (st - 6)) * DFF + n, a);
        }
        float o[8];
#pragma unroll
        for (int e = 0; e < 8; ++e) { const float c = cb[n + e] + a2[e] * cw[n + e] + a1[e] * cw[DFF + n + e] + a[e] * cw[2 * DFF + n + e]; o[e] = c * sigmoidf_(c) * b[e]; }
        store_bf16x8(H + (size_t)row * DFF + n, o);
    }
}
__device__ __forceinline__ void phase_final_norm(const Params& P) {
    const int lane = threadIdx.x & 63, wave = threadIdx.x >> 6; const int gw = blockIdx.x * NWAVES + wave, NGW = gridDim.x * NWAVES;
    const float* Fm = (const float*)(P.ws + WS_MIX);
    for (int row = gw; row < MT; row += NGW) {
        float* yr = P.out + (size_t)row * D; f32x4 m[4]; float s = 0.f;
#pragma unroll
        for (int j = 0; j < 4; ++j) { m[j] = ((const f32x4*)(Fm + (size_t)row * D))[lane + 64 * j]; s += (m[j].x * m[j].x + m[j].y * m[j].y) + (m[j].z * m[j].z + m[j].w * m[j].w); }
        const float r = rsqrtf(wave_sum(s) * (1.0f / 1024.0f) + EPS);
#pragma unroll
        for (int j = 0; j < 4; ++j) { const f32x4 g = ((const f32x4*)P.in[23])[lane + 64 * j]; ((f32x4*)yr)[lane + 64 * j] = ((const f32x4*)yr)[lane + 64 * j] + m[j] * r * g; }
    }
}

constexpr int NPHASE = 12;
__global__ void __launch_bounds__(NTHR, 2) mega_fwd(Params P) {
    extern __shared__ __attribute__((aligned(16))) unsigned char lds[];
    volatile unsigned* MISC = (volatile unsigned*)(lds + LDS_BYTES - 64);
    if (threadIdx.x < 16) MISC[threadIdx.x] = 0u;
    __syncthreads();
    XcdBarrier bar; bar.bar = (unsigned*)(P.ws + WS_CTL) + 4096; bar.x = 0; bar.st = nullptr;
    const bool multi = (P.ph_hi - P.ph_lo) > 1;
    if (multi) bar = xcd_barrier_post((unsigned*)(P.ws + WS_CTL) + 4096, MISC);
    const int lo = P.ph_lo, hi = P.ph_hi;
#define IN(k) (lo <= (k) && (k) < hi)
#define SEAM(k) do { if (IN(k) && IN((k) + 1)) xcd_barrier(bar); } while (0)
    if (IN(0)) phase_prep(P, lds);
    SEAM(0);
    if (IN(1)) phase_inproj(P, lds);
    SEAM(1);
    if (IN(2)) phase_mix1(P, lds);
    SEAM(2);
    if (IN(3)) phase_scan(P);
    SEAM(3);
    if (IN(4)) phase_mix2(P, lds);
    SEAM(4);
    if (IN(5)) phase_branch(P, lds);
    SEAM(5);
    if (IN(6)) phase_gemm_f32((const bf16_t*)(P.ws + WS_MERGED), (const bf16_t*)(P.ws + WS_WOUT_T), 1024, (float*)(P.ws + WS_MIX), lds);
    SEAM(6);
    if (IN(7)) phase_mid_norm(P);
    SEAM(7);
    if (IN(8)) phase_ffn_up(P, lds);
    SEAM(8);
    if (IN(9)) phase_ffn_gate(P);
    SEAM(9);
    if (IN(10)) phase_gemm_f32((const bf16_t*)(P.ws + WS_H), (const bf16_t*)(P.ws + WS_WD_T), 4096, (float*)(P.ws + WS_MIX), lds);
    SEAM(10);
    if (IN(11)) phase_final_norm(P);
#undef IN
#undef SEAM
}
}

extern "C" void kernel_launch(void* const* d_in, const int* in_sizes, int n_in, void* d_out, int out_size, void* d_ws, size_t ws_size, hipStream_t stream) {
    static int ready = 0;
    if (ready == 0) {
        if (n_in != 29 || (size_t)out_size != O_END || ws_size < WS_END) { fprintf(stderr, "kernel_launch: unexpected shapes (n_in %d out %d ws %zu)\n", n_in, out_size, ws_size); ready = -1; return; }
        if (hipFuncSetAttribute((const void*)mega_fwd, hipFuncAttributeMaxDynamicSharedMemorySize, LDS_BYTES) != hipSuccess) { fprintf(stderr, "kernel_launch: hipFuncSetAttribute failed\n"); ready = -1; return; }
        ready = 1;
    }
    if (ready < 0) return;
    (void)hipMemsetAsync((char*)d_ws + WS_CTL, 0, CTL_BYTES, stream);
    Params p{};
    for (int i = 0; i < 29; ++i) p.in[i] = (const float*)d_in[i];
    p.out = (float*)d_out; p.ws = (unsigned char*)d_ws;
#if MK_ONE_LAUNCH
    p.ph_lo = 0; p.ph_hi = NPHASE;
    hipLaunchKernelGGL(mega_fwd, dim3(256), dim3(NTHR), LDS_BYTES, stream, p);
#else
    for (int ph = 0; ph < NPHASE; ++ph) { p.ph_lo = ph; p.ph_hi = ph + 1; hipLaunchKernelGGL(mega_fwd, dim3(256), dim3(NTHR), LDS_BYTES, stream, p); }
#endif
}
```

```cpp
#include <hip/hip_runtime.h>
#include <cstdio>
#include <cstdint>

#ifndef MIX1_SEL
#define MIX1_SEL 63
#endif
#ifndef MK_ONE_LAUNCH
#define MK_ONE_LAUNCH 1
#endif

namespace {
typedef unsigned short bf16_t;
typedef short bf16x8 __attribute__((ext_vector_type(8)));
typedef float f32x4 __attribute__((ext_vector_type(4)));
typedef float f32x2 __attribute__((ext_vector_type(2)));
typedef unsigned u32x4 __attribute__((ext_vector_type(4)));
typedef unsigned u32x2 __attribute__((ext_vector_type(2)));

constexpr int NTHR = 512, NWAVES = 8;
constexpr int D = 1024, SEQ = 8192, NB = 2, MP = NB * SEQ, SBATCH = 32, STOK = 8, MS = SBATCH * STOK, MT = MP + MS;
constexpr int NIN = 10240, DFF = 4096;
constexpr int C_Q = 0, C_K = 1536, C_V = 3072, C_HQ = 4608, C_HF = 5120, C_HI = 5632, C_HG = 6144, C_MQ = 6656, C_GA = 7168, C_GH = 8192, C_GM = 9216;
constexpr float EPS = 1e-6f;

constexpr size_t O_YP = 0, O_YS = 16777216, O_PW1 = 17039360, O_PW2 = 17301504, O_PW3 = 18350080, O_PHG = 22544384, O_PCONV = 22675456, O_PMEM = 22691840,
                 O_SW1 = 23216128, O_SW2 = 27410432, O_SW3 = 44187648, O_SHG = 111296512, O_SCONV = 113393664, O_END = 113655808;

constexpr size_t MiB = 1u << 20;
constexpr size_t WS_CTL = 0, CTL_BYTES = 1 * MiB;
constexpr size_t WS_TAB = 1 * MiB;
constexpr size_t WS_WIN_T = 2 * MiB;
constexpr size_t WS_WMEM_T = 22 * MiB;
constexpr size_t WS_WBR_T = 24 * MiB;
constexpr size_t WS_WOUT_T = 27 * MiB;
constexpr size_t WS_WAB_T = 29 * MiB;
constexpr size_t WS_WD_T = 45 * MiB;
constexpr size_t WS_XN = 54 * MiB;
constexpr size_t WS_MEMN = 87 * MiB;
constexpr size_t WS_MEMKV = 88 * MiB;
constexpr size_t WS_PROJ = 90 * MiB;
constexpr size_t WS_ATTO = 416 * MiB;
constexpr size_t WS_LSE = 465 * MiB;
constexpr size_t WS_ABR = 466 * MiB;
constexpr size_t WS_HQT = 515 * MiB;
constexpr size_t WS_OINTRA = 531 * MiB;
constexpr size_t WS_U = 563 * MiB;
constexpr size_t WS_DC = 627 * MiB;
constexpr size_t WS_S0 = 628 * MiB;
constexpr size_t WS_MERGED = 692 * MiB;
constexpr size_t WS_MIX = 725 * MiB;
constexpr size_t WS_H = 790 * MiB;
constexpr size_t WS_AB = WS_PROJ;
constexpr size_t WS_END = 920 * MiB;

constexpr int LDS_BYTES = 155648;

struct Params { const float* in[29]; float* out; unsigned char* ws; int ph_lo, ph_hi; };

__device__ __forceinline__ unsigned f2bf(float f) { unsigned u = __float_as_uint(f); return (u + 0x7fffu + ((u >> 16) & 1u)) >> 16; }
__device__ __forceinline__ float bf2f(unsigned h) { return __uint_as_float(h << 16); }
__device__ __forceinline__ unsigned pk2(float lo, float hi) { return f2bf(lo) | (f2bf(hi) << 16); }
__device__ __forceinline__ float wave_sum(float v) {
#pragma unroll
    for (int o = 1; o < 64; o <<= 1) v += __shfl_xor(v, o);
    return v;
}
__device__ __forceinline__ float sigmoidf_(float x) { return 1.0f / (1.0f + __expf(-x)); }
#define LDS_WAIT() asm volatile("s_waitcnt lgkmcnt(0)" ::: "memory")

#define XB_TMO      128
#define XB_XCNT(j)  (256  + 64 * (j))
#define XB_XSUB(j)  (1280 + 64 * (j))
#define XB_XGEN(j)  (2304 + 64 * (j))
#define XB_TOP      3328
#define XB_TOPGEN   3392
#define XB_SPIN_CAP (1u << 22)
__device__ __forceinline__ unsigned xb_ld(unsigned* p)              { return __hip_atomic_load(p, __ATOMIC_RELAXED, __HIP_MEMORY_SCOPE_AGENT); }
__device__ __forceinline__ unsigned xb_add(unsigned* p, unsigned v) { return __hip_atomic_fetch_add(p, v, __ATOMIC_RELAXED, __HIP_MEMORY_SCOPE_AGENT); }
__device__ __forceinline__ unsigned xb_xcc_id() { return (unsigned)__builtin_amdgcn_s_getreg((3 << 11) | 20) & 0xFu; }
#define XB_SPIN(cond, bar) do { unsigned _sp = 0; while (cond) { __builtin_amdgcn_s_sleep(1); \
    if ((++_sp & 255u) == 0u) { if (xb_ld(&(bar)[XB_TMO])) break; if (_sp > XB_SPIN_CAP) { atomicAdd(&(bar)[XB_TMO], 1u); break; } } } } while (0)
struct XcdBarrier { unsigned* bar; unsigned x; volatile unsigned* st; };
__device__ __forceinline__ XcdBarrier xcd_barrier_post(unsigned* bar, volatile unsigned* st) {
    XcdBarrier b; b.bar = bar; b.x = xb_xcc_id(); b.st = st;
    if (threadIdx.x == 0) (void)xb_add(&bar[XB_XCNT(b.x)], 1u);
    return b;
}
__device__ __forceinline__ void xcd_barrier_complete(unsigned* bar, unsigned x, unsigned& nloc, unsigned& nx) {
    const unsigned G = gridDim.x;
    unsigned sum, cnt, mine, sp = 0u;
    for (;;) {
        sum = 0u; cnt = 0u; mine = 0u;
#pragma unroll
        for (unsigned j = 0; j < 16; ++j) { const unsigned c = xb_ld(&bar[XB_XCNT(j)]); sum += c; cnt += (c > 0u) ? 1u : 0u; mine = (j == x) ? c : mine; }
        if (sum == G) break;
        __builtin_amdgcn_s_sleep(1);
        if ((++sp & 255u) == 0u) { if (xb_ld(&bar[XB_TMO])) break; if (sp > XB_SPIN_CAP) { atomicAdd(&bar[XB_TMO], 1u); break; } }
    }
    nloc = mine > 0u ? mine : 1u; nx = cnt > 0u ? cnt : 1u;
}
__device__ __forceinline__ void xcd_barrier(const XcdBarrier& b) {
    asm volatile("s_waitcnt vmcnt(0)" ::: "memory");
    __syncthreads();
    if (threadIdx.x == 0) {
        unsigned* bar = b.bar;
        __builtin_amdgcn_s_waitcnt(0);
        unsigned nloc = b.st[0], nx = b.st[1];
        if (nloc == 0u) { xcd_barrier_complete(bar, b.x, nloc, nx); b.st[0] = nloc; b.st[1] = nx; }
        const unsigned old = xb_add(&bar[XB_XSUB(b.x)], 1u);
        const unsigned gen = old / nloc;
        if (old + 1u == (gen + 1u) * nloc) {
            __builtin_amdgcn_fence(__ATOMIC_RELEASE, "agent");
            asm volatile("s_waitcnt vmcnt(0)" ::: "memory");
            const unsigned og = xb_add(&bar[XB_TOP], 1u);
            const unsigned tg = og / nx;
            if (og + 1u == (tg + 1u) * nx) xb_add(&bar[XB_TOPGEN], 1u);
            else XB_SPIN(xb_ld(&bar[XB_TOPGEN]) == tg, bar);
            __builtin_amdgcn_fence(__ATOMIC_ACQUIRE, "agent");
            xb_add(&bar[XB_XGEN(b.x)], 1u);
            asm volatile("s_waitcnt vmcnt(0)" ::: "memory");
        } else {
            XB_SPIN(xb_ld(&bar[XB_XGEN(b.x)]) == gen, bar);
            __builtin_amdgcn_fence(__ATOMIC_ACQUIRE, "agent");
            asm volatile("s_waitcnt vmcnt(0)" ::: "memory");
        }
    }
    __syncthreads();
}

__device__ __forceinline__ int dest_row(int n, int kind, int row_off) { return kind == 0 ? row_off + n : ((n >> 7) * 256 + (n & 127) + (kind == 2 ? 128 : 0)); }
__device__ __forceinline__ void transpose_item(const float* __restrict__ W, int K, int N, bf16_t* __restrict__ WT, int kind, int row_off, float* scr, int item, int lane) {
    const int nblk = N / 32, kb = item / nblk, nb = item % nblk, k0 = 64 * kb, n0 = 32 * nb;
#pragma unroll 8
    for (int i = 0; i < 32; ++i) { const int kk = 2 * i + (lane >> 5); scr[kk * 33 + (lane & 31)] = W[(size_t)(k0 + kk) * N + n0 + (lane & 31)]; }
    LDS_WAIT();
    const int c = lane & 7;
#pragma unroll
    for (int j = 0; j < 4; ++j) { const int n = (lane >> 3) + 8 * j; const float* s = scr + (8 * c) * 33 + n;
        u32x4 o; o.x = pk2(s[0 * 33], s[1 * 33]); o.y = pk2(s[2 * 33], s[3 * 33]); o.z = pk2(s[4 * 33], s[5 * 33]); o.w = pk2(s[6 * 33], s[7 * 33]);
        *(u32x4*)(WT + (size_t)dest_row(n0 + n, kind, row_off) * K + k0 + 8 * c) = o; }
    LDS_WAIT();
}
__device__ __forceinline__ void rms_row_bf16(const float* __restrict__ xr, const float* __restrict__ gain, bf16_t* __restrict__ orow, int lane) {
    f32x4 v[4]; float s = 0.f;
#pragma unroll
    for (int j = 0; j < 4; ++j) { v[j] = ((const f32x4*)xr)[lane + 64 * j]; s += (v[j].x * v[j].x + v[j].y * v[j].y) + (v[j].z * v[j].z + v[j].w * v[j].w); }
    const float r = rsqrtf(wave_sum(s) * (1.0f / 1024.0f) + EPS);
#pragma unroll
    for (int j = 0; j < 4; ++j) { const f32x4 g = ((const f32x4*)gain)[lane + 64 * j];
        u32x2 o; o.x = pk2(v[j].x * r * g.x, v[j].y * r * g.y); o.y = pk2(v[j].z * r * g.z, v[j].w * r * g.w);
        ((u32x2*)orow)[lane + 64 * j] = o; }
}
__device__ __forceinline__ void phase_prep(const Params& P, unsigned char* lds) {
    const int tid = threadIdx.x, lane = tid & 63, wave = tid >> 6;
    const int gw = blockIdx.x * NWAVES + wave, NGW = gridDim.x * NWAVES;
    unsigned char* ws = P.ws;
    float* scr = (float*)lds + wave * (64 * 33);
    {
        constexpr int I_IN = 16 * 320, I_MEM = 16 * 32, I_BR = 8 * 32, I_OUT = 16 * 32, I_A = 16 * 128, I_D = 64 * 32;
        constexpr int NIT = I_IN + I_MEM + 3 * I_BR + I_OUT + 2 * I_A + I_D;
        for (int it = gw; it < NIT; it += NGW) {
            int r = it;
            if (r < I_IN) { transpose_item(P.in[13], 1024, NIN, (bf16_t*)(ws + WS_WIN_T), 0, 0, scr, r, lane); continue; } r -= I_IN;
            if (r < I_MEM) { transpose_item(P.in[17], 1024, 1024, (bf16_t*)(ws + WS_WMEM_T), 0, 0, scr, r, lane); continue; } r -= I_MEM;
            if (r < I_BR) { transpose_item(P.in[18], 512, 1024, (bf16_t*)(ws + WS_WBR_T), 0, 0, scr, r, lane); continue; } r -= I_BR;
            if (r < I_BR) { transpose_item(P.in[19], 512, 1024, (bf16_t*)(ws + WS_WBR_T), 0, 1024, scr, r, lane); continue; } r -= I_BR;
            if (r < I_BR) { transpose_item(P.in[20], 512, 1024, (bf16_t*)(ws + WS_WBR_T), 0, 2048, scr, r, lane); continue; } r -= I_BR;
            if (r < I_OUT) { transpose_item(P.in[21], 1024, 1024, (bf16_t*)(ws + WS_WOUT_T), 0, 0, scr, r, lane); continue; } r -= I_OUT;
            if (r < I_A) { transpose_item(P.in[24], 1024, DFF, (bf16_t*)(ws + WS_WAB_T), 1, 0, scr, r, lane); continue; } r -= I_A;
            if (r < I_A) { transpose_item(P.in[25], 1024, DFF, (bf16_t*)(ws + WS_WAB_T), 2, 0, scr, r, lane); continue; } r -= I_A;
            transpose_item(P.in[28], DFF, 1024, (bf16_t*)(ws + WS_WD_T), 0, 0, scr, r, lane);
        }
    }
    {
        bf16_t* XN = (bf16_t*)(ws + WS_XN); bf16_t* MEMN = (bf16_t*)(ws + WS_MEMN);
        for (int m = gw; m < MT + 512; m += NGW) {
            if (m < MP) rms_row_bf16(P.in[0] + (size_t)m * D, P.in[11], XN + (size_t)m * D, lane);
            else if (m < MT) rms_row_bf16(P.in[1] + (size_t)(m - MP) * D, P.in[11], XN + (size_t)m * D, lane);
            else rms_row_bf16(P.in[2] + (size_t)(m - MT) * D, P.in[16], MEMN + (size_t)(m - MT) * D, lane);
        }
    }
    {
        constexpr int R1 = 32 * 120, R2 = 32 * 504, R3 = 32 * 2040;
        for (int r = gw; r < R1 + R2 + R3; r += NGW) {
            int q = r, W; const float* src; float* dst;
            if (q < R1) { W = 128; src = P.in[3]; dst = P.out + O_SW1; }
            else if (q < R1 + R2) { q -= R1; W = 512; src = P.in[4]; dst = P.out + O_SW2; }
            else { q -= R1 + R2; W = 2048; src = P.in[5]; dst = P.out + O_SW3; }
            const int b = q / (W - 8), i = q % (W - 8);
            const f32x4* s4 = (const f32x4*)(src + ((size_t)b * W + i + 8) * 1024); f32x4* d4 = (f32x4*)(dst + ((size_t)b * W + i) * 1024);
            f32x4 t0 = s4[lane], t1 = s4[lane + 64], t2 = s4[lane + 128], t3 = s4[lane + 192];
            d4[lane] = t0; d4[lane + 64] = t1; d4[lane + 128] = t2; d4[lane + 192] = t3;
        }
    }
    if (blockIdx.x == 0) {
        float* BT = (float*)(ws + WS_TAB); float* LB = BT + 3 * 4 * 132;
        const float* rel_bias = P.in[9];
        for (int e = tid; e < 3 * 4 * 129; e += NTHR) {
            const int g = e / (4 * 129), h = (e / 129) % 4, j = e % 129;
            const int dil = g == 0 ? 1 : (g == 1 ? 4 : 16);
            const int dist = j * dil; int bucket;
            if (dist < 16) bucket = dist;
            else { const float d = (float)dist; int large = 16 + (int)(logf(d / 16.0f) / logf(128.0f) * 16.0f); bucket = large < 31 ? large : 31; }
            BT[(g * 4 + h) * 132 + j] = rel_bias[bucket * 12 + g * 4 + h];
        }
        for (int e = tid; e < 512; e += NTHR) { const float l0 = P.in[10][e], l1 = P.in[10][512 + e]; LB[e] = 1.0f / (1.0f + expf(l1 - l0)); }
    }
}

template <class Epi>
__device__ __forceinline__ void sgemm_unit(const bf16_t* __restrict__ A, int lda, const bf16_t* __restrict__ Bt, int ldb, int K, int row0, int col0, float* red, const Epi& epi) {
    const int tid = threadIdx.x, lane = tid & 63, wave = tid >> 6, kq = wave >> 1, ch = wave & 1, fr = lane & 15, fq = lane >> 4;
    f32x4 acc[4][2];
#pragma unroll
    for (int i = 0; i < 4; ++i)
#pragma unroll
        for (int j = 0; j < 2; ++j) acc[i][j] = (f32x4){0.f, 0.f, 0.f, 0.f};
    const int kbeg = kq * (K >> 2), kend = kbeg + (K >> 2);
    const bf16_t* ap = A + (size_t)(row0 + fr) * lda + fq * 8;
    const bf16_t* bp = Bt + (size_t)(col0 + ch * 32 + fr) * ldb + fq * 8;
#pragma unroll 2
    for (int k = kbeg; k < kend; k += 32) {
        bf16x8 a[4], b[2];
#pragma unroll
        for (int i = 0; i < 4; ++i) a[i] = *(const bf16x8*)(ap + (size_t)i * 16 * lda + k);
#pragma unroll
        for (int j = 0; j < 2; ++j) b[j] = *(const bf16x8*)(bp + (size_t)j * 16 * ldb + k);
#pragma unroll
        for (int i = 0; i < 4; ++i)
#pragma unroll
            for (int j = 0; j < 2; ++j) acc[i][j] = __builtin_amdgcn_mfma_f32_16x16x32_bf16(a[i], b[j], acc[i][j], 0, 0, 0);
    }
    __syncthreads();
#pragma unroll
    for (int i = 0; i < 4; ++i)
#pragma unroll
        for (int j = 0; j < 2; ++j)
#pragma unroll
            for (int r = 0; r < 4; ++r) red[(kq * 64 + i * 16 + 4 * fq + r) * 65 + ch * 32 + j * 16 + fr] = acc[i][j][r];
    __syncthreads();
    const int row = tid >> 3, c8 = (tid & 7) * 8;
    float v[8];
#pragma unroll
    for (int e = 0; e < 8; ++e) v[e] = (red[(0 * 64 + row) * 65 + c8 + e] + red[(1 * 64 + row) * 65 + c8 + e]) + (red[(2 * 64 + row) * 65 + c8 + e] + red[(3 * 64 + row) * 65 + c8 + e]);
    epi(row0 + row, col0 + c8, v);
}
__device__ __forceinline__ void store_bf16x8(bf16_t* p, const float* v) { u32x4 o; o.x = pk2(v[0], v[1]); o.y = pk2(v[2], v[3]); o.z = pk2(v[4], v[5]); o.w = pk2(v[6], v[7]); *(u32x4*)p = o; }
__device__ __forceinline__ void store_f32x8(float* p, const float* v) { ((f32x4*)p)[0] = (f32x4){v[0], v[1], v[2], v[3]}; ((f32x4*)p)[1] = (f32x4){v[4], v[5], v[6], v[7]}; }
__device__ __forceinline__ void load_bf16x8(const bf16_t* p, float* v) { const u32x4 w = *(const u32x4*)p;
    v[0] = bf2f(w.x & 0xffffu); v[1] = bf2f(w.x >> 16); v[2] = bf2f(w.y & 0xffffu); v[3] = bf2f(w.y >> 16); v[4] = bf2f(w.z & 0xffffu); v[5] = bf2f(w.z >> 16); v[6] = bf2f(w.w & 0xffffu); v[7] = bf2f(w.w >> 16); }

}
namespace pg8 {
#define PG8_LAS __attribute__((address_space(3)))
typedef unsigned short bf16_t;
typedef short bf16x8 __attribute__((ext_vector_type(8)));
typedef float f32x4 __attribute__((ext_vector_type(4)));
typedef unsigned u32x4 __attribute__((ext_vector_type(4)));
constexpr int BM = 256, BK = 64, HALF = 128, HTB = HALF * BK * 2  , STAGE_BYTES = 8 * HTB, NXCD = 8, WGM = 8;

__host__ __device__ __forceinline__ int lds_byte(int r, int c) { const int st = (r >> 4) * 2 + (c >> 5), rr = r & 15, cc = c & 31, ob = rr * 64 + cc * 2; return st * 1024 + (ob ^ (((ob >> 9) & 1) << 5)); }
__host__ __device__ __forceinline__ void stage_rc(int b, int& R, int& C) { const int st = b / 1024, sb = b % 1024, swz = sb ^ (((sb >> 9) & 1) << 5); R = (st >> 1) * 16 + swz / 64; C = (st & 1) * 32 + (swz % 64) / 2; }
__host__ __device__ __forceinline__ int perm32(int rho) { const int n = rho >> 4, i = rho & 15; return 8 * (i >> 2) + 4 * n + (i & 3); }

struct Unit { int pm, pn; };
struct Gemm { const bf16_t* A; const bf16_t* Bt; int M, N, K; };

struct StaticOrder {
    int nM, nN, nwg, G, c;
    __host__ __device__ void init(int M, int N, int G_, int c_) { nM = M / BM; nN = N / BM; nwg = nM * nN; G = G_; c = c_; }
    __host__ __device__ bool next(int i, Unit& u) const {
        const long L = (long)i * G + c; if (L >= nwg) return false;
        int wgid = (int)L; { const int q = nwg / NXCD, r = nwg % NXCD, xcd = wgid % NXCD, off = wgid / NXCD; wgid = (xcd < r ? xcd * (q + 1) : r * (q + 1) + (xcd - r) * q) + off; }
        const int nig = WGM * nN, gid = wgid / nig, fm = gid * WGM, gsz = (nM - fm) < WGM ? (nM - fm) : WGM;
        u.pm = fm + ((wgid % nig) % gsz); u.pn = (wgid % nig) / gsz; return true;
    }
    __device__ __forceinline__ void a_ready(const Unit&) const {}
    __device__ __forceinline__ void done(const Unit&) const {}
};
__device__ __forceinline__ unsigned cvt_pk_bf16(float lo, float hi) { unsigned r; asm volatile("v_cvt_pk_bf16_f32 %0, %1, %2" : "=v"(r) : "v"(lo), "v"(hi)); return r; }
typedef float f32x2 __attribute__((ext_vector_type(2)));

template <class F> struct Epi8 {
    static constexpr bool PERM = true, AFTER_DRAIN = false; F f;
    __device__ __forceinline__ bool keep(const Unit&) const { return false; }
    __device__ __forceinline__ void operator()(f32x4 (&acc)[2][2][4][2], const Unit& u, int wr, int wc, int fr, int fq) const {
        const int row0 = u.pm * BM + wr * 64 + fr, col0 = u.pn * BM + wc * 32 + 8 * fq;
#pragma unroll
        for (int ai = 0; ai < 2; ++ai)
#pragma unroll
            for (int m = 0; m < 4; ++m)
#pragma unroll
                for (int bj = 0; bj < 2; ++bj) { const f32x4 a = acc[ai][bj][m][0], b = acc[ai][bj][m][1]; float v[8] = {a[0], a[1], a[2], a[3], b[0], b[1], b[2], b[3]};
                    f(row0 + ai * HALF + m * 16, col0 + bj * HALF, v); }
    }
};
template <class F> struct Epi4 {
    static constexpr bool PERM = false, AFTER_DRAIN = false; F f;
    __device__ __forceinline__ bool keep(const Unit&) const { return false; }
    __device__ __forceinline__ void operator()(f32x4 (&acc)[2][2][4][2], const Unit& u, int wr, int wc, int fr, int fq) const {
        const int row0 = u.pm * BM + wr * 64 + fr, col0 = u.pn * BM + wc * 32 + 4 * fq;
#pragma unroll
        for (int ai = 0; ai < 2; ++ai)
#pragma unroll
            for (int m = 0; m < 4; ++m)
#pragma unroll
                for (int bj = 0; bj < 2; ++bj)
#pragma unroll
                    for (int n = 0; n < 2; ++n) f(row0 + ai * HALF + m * 16, col0 + bj * HALF + n * 16, acc[ai][bj][m][n]);
    }
};
template <class Epi, class Sched, bool ALIGN_EPI = false, bool SP2 = false>
__device__ __forceinline__ void gemm_phase(PG8_LAS unsigned char* lds, const Gemm g, const Sched& S, const Epi& E) {
    const int tid = threadIdx.x, wid = __builtin_amdgcn_readfirstlane(tid >> 6), lane = tid & 63, wr = wid >> 2, wc = wid & 3, fr = lane & 15, fq = lane >> 4;
    const int K = g.K, nt = K / BK;
    unsigned voffA[2], voffB[2];
#pragma unroll
    for (int i = 0; i < 2; ++i) { int R, C; stage_rc(tid * 16 + i * 8192, R, C); const int Rb = Epi::PERM ? ((R & ~31) + perm32(R & 31)) : R;
        voffA[i] = (unsigned)(R * K + C) * 2u; voffB[i] = (unsigned)(Rb * K + C) * 2u; }
    const size_t kstep = (size_t)(BK * 2);
    const size_t hstep = (size_t)HALF * K * 2;
    const size_t tstep = 2 * hstep;
    const unsigned ldsw = (unsigned)wid * 1024u;
    const int aoff = lds_byte(wr * 64 + fr, fq * 8), boff = lds_byte(wc * 32 + fr, fq * 8);
#define PG8_SA(b, h) (((b) * 2 + (h)) * HTB)
#define PG8_SB(b, h) ((4 + (b) * 2 + (h)) * HTB)
#define PG8_STAGE(bufoff, gbase, voff) do { _Pragma("unroll") for (int _i = 0; _i < 2; ++_i) \
        __builtin_amdgcn_global_load_lds((const unsigned*)((const char*)(gbase) + (voff)[_i]), (PG8_LAS unsigned*)(lds + (bufoff) + ldsw + _i * 8192), 16, 0, 0); } while (0)
#define PG8_LDA(dst, b, h) do { _Pragma("unroll") for (int m = 0; m < 4; ++m) _Pragma("unroll") for (int k = 0; k < 2; ++k) dst[m][k] = *(const PG8_LAS bf16x8*)(lds + PG8_SA(b, h) + aoff + m * 2048 + k * 1024); } while (0)
#define PG8_LDB(dst, b, h) do { _Pragma("unroll") for (int n = 0; n < 2; ++n) _Pragma("unroll") for (int k = 0; k < 2; ++k) dst[n][k] = *(const PG8_LAS bf16x8*)(lds + PG8_SB(b, h) + boff + n * 2048 + k * 1024); } while (0)
#define PG8_MMA(ai, bj, At, Bt) do { __builtin_amdgcn_s_setprio(1); _Pragma("unroll") for (int m = 0; m < 4; ++m) _Pragma("unroll") for (int n = 0; n < 2; ++n) _Pragma("unroll") for (int k = 0; k < 2; ++k) \
        acc[ai][bj][m][n] = __builtin_amdgcn_mfma_f32_16x16x32_bf16(Bt[n][k], At[m][k], acc[ai][bj][m][n], 0, 0, 0); __builtin_amdgcn_s_setprio(0); } while (0)
#define PG8_WAIT_V(n) asm volatile("s_waitcnt vmcnt(" #n ")" ::: "memory")
#define PG8_WAIT_L(n) asm volatile("s_waitcnt lgkmcnt(" #n ")" ::: "memory")
#define PG8_BAR __builtin_amdgcn_s_barrier()
#define PG8_SCHED __builtin_amdgcn_sched_barrier(0)
    Unit cur, nxt; int ui = 0;
    if (!S.next(0, cur)) return;
    f32x4 acc[2][2][4][2];
#pragma unroll
    for (int a = 0; a < 2; ++a)
#pragma unroll
        for (int b = 0; b < 2; ++b)
#pragma unroll
            for (int m = 0; m < 4; ++m)
#pragma unroll
                for (int n = 0; n < 2; ++n) acc[a][b][m][n] = (f32x4){0.f, 0.f, 0.f, 0.f};
    bf16x8 At[4][2], B0[2][2], B1[2][2];
    const char* cA = (const char*)g.A + (size_t)cur.pm * tstep; const char* cB = (const char*)g.Bt + (size_t)cur.pn * tstep;
    S.a_ready(cur);
    if constexpr (SP2) {
        PG8_STAGE(PG8_SB(0, 0), cB, voffB); PG8_STAGE(PG8_SB(0, 1), cB + hstep, voffB); PG8_STAGE(PG8_SA(0, 0), cA, voffA); PG8_STAGE(PG8_SA(0, 1), cA + hstep, voffA);
        if (wr == 1) PG8_BAR;
        PG8_WAIT_V(2); PG8_BAR;
        PG8_STAGE(PG8_SB(1, 0), cB + kstep, voffB); PG8_STAGE(PG8_SA(1, 0), cA + kstep, voffA); PG8_STAGE(PG8_SB(1, 1), cB + hstep + kstep, voffB);
        PG8_WAIT_V(6); PG8_BAR;
    } else {
        PG8_STAGE(PG8_SB(0, 0), cB, voffB); PG8_STAGE(PG8_SA(0, 0), cA, voffA); PG8_STAGE(PG8_SB(0, 1), cB + hstep, voffB); PG8_STAGE(PG8_SA(0, 1), cA + hstep, voffA);
        if (wr == 1) PG8_BAR;
        PG8_WAIT_V(4); PG8_BAR;
        PG8_STAGE(PG8_SB(1, 0), cB + kstep, voffB); PG8_STAGE(PG8_SA(1, 0), cA + kstep, voffA); PG8_STAGE(PG8_SB(1, 1), cB + hstep + kstep, voffB);
        PG8_WAIT_V(6); PG8_BAR;
    }
    for (;;) {
        const bool has_next = S.next(ui + 1, nxt);
        const char* nA = has_next ? (const char*)g.A + (size_t)nxt.pm * tstep : cA; const char* nB = has_next ? (const char*)g.Bt + (size_t)nxt.pn * tstep : cB;
        for (int t = 0; t < nt; t += 2) {
            const bool last = (t == nt - 2);
            const char* a1 = cA + (size_t)(t + 1) * kstep;
            const char* a2 = last ? nA : cA + (size_t)(t + 2) * kstep; const char* b2 = last ? nB : cB + (size_t)(t + 2) * kstep;
            const char* a3 = a2 + kstep; const char* b3 = b2 + kstep;
            if (last && has_next) S.a_ready(nxt);
            if constexpr (SP2) {
            PG8_LDB(B0, 0, 0); PG8_LDB(B1, 0, 1); PG8_SCHED; PG8_LDA(At, 0, 0); PG8_STAGE(PG8_SA(1, 1), a1 + hstep, voffA);
            PG8_WAIT_V(8); PG8_WAIT_L(0); PG8_BAR; PG8_MMA(0, 0, At, B0); PG8_MMA(0, 1, At, B1); PG8_BAR; PG8_SCHED;
            PG8_LDA(At, 0, 1); PG8_STAGE(PG8_SB(0, 0), b2, voffB); PG8_STAGE(PG8_SB(0, 1), b2 + hstep, voffB); PG8_STAGE(PG8_SA(0, 0), a2, voffA);
            PG8_WAIT_V(8); PG8_WAIT_L(0); PG8_BAR; PG8_MMA(1, 0, At, B0); PG8_MMA(1, 1, At, B1); PG8_BAR; PG8_SCHED;
            PG8_LDB(B0, 1, 0); PG8_LDB(B1, 1, 1); PG8_SCHED; PG8_LDA(At, 1, 0); PG8_STAGE(PG8_SA(0, 1), a2 + hstep, voffA);
            PG8_WAIT_V(8); PG8_WAIT_L(0); PG8_BAR; PG8_MMA(0, 0, At, B0); PG8_MMA(0, 1, At, B1); PG8_BAR; PG8_SCHED;
            PG8_LDA(At, 1, 1); PG8_STAGE(PG8_SB(1, 0), b3, voffB); PG8_STAGE(PG8_SB(1, 1), b3 + hstep, voffB); PG8_STAGE(PG8_SA(1, 0), a3, voffA);
            PG8_WAIT_V(8); PG8_WAIT_L(0); PG8_BAR; PG8_MMA(1, 0, At, B0); PG8_MMA(1, 1, At, B1); PG8_BAR; PG8_SCHED;
            } else {
            PG8_LDB(B0, 0, 0); PG8_SCHED; PG8_LDA(At, 0, 0); PG8_STAGE(PG8_SA(1, 1), a1 + hstep, voffA);
            PG8_WAIT_L(8); PG8_BAR; PG8_WAIT_L(0); PG8_MMA(0, 0, At, B0); PG8_BAR; PG8_SCHED;
            PG8_LDB(B1, 0, 1); PG8_STAGE(PG8_SB(0, 0), b2, voffB);
            PG8_BAR; PG8_WAIT_L(0); PG8_MMA(0, 1, At, B1); PG8_BAR;
            PG8_LDA(At, 0, 1); PG8_STAGE(PG8_SA(0, 0), a2, voffA);
            PG8_BAR; PG8_WAIT_L(0); PG8_MMA(1, 0, At, B0); PG8_BAR; PG8_SCHED;
            PG8_STAGE(PG8_SB(0, 1), b2 + hstep, voffB);
            PG8_WAIT_V(6); PG8_BAR; PG8_MMA(1, 1, At, B1); PG8_BAR;
            PG8_LDB(B0, 1, 0); PG8_SCHED; PG8_LDA(At, 1, 0); PG8_STAGE(PG8_SA(0, 1), a2 + hstep, voffA);
            PG8_WAIT_L(8); PG8_BAR; PG8_WAIT_L(0); PG8_MMA(0, 0, At, B0); PG8_BAR; PG8_SCHED;
            PG8_LDB(B1, 1, 1); PG8_STAGE(PG8_SB(1, 0), b3, voffB);
            PG8_BAR; PG8_WAIT_L(0); PG8_MMA(0, 1, At, B1); PG8_BAR;
            PG8_LDA(At, 1, 1); PG8_STAGE(PG8_SA(1, 0), a3, voffA);
            PG8_BAR; PG8_WAIT_L(0); PG8_MMA(1, 0, At, B0); PG8_BAR; PG8_SCHED;
            PG8_STAGE(PG8_SB(1, 1), b3 + hstep, voffB);
            PG8_WAIT_V(6); PG8_BAR; PG8_MMA(1, 1, At, B1); PG8_BAR;
            }
        }
        if constexpr (ALIGN_EPI) { if (wr == 0) PG8_BAR; }
        if constexpr (!Epi::AFTER_DRAIN) { E(acc, cur, wr, wc, fr, fq); S.done(cur); }
        if (!has_next) break;
        if (!E.keep(cur)) {
#pragma unroll
        for (int a = 0; a < 2; ++a)
#pragma unroll
            for (int b = 0; b < 2; ++b)
#pragma unroll
                for (int m = 0; m < 4; ++m)
#pragma unroll
                    for (int n = 0; n < 2; ++n) acc[a][b][m][n] = (f32x4){0.f, 0.f, 0.f, 0.f};
        }
        cur = nxt; cA = nA; cB = nB; ++ui;
        if constexpr (ALIGN_EPI) { if (wr == 1) PG8_BAR; }
    }
    PG8_WAIT_V(0);
    if constexpr (!ALIGN_EPI) { if (wr == 0) PG8_BAR; }
    PG8_BAR;
    if constexpr (Epi::AFTER_DRAIN) { E.fused(acc, cur, wr, wc, fr, fq, lds, wid, lane); S.done(cur); }
#undef PG8_SA
#undef PG8_SB
#undef PG8_STAGE
#undef PG8_LDA
#undef PG8_LDB
#undef PG8_MMA
#undef PG8_WAIT_V
#undef PG8_WAIT_L
#undef PG8_BAR
#undef PG8_SCHED
}
}

namespace {
struct InProjF {
    bf16_t* PROJ; const float* bias; float* out;
    __device__ __forceinline__ void operator()(int row, int col, float* v) const {
        const f32x4 b0 = *(const f32x4*)(bias + col), b1 = *(const f32x4*)(bias + col + 4);
        v[0] += b0[0]; v[1] += b0[1]; v[2] += b0[2]; v[3] += b0[3]; v[4] += b1[0]; v[5] += b1[1]; v[6] += b1[2]; v[7] += b1[3];
        store_bf16x8(PROJ + (size_t)row * NIN + col, v);
        if (col >= C_K && col < C_HQ) {
            const int kv = col - C_K, which = kv / 1536, rem = kv % 1536, g = rem >> 9, hd = rem & 511;
            const int W = g == 0 ? 128 : (g == 1 ? 512 : 2048);
            if (row < MP) { const int b = row >> 13, t = row & 8191;
                if (t >= SEQ - W) { float* pw = out + (g == 0 ? O_PW1 : (g == 1 ? O_PW2 : O_PW3)); store_f32x8(pw + (((size_t)b * W + (t - (SEQ - W))) * 2 + which) * 512 + hd, v); } }
            else { const int sb = (row - MP) >> 3, st = (row - MP) & 7; float* sw = out + (g == 0 ? O_SW1 : (g == 1 ? O_SW2 : O_SW3));
                store_f32x8(sw + (((size_t)sb * W + (W - 8 + st)) * 2 + which) * 512 + hd, v); }
        }
    }
};
__device__ __forceinline__ void phase_inproj(const Params& P, unsigned char* lds) {
    float* red = (float*)lds; unsigned char* ws = P.ws;
    const bf16_t* XN = (const bf16_t*)(ws + WS_XN); const bf16_t* WT = (const bf16_t*)(ws + WS_WIN_T);
    const InProjF f{(bf16_t*)(ws + WS_PROJ), P.in[14], P.out};
    {
        pg8::Gemm g{XN, WT, MP, NIN, D}; pg8::StaticOrder S; S.init(MP, NIN, (int)gridDim.x, (int)blockIdx.x);
        const pg8::Epi8<InProjF> E{f};
        pg8::gemm_phase<pg8::Epi8<InProjF>, pg8::StaticOrder, true, true>((PG8_LAS unsigned char*)lds, g, S, E);
    }
    constexpr int NU_S = 4 * (NIN / 64), NU_MEM = 8 * 16;
    for (int u = blockIdx.x; u < NU_S + NU_MEM; u += gridDim.x) {
        if (u < NU_S) { const int tr = 256 + (u & 3), tc = u >> 2; sgemm_unit(XN, D, WT, D, D, tr * 64, tc * 64, red, f); }
        else {
            const int q = u - NU_S, tr = q % 8, tc = q / 8;
            bf16_t* MEMKV = (bf16_t*)(ws + WS_MEMKV); float* out = P.out;
            sgemm_unit((const bf16_t*)(ws + WS_MEMN), D, (const bf16_t*)(ws + WS_WMEM_T), D, D, tr * 64, tc * 64, red, [&](int row, int col, float* v) {
                store_f32x8(out + O_PMEM + (size_t)row * 1024 + col, v); store_bf16x8(MEMKV + (size_t)row * 1024 + col, v); });
        }
    }
}

struct AttnUnit {
    const bf16_t* q; long q_rs; const bf16_t* k; long k_rs; const bf16_t* v; long v_rs; int k_valid_from;
    bf16_t* o; long o_rs; float* lse; long lse_rs; const float* bias;
};
__device__ __forceinline__ void attn_unit(const AttnUnit& U, unsigned char* lds) {
    bf16_t* Ks = (bf16_t*)lds;
    bf16_t* Vt = (bf16_t*)(lds + 69632);
    float* btab = (float*)(lds + 69632 + 67584);
    const int tid = threadIdx.x, lane = tid & 63, wave = tid >> 6, fr = lane & 15, fq = lane >> 4;
    __syncthreads();
#pragma unroll
    for (int it = 0; it < 8; ++it) { const int idx = tid + NTHR * it, j = idx >> 4, c = idx & 15;
        u32x4 kv = (u32x4){0u, 0u, 0u, 0u}, vv = (u32x4){0u, 0u, 0u, 0u};
        if (j >= U.k_valid_from) { kv = *(const u32x4*)(U.k + (long)j * U.k_rs + c * 8); vv = *(const u32x4*)(U.v + (long)j * U.v_rs + c * 8); }
        *(u32x4*)(Ks + j * 136 + c * 8) = kv;
        bf16_t* vt = Vt + (c * 8) * 264 + j;
        vt[0 * 264] = (bf16_t)(vv.x & 0xffffu); vt[1 * 264] = (bf16_t)(vv.x >> 16); vt[2 * 264] = (bf16_t)(vv.y & 0xffffu); vt[3 * 264] = (bf16_t)(vv.y >> 16);
        vt[4 * 264] = (bf16_t)(vv.z & 0xffffu); vt[5 * 264] = (bf16_t)(vv.z >> 16); vt[6 * 264] = (bf16_t)(vv.w & 0xffffu); vt[7 * 264] = (bf16_t)(vv.w >> 16); }
    if (U.bias && tid < 129) btab[tid] = U.bias[tid];
    bf16x8 qa[4];
    { const bf16_t* qp = U.q + (long)(wave * 16 + fr) * U.q_rs + fq * 8;
#pragma unroll
      for (int kk = 0; kk < 4; ++kk) qa[kk] = *(const bf16x8*)(qp + kk * 32); }
    __syncthreads();
    f32x4 s[16];
#pragma unroll
    for (int kb = 0; kb < 16; ++kb) { s[kb] = (f32x4){0.f, 0.f, 0.f, 0.f};
#pragma unroll
        for (int kk = 0; kk < 4; ++kk) { const bf16x8 kf = *(const bf16x8*)(Ks + (kb * 16 + fr) * 136 + kk * 32 + fq * 8); s[kb] = __builtin_amdgcn_mfma_f32_16x16x32_bf16(qa[kk], kf, s[kb], 0, 0, 0); } }
    const float scale = 0.08838834764831845f;
    float mx[4] = {-3.0e38f, -3.0e38f, -3.0e38f, -3.0e38f};
    const bool banded = U.bias != nullptr; const int vfrom = U.k_valid_from;
#pragma unroll
    for (int kb = 0; kb < 16; ++kb)
#pragma unroll
        for (int r = 0; r < 4; ++r) { float x = s[kb][r] * scale;
            if (banded) { const int qi = wave * 16 + 4 * fq + r, kj = kb * 16 + fr, lag = 128 + qi - kj; const bool ok = lag >= 0 && lag <= 128 && kj >= vfrom; x = ok ? x + btab[ok ? lag : 0] : -1.0e30f; }
            s[kb][r] = x; mx[r] = fmaxf(mx[r], x); }
#pragma unroll
    for (int r = 0; r < 4; ++r) { mx[r] = fmaxf(mx[r], __shfl_xor(mx[r], 1)); mx[r] = fmaxf(mx[r], __shfl_xor(mx[r], 2)); mx[r] = fmaxf(mx[r], __shfl_xor(mx[r], 4)); mx[r] = fmaxf(mx[r], __shfl_xor(mx[r], 8)); }
    float sum[4] = {0.f, 0.f, 0.f, 0.f};
#pragma unroll
    for (int kb = 0; kb < 16; ++kb)
#pragma unroll
        for (int r = 0; r < 4; ++r) { const float p = __expf(s[kb][r] - mx[r]); s[kb][r] = p; sum[r] += p; }
#pragma unroll
    for (int r = 0; r < 4; ++r) { sum[r] += __shfl_xor(sum[r], 1); sum[r] += __shfl_xor(sum[r], 2); sum[r] += __shfl_xor(sum[r], 4); sum[r] += __shfl_xor(sum[r], 8); }
    __syncthreads();
    bf16_t* Ps = Ks + wave * (16 * 264);
#pragma unroll
    for (int kb = 0; kb < 16; ++kb)
#pragma unroll
        for (int r = 0; r < 4; ++r) Ps[(4 * fq + r) * 264 + kb * 16 + fr] = (bf16_t)f2bf(s[kb][r]);
    LDS_WAIT();
    f32x4 o[8];
#pragma unroll
    for (int db = 0; db < 8; ++db) o[db] = (f32x4){0.f, 0.f, 0.f, 0.f};
#pragma unroll
    for (int ks = 0; ks < 8; ++ks) { const bf16x8 pf = *(const bf16x8*)(Ps + fr * 264 + ks * 32 + fq * 8);
#pragma unroll
        for (int db = 0; db < 8; ++db) { const bf16x8 vf = *(const bf16x8*)(Vt + (db * 16 + fr) * 264 + ks * 32 + fq * 8); o[db] = __builtin_amdgcn_mfma_f32_16x16x32_bf16(pf, vf, o[db], 0, 0, 0); } }
#pragma unroll
    for (int r = 0; r < 4; ++r) { const float inv = 1.0f / sum[r]; const int qi = wave * 16 + 4 * fq + r; bf16_t* op = U.o + (long)qi * U.o_rs + fr;
#pragma unroll
        for (int db = 0; db < 8; ++db) op[db * 16] = (bf16_t)f2bf(o[db][r] * inv);
        if (U.lse && fr == 0) U.lse[(long)qi * U.lse_rs] = mx[r] + __logf(sum[r]); }
}

template <class KeyPtr, class ValPtr>
__device__ __forceinline__ void sample_attn_item(const bf16_t* qrow0  , int nk, const float* biastab  , KeyPtr kptr, ValPtr vptr,
                                                 bf16_t* orow0, long o_rs, float* lse0, long lse_rs, unsigned char* lds) {
    float* qs = (float*)lds;
    float* ps = qs + 1024;
    float* st = ps + 8 * 260;
    const int tid = threadIdx.x, lane = tid & 63, wave = tid >> 6;
    __syncthreads();
    for (int idx = tid; idx < 1024; idx += NTHR) { const int t = idx >> 7, d = idx & 127; qs[idx] = bf2f(qrow0[(long)t * NIN + d]) * 0.08838834764831845f; }
    __syncthreads();
    for (int idx = tid; idx < 8 * nk; idx += NTHR) { const int t = idx / nk, j = idx - t * nk; const f32x4* kp = (const f32x4*)kptr(t, j); const f32x4* qp = (const f32x4*)(qs + t * 128);
        float acc = 0.f;
#pragma unroll 8
        for (int d = 0; d < 32; ++d) { const f32x4 a = kp[d], b = qp[d]; acc += (a.x * b.x + a.y * b.y) + (a.z * b.z + a.w * b.w); }
        ps[t * 260 + j] = acc + (biastab ? biastab[j] : 0.f); }
    __syncthreads();
    { const int t = wave; float m = -3.0e38f;
      for (int j = lane; j < nk; j += 64) m = fmaxf(m, ps[t * 260 + j]);
#pragma unroll
      for (int o = 1; o < 64; o <<= 1) m = fmaxf(m, __shfl_xor(m, o));
      float s = 0.f;
      for (int j = lane; j < nk; j += 64) { const float p = __expf(ps[t * 260 + j] - m); ps[t * 260 + j] = p; s += p; }
      s = wave_sum(s);
      if (lane == 0) { st[t] = 1.0f / s; if (lse0) lse0[(long)t * lse_rs] = m + __logf(s); } }
    __syncthreads();
    { const int t = wave; f32x2 acc = (f32x2){0.f, 0.f};
      for (int j = 0; j < nk; ++j) { const float p = ps[t * 260 + j]; const f32x2 vv = ((const f32x2*)vptr(t, j))[lane]; acc.x += p * vv.x; acc.y += p * vv.y; }
      const float inv = st[t];
      *(unsigned*)(orow0 + (long)t * o_rs + 2 * lane) = pk2(acc.x * inv, acc.y * inv); }
}

__device__ __forceinline__ void sample_hgrn_item(const Params& P, int sb, int h, unsigned char* lds) {
    float* fs = (float*)lds;
    float* ks = fs + 1024;
    float* qs = ks + 1024;
    float* is_ = qs + 1024;
    float* part = is_ + 1024;
    float* osq = part + 512;
    const int tid = threadIdx.x, lane = tid & 63, wave = tid >> 6;
    const bf16_t* PROJ = (const bf16_t*)(P.ws + WS_PROJ); const float* LB = (const float*)(P.ws + WS_TAB) + 3 * 4 * 132;
    __syncthreads();
    for (int idx = tid; idx < 1024; idx += NTHR) { const int t = idx >> 7, k = idx & 127; const bf16_t* pr = PROJ + (size_t)(MP + sb * 8 + t) * NIN + h * 128 + k;
        const float lb = LB[h * 128 + k]; const float f = lb + (1.0f - lb) * sigmoidf_(bf2f(pr[C_HF]));
        fs[idx] = f; ks[idx] = 1.0f - f; qs[idx] = bf2f(pr[C_HQ]); is_[idx] = bf2f(pr[C_HI]); }
    const int v = tid & 127, kq = tid >> 7;
    const float* s_in = P.in[7] + ((size_t)(sb * 4 + h) * 128) * 128; float* s_out = P.out + O_SHG + ((size_t)(sb * 4 + h) * 128) * 128;
    float S[32];
#pragma unroll
    for (int i = 0; i < 32; ++i) S[i] = s_in[(size_t)(kq * 32 + i) * 128 + v];
    __syncthreads();
    const float gain = P.in[15][v];
    for (int t = 0; t < 8; ++t) {
        const float iv = is_[t * 128 + v]; float po = 0.f;
#pragma unroll
        for (int i = 0; i < 32; ++i) { const int k = kq * 32 + i; S[i] = fs[t * 128 + k] * S[i] + ks[t * 128 + k] * iv; po += S[i] * qs[t * 128 + k]; }
        part[kq * 128 + v] = po;
        __syncthreads();
        if (tid < 128) { const float o = (part[v] + part[128 + v]) + (part[256 + v] + part[384 + v]);
            const float ss = wave_sum(o * o); if (lane == 0) osq[wave] = ss;
            part[v] = o; }
        __syncthreads();
        if (tid < 128) { const float o = part[v]; const float r = rsqrtf((osq[0] + osq[1]) * (1.0f / 128.0f) + EPS);
            const size_t row = (size_t)(MP + sb * 8 + t); const float gate = sigmoidf_(bf2f(PROJ[row * NIN + C_HG + h * 128 + v]));
            ((bf16_t*)(P.ws + WS_ABR))[((size_t)1 * MT + row) * 512 + h * 128 + v] = (bf16_t)f2bf(o * r * gain * gate); }
        __syncthreads();
    }
#pragma unroll
    for (int i = 0; i < 32; ++i) s_out[(size_t)(kq * 32 + i) * 128 + v] = S[i];
}

__device__ __forceinline__ void hgrn_local_unit(const Params& P, int bh, int c, unsigned char* lds) {
    float* Gs = (float*)lds;
    float* Qs = Gs + 8192;
    float* Kk = Qs + 8192;
    float* Vs = Kk + 8192;
    float* Sc = Vs + 8192;
    const int tid = threadIdx.x, lane = tid & 63;
    const int b = bh >> 2, h = bh & 3; const size_t row0 = (size_t)b * SEQ + (size_t)c * 64;
    const bf16_t* PROJ = (const bf16_t*)(P.ws + WS_PROJ); const float* LB = (const float*)(P.ws + WS_TAB) + 3 * 4 * 132;
    __syncthreads();
    for (int idx = tid; idx < 8192; idx += NTHR) { const int t = idx >> 7, k = idx & 127; const bf16_t* pr = PROJ + (row0 + t) * NIN + h * 128 + k;
        const float lb = LB[h * 128 + k]; const float f = lb + (1.0f - lb) * sigmoidf_(bf2f(pr[C_HF]));
        Gs[idx] = logf(f); Kk[idx] = 1.0f - f; Qs[idx] = bf2f(pr[C_HQ]); Vs[idx] = bf2f(pr[C_HI]); }
    __syncthreads();
    if (tid < 128) { float a = 0.f; for (int t = 0; t < 64; ++t) { a += Gs[t * 128 + tid]; Gs[t * 128 + tid] = a; } }
    __syncthreads();
    { bf16_t* HQT = (bf16_t*)(P.ws + WS_HQT);
      for (int idx = tid; idx < 8192; idx += NTHR) { const int t = idx >> 7, k = idx & 127; HQT[(row0 + t) * 512 + h * 128 + k] = (bf16_t)f2bf(Qs[idx] * __expf(Gs[idx])); }
      if (tid < 128) ((float*)(P.ws + WS_DC))[((size_t)bh * 128 + c) * 128 + tid] = __expf(Gs[63 * 128 + tid]); }
    { const int t = tid >> 3, sub = tid & 7;
      for (int s = sub; s < 64; s += 8) { float acc = 0.f;
          if (s <= t) { for (int kk = 0; kk < 128; ++kk) { const int k = (kk + lane) & 127; acc += Qs[t * 128 + k] * Kk[s * 128 + k] * __expf(Gs[t * 128 + k] - Gs[s * 128 + k]); } }
          Sc[t * 64 + s] = acc; } }
    __syncthreads();
    { const int t = tid >> 3, v0 = (tid & 7) * 16; f32x4 o[4];
#pragma unroll
      for (int i = 0; i < 4; ++i) o[i] = (f32x4){0.f, 0.f, 0.f, 0.f};
      for (int s = 0; s <= t; ++s) { const float p = Sc[t * 64 + s]; const f32x4* vp = (const f32x4*)(Vs + s * 128 + v0);
#pragma unroll
          for (int i = 0; i < 4; ++i) o[i] += p * vp[i]; }
      f32x4* op = (f32x4*)((float*)(P.ws + WS_OINTRA) + (row0 + t) * 512 + h * 128 + v0);
#pragma unroll
      for (int i = 0; i < 4; ++i) op[i] = o[i]; }
    for (int idx = tid; idx < 8192; idx += NTHR) { const int k = idx & 127; Kk[idx] = Kk[idx] * __expf(Gs[63 * 128 + k] - Gs[idx]); }
    __syncthreads();
    { const int k = tid >> 2, v0 = (tid & 3) * 32; f32x4 u[8];
#pragma unroll
      for (int i = 0; i < 8; ++i) u[i] = (f32x4){0.f, 0.f, 0.f, 0.f};
      for (int s = 0; s < 64; ++s) { const float kt = Kk[s * 128 + k]; const f32x4* vp = (const f32x4*)(Vs + s * 128 + v0);
#pragma unroll
          for (int i = 0; i < 8; ++i) u[i] += kt * vp[i]; }
      f32x4* up = (f32x4*)((float*)(P.ws + WS_U) + ((size_t)bh * 128 + c) * 16384 + k * 128 + v0);
#pragma unroll
      for (int i = 0; i < 8; ++i) up[i] = u[i]; }
}

__device__ __forceinline__ void phase_mix1(const Params& P, unsigned char* lds) {
    unsigned char* ws = P.ws; bf16_t* PROJ = (bf16_t*)(ws + WS_PROJ);
    const float* BT = (const float*)(ws + WS_TAB);
    constexpr int N_DIL = 3 * 2 * 4 * 64, N_MEM = 2 * 4 * 64, N_HL = 8 * 128, N_SA = 32 * 3 * 4, N_SM = 32 * 4, N_SH = 32 * 4;
    constexpr int NTOT = N_DIL + N_MEM + N_HL + N_SA + N_SM + N_SH;
    for (int it = blockIdx.x; it < NTOT; it += gridDim.x) {
        int r = it;
        if (r < N_DIL + N_MEM) {
            AttnUnit U;
            if (r < N_DIL) {
                const int g = r / 512, b = (r >> 8) & 1, h = (r >> 6) & 3, rb = r & 63;
                const int dil = g == 0 ? 1 : (g == 1 ? 4 : 16); const int nbper = 64 / dil; const int res = rb / nbper, n = rb % nbper;
                const long base = (long)b * SEQ + (long)n * 128 * dil + res; const long kbase = base - (long)128 * dil;
                U.q = PROJ + base * NIN + C_Q + g * 512 + h * 128; U.q_rs = (long)dil * NIN;
                U.k = PROJ + kbase * NIN + C_K + g * 512 + h * 128; U.k_rs = (long)dil * NIN; U.v = PROJ + kbase * NIN + C_V + g * 512 + h * 128; U.v_rs = (long)dil * NIN;
                U.k_valid_from = n == 0 ? 128 : 0;
                U.o = (bf16_t*)(ws + WS_ATTO) + ((long)g * MT + base) * 512 + h * 128; U.o_rs = (long)dil * 512;
                U.lse = (float*)(ws + WS_LSE) + ((long)g * MT + base) * 4 + h; U.lse_rs = (long)dil * 4; U.bias = BT + (g * 4 + h) * 132;
            } else {
                const int q = r - N_DIL; const int b = q >> 8, h = (q >> 6) & 3, n = q & 63; const long base = (long)b * SEQ + (long)n * 128;
                const bf16_t* MEMKV = (const bf16_t*)(ws + WS_MEMKV);
                U.q = PROJ + base * NIN + C_MQ + h * 128; U.q_rs = NIN; U.k = MEMKV + (long)b * 256 * 1024 + h * 128; U.k_rs = 1024; U.v = U.k + 512; U.v_rs = 1024; U.k_valid_from = 0;
                U.o = (bf16_t*)(ws + WS_ABR) + ((long)2 * MT + base) * 512 + h * 128; U.o_rs = 512; U.lse = nullptr; U.lse_rs = 0; U.bias = nullptr;
            }
            if (MIX1_SEL & 1) attn_unit(U, lds);
            continue; }
        r -= N_DIL + N_MEM;
        if (r < N_HL) { if (MIX1_SEL & 4) hgrn_local_unit(P, r >> 7, r & 127, lds); continue; }
        r -= N_HL;
        if (r < N_SA + N_SM) {
            int sb, g, h;
            if (r < N_SA) { sb = r / 12; g = (r / 4) % 3; h = r & 3; } else { const int q = r - N_SA; sb = q >> 2; g = 3; h = q & 3; }
            const int W = g == 0 ? 128 : (g == 1 ? 512 : (g == 2 ? 2048 : 256)), dil = g == 0 ? 1 : (g == 1 ? 4 : (g == 2 ? 16 : -1));
            const float* cache = (g == 0 ? P.in[3] : (g == 1 ? P.in[4] : (g == 2 ? P.in[5] : P.in[6]))) + (size_t)sb * W * 1024 + h * 128;
            const float* neu = P.out + (g == 0 ? O_SW1 : (g == 1 ? O_SW2 : O_SW3)) + ((size_t)sb * W + (W - 8)) * 1024 + h * 128;
            const long row0 = MP + sb * 8;
            const int tq = g < 3 ? 1 : 0, base_idx = g < 3 ? W : 0;
            auto kp = [&](int t, int j) { const int idx = base_idx + tq * t - dil * j; return idx < W ? cache + (size_t)idx * 1024 : neu + (size_t)(idx - W) * 1024; };
            bf16_t* op = g < 3 ? (bf16_t*)(ws + WS_ATTO) + ((long)g * MT + row0) * 512 + h * 128 : (bf16_t*)(ws + WS_ABR) + ((long)2 * MT + row0) * 512 + h * 128;
            if (MIX1_SEL & 8) sample_attn_item(PROJ + row0 * NIN + (g < 3 ? C_Q + g * 512 : C_MQ) + h * 128, g < 3 ? 129 : 256, g < 3 ? BT + (g * 4 + h) * 132 : nullptr,
                kp, [&](int t, int j) { return kp(t, j) + 512; }, op, 512, g < 3 ? (float*)(ws + WS_LSE) + ((long)g * MT + row0) * 4 + h : nullptr, 4, lds);
            continue; }
        r -= N_SA;
        r -= N_SM;
        if (MIX1_SEL & 32) sample_hgrn_item(P, r >> 2, r & 3, lds);
    }
}

__device__ __forceinline__ void phase_scan(const Params& P) {
    const float* U = (const float*)(P.ws + WS_U); const float* DC = (const float*)(P.ws + WS_DC); float* S0 = (float*)(P.ws + WS_S0);
    for (int e = blockIdx.x * NTHR + threadIdx.x; e < 8 * 16384; e += gridDim.x * NTHR) {
        const int bh = e >> 14, kv = e & 16383, k = kv >> 7; float S = 0.f;
        for (int c = 0; c < 128; ++c) { const size_t o = ((size_t)bh * 128 + c) * 16384 + kv; S0[o] = S; S = DC[((size_t)bh * 128 + c) * 128 + k] * S + U[o]; }
        P.out[O_PHG + (size_t)bh * 16384 + kv] = S;
    }
}

__device__ __forceinline__ void hgrn_final_unit(const Params& P, int bh, int c, unsigned char* lds) {
    float* Ss = (float*)lds;
    float* Qt = Ss + 16384;
    const int tid = threadIdx.x; const int b = bh >> 2, h = bh & 3; const size_t row0 = (size_t)b * SEQ + (size_t)c * 64;
    __syncthreads();
    { const f32x4* s4 = (const f32x4*)((const float*)(P.ws + WS_S0) + ((size_t)bh * 128 + c) * 16384);
      for (int idx = tid; idx < 4096; idx += NTHR) ((f32x4*)Ss)[idx] = s4[idx];
      const bf16_t* HQT = (const bf16_t*)(P.ws + WS_HQT);
      for (int idx = tid; idx < 1024; idx += NTHR) { const int t = idx >> 4, c8 = (idx & 15) * 8; float v[8]; load_bf16x8(HQT + (row0 + t) * 512 + h * 128 + c8, v);
#pragma unroll
          for (int e = 0; e < 8; ++e) Qt[t * 128 + c8 + e] = v[e]; } }
    __syncthreads();
    const int t = tid >> 3, v0 = (tid & 7) * 16; const size_t row = row0 + t;
    f32x4 o[4];
    { const f32x4* oi = (const f32x4*)((const float*)(P.ws + WS_OINTRA) + row * 512 + h * 128 + v0);
#pragma unroll
      for (int i = 0; i < 4; ++i) o[i] = oi[i]; }
    for (int k = 0; k < 128; ++k) { const float q = Qt[t * 128 + k]; const f32x4* sp = (const f32x4*)(Ss + k * 128 + v0);
#pragma unroll
        for (int i = 0; i < 4; ++i) o[i] += q * sp[i]; }
    float ss = 0.f;
#pragma unroll
    for (int i = 0; i < 4; ++i) ss += (o[i].x * o[i].x + o[i].y * o[i].y) + (o[i].z * o[i].z + o[i].w * o[i].w);
    ss += __shfl_xor(ss, 1); ss += __shfl_xor(ss, 2); ss += __shfl_xor(ss, 4);
    const float r = rsqrtf(ss * (1.0f / 128.0f) + EPS);
    const float* gain = P.in[15] + v0; const bf16_t* gp = (const bf16_t*)(P.ws + WS_PROJ) + row * NIN + C_HG + h * 128 + v0;
    float gt[16]; load_bf16x8(gp, gt); load_bf16x8(gp + 8, gt + 8);
    float res[16];
#pragma unroll
    for (int i = 0; i < 4; ++i) { res[4 * i + 0] = o[i].x * r * gain[4 * i + 0] * sigmoidf_(gt[4 * i + 0]); res[4 * i + 1] = o[i].y * r * gain[4 * i + 1] * sigmoidf_(gt[4 * i + 1]);
        res[4 * i + 2] = o[i].z * r * gain[4 * i + 2] * sigmoidf_(gt[4 * i + 2]); res[4 * i + 3] = o[i].w * r * gain[4 * i + 3] * sigmoidf_(gt[4 * i + 3]); }
    bf16_t* op = (bf16_t*)(P.ws + WS_ABR) + ((size_t)1 * MT + row) * 512 + h * 128 + v0;
    store_bf16x8(op, res); store_bf16x8(op + 8, res + 8);
}
__device__ __forceinline__ void phase_mix2(const Params& P, unsigned char* lds) {
    for (int it = blockIdx.x; it < 1024; it += gridDim.x) hgrn_final_unit(P, it >> 7, it & 127, lds);
    const int lane = threadIdx.x & 63, wave = threadIdx.x >> 6; const int gw = blockIdx.x * NWAVES + wave, NGW = gridDim.x * NWAVES;
    const bf16_t* ATTO = (const bf16_t*)(P.ws + WS_ATTO); const float* LSE = (const float*)(P.ws + WS_LSE); bf16_t* ABR = (bf16_t*)(P.ws + WS_ABR);
    for (int row = gw; row < MT; row += NGW) {
        const int h = lane >> 4; const float l0 = LSE[((size_t)0 * MT + row) * 4 + h], l1 = LSE[((size_t)1 * MT + row) * 4 + h], l2 = LSE[((size_t)2 * MT + row) * 4 + h];
        const float m = fmaxf(l0, fmaxf(l1, l2)); float w0 = __expf(l0 - m), w1 = __expf(l1 - m), w2 = __expf(l2 - m); const float inv = 1.0f / (w0 + w1 + w2); w0 *= inv; w1 *= inv; w2 *= inv;
        float a[8], b2[8], c2[8], o[8];
        load_bf16x8(ATTO + ((size_t)0 * MT + row) * 512 + lane * 8, a); load_bf16x8(ATTO + ((size_t)1 * MT + row) * 512 + lane * 8, b2); load_bf16x8(ATTO + ((size_t)2 * MT + row) * 512 + lane * 8, c2);
#pragma unroll
        for (int e = 0; e < 8; ++e) o[e] = w0 * a[e] + w1 * b2[e] + w2 * c2[e];
        store_bf16x8(ABR + (size_t)row * 512 + lane * 8, o);
    }
}

struct BranchOrder {
    pg8::StaticOrder so;
    __device__ __forceinline__ bool next(int i, pg8::Unit& u) const { pg8::Unit t; if (!so.next(i / 3, t)) return false; const int br = i % 3; u.pm = br * (MT / 256) + t.pm; u.pn = br * 4 + t.pn; return true; }
    __device__ __forceinline__ void a_ready(const pg8::Unit&) const {}
    __device__ __forceinline__ void done(const pg8::Unit&) const {}
};
struct EpiBranch {
    static constexpr bool PERM = true, AFTER_DRAIN = false; const bf16_t* PROJ; bf16_t* MERGED;
    __device__ __forceinline__ bool keep(const pg8::Unit& u) const { return (u.pn >> 2) < 2; }
    __device__ __forceinline__ void operator()(f32x4 (&acc)[2][2][4][2], const pg8::Unit& u, int wr, int wc, int fr, int fq) const {
        const int br = u.pn >> 2, pn = u.pn & 3, pm = u.pm - br * (MT / 256);
        const int row0 = pm * 256 + wr * 64 + fr, col0 = pn * 256 + wc * 32 + 8 * fq;
        const int gc = br == 0 ? C_GA : (br == 1 ? C_GH : C_GM), gn = br == 0 ? C_GH : C_GM;
#pragma unroll
        for (int ai = 0; ai < 2; ++ai)
#pragma unroll
            for (int m = 0; m < 4; ++m)
#pragma unroll
                for (int bj = 0; bj < 2; ++bj) {
                    const int row = row0 + ai * 128 + m * 16, col = col0 + bj * 128; const bf16_t* pr = PROJ + (size_t)row * NIN + col;
                    float gcur[8], fac[8]; load_bf16x8(pr + gc, gcur);
                    if (br < 2) { float gnx[8]; load_bf16x8(pr + gn, gnx);
#pragma unroll
                        for (int e = 0; e < 8; ++e) fac[e] = (1.0f + __expf(-gnx[e])) / (1.0f + __expf(-gcur[e])); }
                    else {
#pragma unroll
                        for (int e = 0; e < 8; ++e) fac[e] = 1.0f / (1.0f + __expf(-gcur[e])); }
#pragma unroll
                    for (int e = 0; e < 4; ++e) { acc[ai][bj][m][0][e] *= fac[e]; acc[ai][bj][m][1][e] *= fac[4 + e]; }
                    if (br == 2) { const f32x4 a = acc[ai][bj][m][0], b = acc[ai][bj][m][1]; float v[8] = {a[0], a[1], a[2], a[3], b[0], b[1], b[2], b[3]}; store_bf16x8(MERGED + (size_t)row * 1024 + col, v); }
                }
    }
};
__device__ __forceinline__ void phase_branch(const Params& P, unsigned char* lds) {
    float* red = (float*)lds; unsigned char* ws = P.ws;
    const bf16_t* ABR = (const bf16_t*)(ws + WS_ABR); const bf16_t* WBR = (const bf16_t*)(ws + WS_WBR_T); const bf16_t* PROJ = (const bf16_t*)(ws + WS_PROJ); bf16_t* MERGED = (bf16_t*)(ws + WS_MERGED);
    {
        pg8::Gemm g{ABR, WBR, 3 * MT, 3 * 1024, 512}; BranchOrder S; S.so.init(MP, 1024, (int)gridDim.x, (int)blockIdx.x);
        const EpiBranch E{PROJ, MERGED};
        pg8::gemm_phase<EpiBranch, BranchOrder, false, true>((PG8_LAS unsigned char*)lds, g, S, E);
    }
    constexpr int NU = 4 * 16;
    for (int u = blockIdx.x; u < NU; u += gridDim.x) {
        const int tr = 256 + (u & 3), tc = u >> 2;
        float msum[8] = {0.f, 0.f, 0.f, 0.f, 0.f, 0.f, 0.f, 0.f};
#pragma unroll
        for (int br = 0; br < 3; ++br) {
            sgemm_unit(ABR + (size_t)br * MT * 512, 512, WBR + (size_t)br * 1024 * 512, 512, 512, tr * 64, tc * 64, red, [&](int row, int col, float* v) {
                float g[8]; load_bf16x8(PROJ + (size_t)row * NIN + (br == 0 ? C_GA : (br == 1 ? C_GH : C_GM)) + col, g);
#pragma unroll
                for (int e = 0; e < 8; ++e) msum[e] += sigmoidf_(g[e]) * v[e];
                if (br == 2) store_bf16x8(MERGED + (size_t)row * 1024 + col, msum); });
        }
    }
}
struct StoreF32x4 { float* C; __device__ __forceinline__ void operator()(int row, int col, const f32x4& v) const { *(f32x4*)(C + (size_t)row * 1024 + col) = v; } };
struct StoreBf16x8 { bf16_t* C; int ldc; __device__ __forceinline__ void operator()(int row, int col, float* v) const { store_bf16x8(C + (size_t)row * ldc + col, v); } };
__device__ __forceinline__ void phase_gemm_f32(const bf16_t* A, const bf16_t* Bt, int K, float* C, unsigned char* lds) {
    float* red = (float*)lds;
    {
        pg8::Gemm g{A, Bt, MP, 1024, K}; pg8::StaticOrder S; S.init(MP, 1024, (int)gridDim.x, (int)blockIdx.x);
        const pg8::Epi4<StoreF32x4> E{StoreF32x4{C}};
        pg8::gemm_phase<pg8::Epi4<StoreF32x4>, pg8::StaticOrder, false, true>((PG8_LAS unsigned char*)lds, g, S, E);
    }
    constexpr int NU = 4 * 16;
    for (int u = blockIdx.x; u < NU; u += gridDim.x) { const int tr = 256 + (u & 3), tc = u >> 2;
        sgemm_unit(A, K, Bt, K, K, tr * 64, tc * 64, red, [&](int row, int col, float* v) { store_f32x8(C + (size_t)row * 1024 + col, v); }); }
}
__device__ __forceinline__ void phase_ffn_up(const Params& P, unsigned char* lds) {
    float* red = (float*)lds; const bf16_t* XN = (const bf16_t*)(P.ws + WS_XN); const bf16_t* W = (const bf16_t*)(P.ws + WS_WAB_T); bf16_t* AB = (bf16_t*)(P.ws + WS_AB);
    const StoreBf16x8 f{AB, 8192};
    {
        pg8::Gemm g{XN, W, MP, 8192, D}; pg8::StaticOrder S; S.init(MP, 8192, (int)gridDim.x, (int)blockIdx.x);
        const pg8::Epi8<StoreBf16x8> E{f};
        pg8::gemm_phase<pg8::Epi8<StoreBf16x8>, pg8::StaticOrder, true, true>((PG8_LAS unsigned char*)lds, g, S, E);
    }
    constexpr int NU = 4 * 128;
    for (int u = blockIdx.x; u < NU; u += gridDim.x) { const int tr = 256 + (u & 3), tc = u >> 2; sgemm_unit(XN, D, W, D, D, tr * 64, tc * 64, red, f); }
}
__device__ __forceinline__ void phase_mid_norm(const Params& P) {
    const int lane = threadIdx.x & 63, wave = threadIdx.x >> 6; const int gw = blockIdx.x * NWAVES + wave, NGW = gridDim.x * NWAVES;
    const float* MIX = (const float*)(P.ws + WS_MIX); bf16_t* XN = (bf16_t*)(P.ws + WS_XN);
    for (int row = gw; row < MT; row += NGW) {
        const float* xr = row < MP ? P.in[0] + (size_t)row * D : P.in[1] + (size_t)(row - MP) * D; float* yr = P.out + (size_t)row * D;
        f32x4 m[4], x[4]; float s = 0.f;
#pragma unroll
        for (int j = 0; j < 4; ++j) { m[j] = ((const f32x4*)(MIX + (size_t)row * D))[lane + 64 * j]; s += (m[j].x * m[j].x + m[j].y * m[j].y) + (m[j].z * m[j].z + m[j].w * m[j].w); }
        const float r = rsqrtf(wave_sum(s) * (1.0f / 1024.0f) + EPS); float s2 = 0.f;
#pragma unroll
        for (int j = 0; j < 4; ++j) { const f32x4 g = ((const f32x4*)P.in[12])[lane + 64 * j]; x[j] = ((const f32x4*)xr)[lane + 64 * j] + m[j] * r * g; ((f32x4*)yr)[lane + 64 * j] = x[j];
            s2 += (x[j].x * x[j].x + x[j].y * x[j].y) + (x[j].z * x[j].z + x[j].w * x[j].w); }
        const float r2 = rsqrtf(wave_sum(s2) * (1.0f / 1024.0f) + EPS);
#pragma unroll
        for (int j = 0; j < 4; ++j) { const f32x4 g = ((const f32x4*)P.in[22])[lane + 64 * j]; u32x2 o; o.x = pk2(x[j].x * r2 * g.x, x[j].y * r2 * g.y); o.y = pk2(x[j].z * r2 * g.z, x[j].w * r2 * g.w);
            ((u32x2*)(XN + (size_t)row * D))[lane + 64 * j] = o; }
    }
}
__device__ __forceinline__ void phase_ffn_gate(const Params& P) {
    const bf16_t* AB = (const bf16_t*)(P.ws + WS_AB); bf16_t* H = (bf16_t*)(P.ws + WS_H);
    const float* cw = P.in[26]; const float* cb = P.in[27]; const float* cbuf = P.in[8];
    for (size_t idx = (size_t)blockIdx.x * NTHR + threadIdx.x; idx < (size_t)MT * 512; idx += (size_t)gridDim.x * NTHR) {
        const int row = (int)(idx >> 9), n = (int)(idx & 511) * 8; const int cofs = (n >> 7) * 256 + (n & 127);
        float a[8], b[8], a1[8], a2[8];
        load_bf16x8(AB + (size_t)row * 8192 + cofs, a); load_bf16x8(AB + (size_t)row * 8192 + cofs + 128, b);
        if (row < MP) { const int t = row & 8191;
            if (t >= 1) load_bf16x8(AB + (size_t)(row - 1) * 8192 + cofs, a1); else { for (int e = 0; e < 8; ++e) a1[e] = 0.f; }
            if (t >= 2) load_bf16x8(AB + (size_t)(row - 2) * 8192 + cofs, a2); else { for (int e = 0; e < 8; ++e) a2[e] = 0.f; }
            if (t >= SEQ - 2) store_f32x8(P.out + O_PCONV + ((size_t)(row >> 13) * 2 + (t - (SEQ - 2))) * DFF + n, a);
        } else { const int sb = (row - MP) >> 3, st = (row - MP) & 7; const float* cbb = cbuf + (size_t)sb * 2 * DFF + n;
            if (st >= 1) load_bf16x8(AB + (size_t)(row - 1) * 8192 + cofs, a1); else { for (int e = 0; e < 8; ++e) a1[e] = cbb[DFF + e]; }
            if (st >= 2) load_bf16x8(AB + (size_t)(row - 2) * 8192 + cofs, a2); else { for (int e = 0; e < 8; ++e) a2[e] = cbb[(st == 0 ? 0 : DFF) + e]; }
            if (st >= 6) store_f32x8(P.out + O_SCONV + ((size_t)sb * 2 + (st - 6)) * DFF + n, a);
        }
        float o[8];
#pragma unroll
        for (int e = 0; e < 8; ++e) { const float c = cb[n + e] + a2[e] * cw[n + e] + a1[e] * cw[DFF + n + e] + a[e] * cw[2 * DFF + n + e]; o[e] = c * sigmoidf_(c) * b[e]; }
        store_bf16x8(H + (size_t)row * DFF + n, o);
    }
}
__device__ __forceinline__ void phase_final_norm(const Params& P) {
    const int lane = threadIdx.x & 63, wave = threadIdx.x >> 6; const int gw = blockIdx.x * NWAVES + wave, NGW = gridDim.x * NWAVES;
    const float* Fm = (const float*)(P.ws + WS_MIX);
    for (int row = gw; row < MT; row += NGW) {
        float* yr = P.out + (size_t)row * D; f32x4 m[4]; float s = 0.f;
#pragma unroll
        for (int j = 0; j < 4; ++j) { m[j] = ((const f32x4*)(Fm + (size_t)row * D))[lane + 64 * j]; s += (m[j].x * m[j].x + m[j].y * m[j].y) + (m[j].z * m[j].z + m[j].w * m[j].w); }
        const float r = rsqrtf(wave_sum(s) * (1.0f / 1024.0f) + EPS);
#pragma unroll
        for (int j = 0; j < 4; ++j) { const f32x4 g = ((const f32x4*)P.in[23])[lane + 64 * j]; ((f32x4*)yr)[lane + 64 * j] = ((const f32x4*)yr)[lane + 64 * j] + m[j] * r * g; }
    }
}

constexpr int NPHASE = 12;
__global__ void __launch_bounds__(NTHR, 2) mega_fwd(Params P) {
    extern __shared__ __attribute__((aligned(16))) unsigned char lds[];
    volatile unsigned* MISC = (volatile unsigned*)(lds + LDS_BYTES - 64);
    if (threadIdx.x < 16) MISC[threadIdx.x] = 0u;
    __syncthreads();
    XcdBarrier bar; bar.bar = (unsigned*)(P.ws + WS_CTL) + 4096; bar.x = 0; bar.st = nullptr;
    const bool multi = (P.ph_hi - P.ph_lo) > 1;
    if (multi) bar = xcd_barrier_post((unsigned*)(P.ws + WS_CTL) + 4096, MISC);
    const int lo = P.ph_lo, hi = P.ph_hi;
#define IN(k) (lo <= (k) && (k) < hi)
#define SEAM(k) do { if (IN(k) && IN((k) + 1)) xcd_barrier(bar); } while (0)
    if (IN(0)) phase_prep(P, lds);
    SEAM(0);
    if (IN(1)) phase_inproj(P, lds);
    SEAM(1);
    if (IN(2)) phase_mix1(P, lds);
    SEAM(2);
    if (IN(3)) phase_scan(P);
    SEAM(3);
    if (IN(4)) phase_mix2(P, lds);
    SEAM(4);
    if (IN(5)) phase_branch(P, lds);
    SEAM(5);
    if (IN(6)) phase_gemm_f32((const bf16_t*)(P.ws + WS_MERGED), (const bf16_t*)(P.ws + WS_WOUT_T), 1024, (float*)(P.ws + WS_MIX), lds);
    SEAM(6);
    if (IN(7)) phase_mid_norm(P);
    SEAM(7);
    if (IN(8)) phase_ffn_up(P, lds);
    SEAM(8);
    if (IN(9)) phase_ffn_gate(P);
    SEAM(9);
    if (IN(10)) phase_gemm_f32((const bf16_t*)(P.ws + WS_H), (const bf16_t*)(P.ws + WS_WD_T), 4096, (float*)(P.ws + WS_MIX), lds);
    SEAM(10);
    if (IN(11)) phase_final_norm(P);
#undef IN
#undef SEAM
}
}

extern "C" void kernel_launch(void* const* d_in, const int* in_sizes, int n_in, void* d_out, int out_size, void* d_ws, size_t ws_size, hipStream_t stream) {
    static int ready = 0;
    if (ready == 0) {
        if (n_in != 29 || (size_t)out_size != O_END || ws_size < WS_END) { fprintf(stderr, "kernel_launch: unexpected shapes (n_in %d out %d ws %zu)\n", n_in, out_size, ws_size); ready = -1; return; }
        if (hipFuncSetAttribute((const void*)mega_fwd, hipFuncAttributeMaxDynamicSharedMemorySize, LDS_BYTES) != hipSuccess) { fprintf(stderr, "kernel_launch: hipFuncSetAttribute failed\n"); ready = -1; return; }
        ready = 1;
    }
    if (ready < 0) return;
    (void)hipMemsetAsync((char*)d_ws + WS_CTL, 0, CTL_BYTES, stream);
    Params p{};
    for (int i = 0; i < 29; ++i) p.in[i] = (const float*)d_in[i];
    p.out = (float*)d_out; p.ws = (unsigned char*)d_ws;
#if MK_ONE_LAUNCH
    p.ph_lo = 0; p.ph_hi = NPHASE;
    hipLaunchKernelGGL(mega_fwd, dim3(256), dim3(NTHR), LDS_BYTES, stream, p);
#else
    for (int ph = 0; ph < NPHASE; ++ph) { p.ph_lo = ph; p.ph_hi = ph + 1; hipLaunchKernelGGL(mega_fwd, dim3(256), dim3(NTHR), LDS_BYTES, stream, p); }
#endif
}
```

```cpp
#include <hip/hip_runtime.h>
#include <cstdio>
#include <cstdint>

#ifndef MIX1_SEL
#define MIX1_SEL 63
#endif
#ifndef MK_ONE_LAUNCH
#define MK_ONE_LAUNCH 1
#endif

namespace {
typedef unsigned short bf16_t;
typedef short bf16x8 __attribute__((ext_vector_type(8)));
typedef float f32x4 __attribute__((ext_vector_type(4)));
typedef float f32x2 __attribute__((ext_vector_type(2)));
typedef unsigned u32x4 __attribute__((ext_vector_type(4)));
typedef unsigned u32x2 __attribute__((ext_vector_type(2)));

constexpr int NTHR = 512, NWAVES = 8;
constexpr int D = 1024, SEQ = 8192, NB = 2, MP = NB * SEQ, SBATCH = 32, STOK = 8, MS = SBATCH * STOK, MT = MP + MS;
constexpr int NIN = 10240, DFF = 4096;
constexpr int C_Q = 0, C_K = 1536, C_V = 3072, C_HQ = 4608, C_HF = 5120, C_HI = 5632, C_HG = 6144, C_MQ = 6656, C_GA = 7168, C_GH = 8192, C_GM = 9216;
constexpr float EPS = 1e-6f;

constexpr size_t O_YP = 0, O_YS = 16777216, O_PW1 = 17039360, O_PW2 = 17301504, O_PW3 = 18350080, O_PHG = 22544384, O_PCONV = 22675456, O_PMEM = 22691840,
                 O_SW1 = 23216128, O_SW2 = 27410432, O_SW3 = 44187648, O_SHG = 111296512, O_SCONV = 113393664, O_END = 113655808;

constexpr size_t MiB = 1u << 20;
constexpr size_t WS_CTL = 0, CTL_BYTES = 1 * MiB;
constexpr size_t WS_TAB = 1 * MiB;
constexpr size_t WS_WIN_T = 2 * MiB;
constexpr size_t WS_WMEM_T = 22 * MiB;
constexpr size_t WS_WBR_T = 24 * MiB;
constexpr size_t WS_WOUT_T = 27 * MiB;
constexpr size_t WS_WAB_T = 29 * MiB;
constexpr size_t WS_WD_T = 45 * MiB;
constexpr size_t WS_XN = 54 * MiB;
constexpr size_t WS_MEMN = 87 * MiB;
constexpr size_t WS_MEMKV = 88 * MiB;
constexpr size_t WS_PROJ = 90 * MiB;
constexpr size_t WS_ATTO = 416 * MiB;
constexpr size_t WS_LSE = 465 * MiB;
constexpr size_t WS_ABR = 466 * MiB;
constexpr size_t WS_HQT = 515 * MiB;
constexpr size_t WS_OINTRA = 531 * MiB;
constexpr size_t WS_U = 563 * MiB;
constexpr size_t WS_DC = 627 * MiB;
constexpr size_t WS_S0 = 628 * MiB;
constexpr size_t WS_MERGED = 692 * MiB;
constexpr size_t WS_MIX = 725 * MiB;
constexpr size_t WS_H = 790 * MiB;
constexpr size_t WS_AB = WS_PROJ;
constexpr size_t WS_END = 920 * MiB;

constexpr int LDS_BYTES = 155648;

struct Params { const float* in[29]; float* out; unsigned char* ws; int ph_lo, ph_hi; };

__device__ __forceinline__ unsigned f2bf(float f) { unsigned u = __float_as_uint(f); return (u + 0x7fffu + ((u >> 16) & 1u)) >> 16; }
__device__ __forceinline__ float bf2f(unsigned h) { return __uint_as_float(h << 16); }
__device__ __forceinline__ unsigned pk2(float lo, float hi) { return f2bf(lo) | (f2bf(hi) << 16); }
__device__ __forceinline__ float wave_sum(float v) {
#pragma unroll
    for (int o = 1; o < 64; o <<= 1) v += __shfl_xor(v, o);
    return v;
}
__device__ __forceinline__ float sigmoidf_(float x) { return 1.0f / (1.0f + __expf(-x)); }
#define LDS_WAIT() asm volatile("s_waitcnt lgkmcnt(0)" ::: "memory")

#define XB_TMO      128
#define XB_XCNT(j)  (256  + 64 * (j))
#define XB_XSUB(j)  (1280 + 64 * (j))
#define XB_XGEN(j)  (2304 + 64 * (j))
#define XB_TOP      3328
#define XB_TOPGEN   3392
#define XB_SPIN_CAP (1u << 22)
__device__ __forceinline__ unsigned xb_ld(unsigned* p)              { return __hip_atomic_load(p, __ATOMIC_RELAXED, __HIP_MEMORY_SCOPE_AGENT); }
__device__ __forceinline__ unsigned xb_add(unsigned* p, unsigned v) { return __hip_atomic_fetch_add(p, v, __ATOMIC_RELAXED, __HIP_MEMORY_SCOPE_AGENT); }
__device__ __forceinline__ unsigned xb_xcc_id() { return (unsigned)__builtin_amdgcn_s_getreg((3 << 11) | 20) & 0xFu; }
#define XB_SPIN(cond, bar) do { unsigned _sp = 0; while (cond) { __builtin_amdgcn_s_sleep(1); \
    if ((++_sp & 255u) == 0u) { if (xb_ld(&(bar)[XB_TMO])) break; if (_sp > XB_SPIN_CAP) { atomicAdd(&(bar)[XB_TMO], 1u); break; } } } } while (0)
struct XcdBarrier { unsigned* bar; unsigned x; volatile unsigned* st; };
__device__ __forceinline__ XcdBarrier xcd_barrier_post(unsigned* bar, volatile unsigned* st) {
    XcdBarrier b; b.bar = bar; b.x = xb_xcc_id(); b.st = st;
    if (threadIdx.x == 0) (void)xb_add(&bar[XB_XCNT(b.x)], 1u);
    return b;
}
__device__ __forceinline__ void xcd_barrier_complete(unsigned* bar, unsigned x, unsigned& nloc, unsigned& nx) {
    const unsigned G = gridDim.x;
    unsigned sum, cnt, mine, sp = 0u;
    for (;;) {
        sum = 0u; cnt = 0u; mine = 0u;
#pragma unroll
        for (unsigned j = 0; j < 16; ++j) { const unsigned c = xb_ld(&bar[XB_XCNT(j)]); sum += c; cnt += (c > 0u) ? 1u : 0u; mine = (j == x) ? c : mine; }
        if (sum == G) break;
        __builtin_amdgcn_s_sleep(1);
        if ((++sp & 255u) == 0u) { if (xb_ld(&bar[XB_TMO])) break; if (sp > XB_SPIN_CAP) { atomicAdd(&bar[XB_TMO], 1u); break; } }
    }
    nloc = mine > 0u ? mine : 1u; nx = cnt > 0u ? cnt : 1u;
}
__device__ __forceinline__ void xcd_barrier(const XcdBarrier& b) {
    asm volatile("s_waitcnt vmcnt(0)" ::: "memory");
    __syncthreads();
    if (threadIdx.x == 0) {
        unsigned* bar = b.bar;
        __builtin_amdgcn_s_waitcnt(0);
        unsigned nloc = b.st[0], nx = b.st[1];
        if (nloc == 0u) { xcd_barrier_complete(bar, b.x, nloc, nx); b.st[0] = nloc; b.st[1] = nx; }
        const unsigned old = xb_add(&bar[XB_XSUB(b.x)], 1u);
        const unsigned gen = old / nloc;
        if (old + 1u == (gen + 1u) * nloc) {
            __builtin_amdgcn_fence(__ATOMIC_RELEASE, "agent");
            asm volatile("s_waitcnt vmcnt(0)" ::: "memory");
            const unsigned og = xb_add(&bar[XB_TOP], 1u);
            const unsigned tg = og / nx;
            if (og + 1u == (tg + 1u) * nx) xb_add(&bar[XB_TOPGEN], 1u);
            else XB_SPIN(xb_ld(&bar[XB_TOPGEN]) == tg, bar);
            __builtin_amdgcn_fence(__ATOMIC_ACQUIRE, "agent");
            xb_add(&bar[XB_XGEN(b.x)], 1u);
            asm volatile("s_waitcnt vmcnt(0)" ::: "memory");
        } else {
            XB_SPIN(xb_ld(&bar[XB_XGEN(b.x)]) == gen, bar);
            __builtin_amdgcn_fence(__ATOMIC_ACQUIRE, "agent");
            asm volatile("s_waitcnt vmcnt(0)" ::: "memory");
        }
    }
    __syncthreads();
}

__device__ __forceinline__ int dest_row(int n, int kind, int row_off) { return kind == 0 ? row_off + n : ((n >> 7) * 256 + (n & 127) + (kind == 2 ? 128 : 0)); }
__device__ __forceinline__ void transpose_item(const float* __restrict__ W, int K, int N, bf16_t* __restrict__ WT, int kind, int row_off, float* scr, int item, int lane) {
    const int nblk = N / 32, kb = item / nblk, nb = item % nblk, k0 = 64 * kb, n0 = 32 * nb;
#pragma unroll 8
    for (int i = 0; i < 32; ++i) { const int kk = 2 * i + (lane >> 5); scr[kk * 33 + (lane & 31)] = W[(size_t)(k0 + kk) * N + n0 + (lane & 31)]; }
    LDS_WAIT();
    const int c = lane & 7;
#pragma unroll
    for (int j = 0; j < 4; ++j) { const int n = (lane >> 3) + 8 * j; const float* s = scr + (8 * c) * 33 + n;
        u32x4 o; o.x = pk2(s[0 * 33], s[1 * 33]); o.y = pk2(s[2 * 33], s[3 * 33]); o.z = pk2(s[4 * 33], s[5 * 33]); o.w = pk2(s[6 * 33], s[7 * 33]);
        *(u32x4*)(WT + (size_t)dest_row(n0 + n, kind, row_off) * K + k0 + 8 * c) = o; }
    LDS_WAIT();
}
__device__ __forceinline__ void rms_row_bf16(const float* __restrict__ xr, const float* __restrict__ gain, bf16_t* __restrict__ orow, int lane) {
    f32x4 v[4]; float s = 0.f;
#pragma unroll
    for (int j = 0; j < 4; ++j) { v[j] = ((const f32x4*)xr)[lane + 64 * j]; s += (v[j].x * v[j].x + v[j].y * v[j].y) + (v[j].z * v[j].z + v[j].w * v[j].w); }
    const float r = rsqrtf(wave_sum(s) * (1.0f / 1024.0f) + EPS);
#pragma unroll
    for (int j = 0; j < 4; ++j) { const f32x4 g = ((const f32x4*)gain)[lane + 64 * j];
        u32x2 o; o.x = pk2(v[j].x * r * g.x, v[j].y * r * g.y); o.y = pk2(v[j].z * r * g.z, v[j].w * r * g.w);
        ((u32x2*)orow)[lane + 64 * j] = o; }
}
__device__ __forceinline__ void phase_prep(const Params& P, unsigned char* lds) {
    const int tid = threadIdx.x, lane = tid & 63, wave = tid >> 6;
    const int gw = blockIdx.x * NWAVES + wave, NGW = gridDim.x * NWAVES;
    unsigned char* ws = P.ws;
    float* scr = (float*)lds + wave * (64 * 33);
    {
        constexpr int I_IN = 16 * 320, I_MEM = 16 * 32, I_BR = 8 * 32, I_OUT = 16 * 32, I_A = 16 * 128, I_D = 64 * 32;
        constexpr int NIT = I_IN + I_MEM + 3 * I_BR + I_OUT + 2 * I_A + I_D;
        for (int it = gw; it < NIT; it += NGW) {
            int r = it;
            if (r < I_IN) { transpose_item(P.in[13], 1024, NIN, (bf16_t*)(ws + WS_WIN_T), 0, 0, scr, r, lane); continue; } r -= I_IN;
            if (r < I_MEM) { transpose_item(P.in[17], 1024, 1024, (bf16_t*)(ws + WS_WMEM_T), 0, 0, scr, r, lane); continue; } r -= I_MEM;
            if (r < I_BR) { transpose_item(P.in[18], 512, 1024, (bf16_t*)(ws + WS_WBR_T), 0, 0, scr, r, lane); continue; } r -= I_BR;
            if (r < I_BR) { transpose_item(P.in[19], 512, 1024, (bf16_t*)(ws + WS_WBR_T), 0, 1024, scr, r, lane); continue; } r -= I_BR;
            if (r < I_BR) { transpose_item(P.in[20], 512, 1024, (bf16_t*)(ws + WS_WBR_T), 0, 2048, scr, r, lane); continue; } r -= I_BR;
            if (r < I_OUT) { transpose_item(P.in[21], 1024, 1024, (bf16_t*)(ws + WS_WOUT_T), 0, 0, scr, r, lane); continue; } r -= I_OUT;
            if (r < I_A) { transpose_item(P.in[24], 1024, DFF, (bf16_t*)(ws + WS_WAB_T), 1, 0, scr, r, lane); continue; } r -= I_A;
            if (r < I_A) { transpose_item(P.in[25], 1024, DFF, (bf16_t*)(ws + WS_WAB_T), 2, 0, scr, r, lane); continue; } r -= I_A;
            transpose_item(P.in[28], DFF, 1024, (bf16_t*)(ws + WS_WD_T), 0, 0, scr, r, lane);
        }
    }
    {
        bf16_t* XN = (bf16_t*)(ws + WS_XN); bf16_t* MEMN = (bf16_t*)(ws + WS_MEMN);
        for (int m = gw; m < MT + 512; m += NGW) {
            if (m < MP) rms_row_bf16(P.in[0] + (size_t)m * D, P.in[11], XN + (size_t)m * D, lane);
            else if (m < MT) rms_row_bf16(P.in[1] + (size_t)(m - MP) * D, P.in[11], XN + (size_t)m * D, lane);
            else rms_row_bf16(P.in[2] + (size_t)(m - MT) * D, P.in[16], MEMN + (size_t)(m - MT) * D, lane);
        }
    }
    {
        constexpr int R1 = 32 * 120, R2 = 32 * 504, R3 = 32 * 2040;
        for (int r = gw; r < R1 + R2 + R3; r += NGW) {
            int q = r, W; const float* src; float* dst;
            if (q < R1) { W = 128; src = P.in[3]; dst = P.out + O_SW1; }
            else if (q < R1 + R2) { q -= R1; W = 512; src = P.in[4]; dst = P.out + O_SW2; }
            else { q -= R1 + R2; W = 2048; src = P.in[5]; dst = P.out + O_SW3; }
            const int b = q / (W - 8), i = q % (W - 8);
            const f32x4* s4 = (const f32x4*)(src + ((size_t)b * W + i + 8) * 1024); f32x4* d4 = (f32x4*)(dst + ((size_t)b * W + i) * 1024);
            f32x4 t0 = s4[lane], t1 = s4[lane + 64], t2 = s4[lane + 128], t3 = s4[lane + 192];
            d4[lane] = t0; d4[lane + 64] = t1; d4[lane + 128] = t2; d4[lane + 192] = t3;
        }
    }
    if (blockIdx.x == 0) {
        float* BT = (float*)(ws + WS_TAB); float* LB = BT + 3 * 4 * 132;
        const float* rel_bias = P.in[9];
        for (int e = tid; e < 3 * 4 * 129; e += NTHR) {
            const int g = e / (4 * 129), h = (e / 129) % 4, j = e % 129;
            const int dil = g == 0 ? 1 : (g == 1 ? 4 : 16);
            const int dist = j * dil; int bucket;
            if (dist < 16) bucket = dist;
            else { const float d = (float)dist; int large = 16 + (int)(logf(d / 16.0f) / logf(128.0f) * 16.0f); bucket = large < 31 ? large : 31; }
            BT[(g * 4 + h) * 132 + j] = rel_bias[bucket * 12 + g * 4 + h];
        }
        for (int e = tid; e < 512; e += NTHR) { const float l0 = P.in[10][e], l1 = P.in[10][512 + e]; LB[e] = 1.0f / (1.0f + expf(l1 - l0)); }
    }
}

template <class Epi>
__device__ __forceinline__ void sgemm_unit(const bf16_t* __restrict__ A, int lda, const bf16_t* __restrict__ Bt, int ldb, int K, int row0, int col0, float* red, const Epi& epi) {
    const int tid = threadIdx.x, lane = tid & 63, wave = tid >> 6, kq = wave >> 1, ch = wave & 1, fr = lane & 15, fq = lane >> 4;
    f32x4 acc[4][2];
#pragma unroll
    for (int i = 0; i < 4; ++i)
#pragma unroll
        for (int j = 0; j < 2; ++j) acc[i][j] = (f32x4){0.f, 0.f, 0.f, 0.f};
    const int kbeg = kq * (K >> 2), kend = kbeg + (K >> 2);
    const bf16_t* ap = A + (size_t)(row0 + fr) * lda + fq * 8;
    const bf16_t* bp = Bt + (size_t)(col0 + ch * 32 + fr) * ldb + fq * 8;
#pragma unroll 4
    for (int k = kbeg; k < kend; k += 32) {
        bf16x8 a[4], b[2];
#pragma unroll
        for (int i = 0; i < 4; ++i) a[i] = *(const bf16x8*)(ap + (size_t)i * 16 * lda + k);
#pragma unroll
        for (int j = 0; j < 2; ++j) b[j] = *(const bf16x8*)(bp + (size_t)j * 16 * ldb + k);
#pragma unroll
        for (int i = 0; i < 4; ++i)
#pragma unroll
            for (int j = 0; j < 2; ++j) acc[i][j] = __builtin_amdgcn_mfma_f32_16x16x32_bf16(a[i], b[j], acc[i][j], 0, 0, 0);
    }
    __syncthreads();
#pragma unroll
    for (int i = 0; i < 4; ++i)
#pragma unroll
        for (int j = 0; j < 2; ++j)
#pragma unroll
            for (int r = 0; r < 4; ++r) red[(kq * 64 + i * 16 + 4 * fq + r) * 65 + ch * 32 + j * 16 + fr] = acc[i][j][r];
    __syncthreads();
    const int row = tid >> 3, c8 = (tid & 7) * 8;
    float v[8];
#pragma unroll
    for (int e = 0; e < 8; ++e) v[e] = (red[(0 * 64 + row) * 65 + c8 + e] + red[(1 * 64 + row) * 65 + c8 + e]) + (red[(2 * 64 + row) * 65 + c8 + e] + red[(3 * 64 + row) * 65 + c8 + e]);
    epi(row0 + row, col0 + c8, v);
}
__device__ __forceinline__ void store_bf16x8(bf16_t* p, const float* v) { u32x4 o; o.x = pk2(v[0], v[1]); o.y = pk2(v[2], v[3]); o.z = pk2(v[4], v[5]); o.w = pk2(v[6], v[7]); *(u32x4*)p = o; }
__device__ __forceinline__ void store_f32x8(float* p, const float* v) { ((f32x4*)p)[0] = (f32x4){v[0], v[1], v[2], v[3]}; ((f32x4*)p)[1] = (f32x4){v[4], v[5], v[6], v[7]}; }
__device__ __forceinline__ void load_bf16x8(const bf16_t* p, float* v) { const u32x4 w = *(const u32x4*)p;
    v[0] = bf2f(w.x & 0xffffu); v[1] = bf2f(w.x >> 16); v[2] = bf2f(w.y & 0xffffu); v[3] = bf2f(w.y >> 16); v[4] = bf2f(w.z & 0xffffu); v[5] = bf2f(w.z >> 16); v[6] = bf2f(w.w & 0xffffu); v[7] = bf2f(w.w >> 16); }

}
namespace pg8 {
#define PG8_LAS __attribute__((address_space(3)))
typedef unsigned short bf16_t;
typedef short bf16x8 __attribute__((ext_vector_type(8)));
typedef float f32x4 __attribute__((ext_vector_type(4)));
typedef unsigned u32x4 __attribute__((ext_vector_type(4)));
constexpr int BM = 256, BK = 64, HALF = 128, HTB = HALF * BK * 2  , STAGE_BYTES = 8 * HTB, NXCD = 8, WGM = 8;

__host__ __device__ __forceinline__ int lds_byte(int r, int c) { const int st = (r >> 4) * 2 + (c >> 5), rr = r & 15, cc = c & 31, ob = rr * 64 + cc * 2; return st * 1024 + (ob ^ (((ob >> 9) & 1) << 5)); }
__host__ __device__ __forceinline__ void stage_rc(int b, int& R, int& C) { const int st = b / 1024, sb = b % 1024, swz = sb ^ (((sb >> 9) & 1) << 5); R = (st >> 1) * 16 + swz / 64; C = (st & 1) * 32 + (swz % 64) / 2; }
__host__ __device__ __forceinline__ int perm32(int rho) { const int n = rho >> 4, i = rho & 15; return 8 * (i >> 2) + 4 * n + (i & 3); }

struct Unit { int pm, pn; };
struct Gemm { const bf16_t* A; const bf16_t* Bt; int M, N, K; };

struct StaticOrder {
    int nM, nN, nwg, G, c;
    __host__ __device__ void init(int M, int N, int G_, int c_) { nM = M / BM; nN = N / BM; nwg = nM * nN; G = G_; c = c_; }
    __host__ __device__ bool next(int i, Unit& u) const {
        const long L = (long)i * G + c; if (L >= nwg) return false;
        int wgid = (int)L; { const int q = nwg / NXCD, r = nwg % NXCD, xcd = wgid % NXCD, off = wgid / NXCD; wgid = (xcd < r ? xcd * (q + 1) : r * (q + 1) + (xcd - r) * q) + off; }
        const int nig = WGM * nN, gid = wgid / nig, fm = gid * WGM, gsz = (nM - fm) < WGM ? (nM - fm) : WGM;
        u.pm = fm + ((wgid % nig) % gsz); u.pn = (wgid % nig) / gsz; return true;
    }
    __device__ __forceinline__ void a_ready(const Unit&) const {}
    __device__ __forceinline__ void done(const Unit&) const {}
};
__device__ __forceinline__ unsigned cvt_pk_bf16(float lo, float hi) { unsigned r; asm volatile("v_cvt_pk_bf16_f32 %0, %1, %2" : "=v"(r) : "v"(lo), "v"(hi)); return r; }
typedef float f32x2 __attribute__((ext_vector_type(2)));

template <class F> struct Epi8 {
    static constexpr bool PERM = true, AFTER_DRAIN = false; F f;
    __device__ __forceinline__ bool keep(const Unit&) const { return false; }
    __device__ __forceinline__ void operator()(f32x4 (&acc)[2][2][4][2], const Unit& u, int wr, int wc, int fr, int fq) const {
        const int row0 = u.pm * BM + wr * 64 + fr, col0 = u.pn * BM + wc * 32 + 8 * fq;
#pragma unroll
        for (int ai = 0; ai < 2; ++ai)
#pragma unroll
            for (int m = 0; m < 4; ++m)
#pragma unroll
                for (int bj = 0; bj < 2; ++bj) { const f32x4 a = acc[ai][bj][m][0], b = acc[ai][bj][m][1]; float v[8] = {a[0], a[1], a[2], a[3], b[0], b[1], b[2], b[3]};
                    f(row0 + ai * HALF + m * 16, col0 + bj * HALF, v); }
    }
};
template <class F> struct Epi4 {
    static constexpr bool PERM = false, AFTER_DRAIN = false; F f;
    __device__ __forceinline__ bool keep(const Unit&) const { return false; }
    __device__ __forceinline__ void operator()(f32x4 (&acc)[2][2][4][2], const Unit& u, int wr, int wc, int fr, int fq) const {
        const int row0 = u.pm * BM + wr * 64 + fr, col0 = u.pn * BM + wc * 32 + 4 * fq;
#pragma unroll
        for (int ai = 0; ai < 2; ++ai)
#pragma unroll
            for (int m = 0; m < 4; ++m)
#pragma unroll
                for (int bj = 0; bj < 2; ++bj)
#pragma unroll
                    for (int n = 0; n < 2; ++n) f(row0 + ai * HALF + m * 16, col0 + bj * HALF + n * 16, acc[ai][bj][m][n]);
    }
};
template <class Epi, class Sched, bool ALIGN_EPI = false, bool SP2 = false>
__device__ __forceinline__ void gemm_phase(PG8_LAS unsigned char* lds, const Gemm g, const Sched& S, const Epi& E) {
    const int tid = threadIdx.x, wid = __builtin_amdgcn_readfirstlane(tid >> 6), lane = tid & 63, wr = wid >> 2, wc = wid & 3, fr = lane & 15, fq = lane >> 4;
    const int K = g.K, nt = K / BK;
    unsigned voffA[2], voffB[2];
#pragma unroll
    for (int i = 0; i < 2; ++i) { int R, C; stage_rc(tid * 16 + i * 8192, R, C); const int Rb = Epi::PERM ? ((R & ~31) + perm32(R & 31)) : R;
        voffA[i] = (unsigned)(R * K + C) * 2u; voffB[i] = (unsigned)(Rb * K + C) * 2u; }
    const size_t kstep = (size_t)(BK * 2);
    const size_t hstep = (size_t)HALF * K * 2;
    const size_t tstep = 2 * hstep;
    const unsigned ldsw = (unsigned)wid * 1024u;
    const int aoff = lds_byte(wr * 64 + fr, fq * 8), boff = lds_byte(wc * 32 + fr, fq * 8);
#define PG8_SA(b, h) (((b) * 2 + (h)) * HTB)
#define PG8_SB(b, h) ((4 + (b) * 2 + (h)) * HTB)
#define PG8_STAGE(bufoff, gbase, voff) do { _Pragma("unroll") for (int _i = 0; _i < 2; ++_i) \
        __builtin_amdgcn_global_load_lds((const unsigned*)((const char*)(gbase) + (voff)[_i]), (PG8_LAS unsigned*)(lds + (bufoff) + ldsw + _i * 8192), 16, 0, 0); } while (0)
#define PG8_LDA(dst, b, h) do { _Pragma("unroll") for (int m = 0; m < 4; ++m) _Pragma("unroll") for (int k = 0; k < 2; ++k) dst[m][k] = *(const PG8_LAS bf16x8*)(lds + PG8_SA(b, h) + aoff + m * 2048 + k * 1024); } while (0)
#define PG8_LDB(dst, b, h) do { _Pragma("unroll") for (int n = 0; n < 2; ++n) _Pragma("unroll") for (int k = 0; k < 2; ++k) dst[n][k] = *(const PG8_LAS bf16x8*)(lds + PG8_SB(b, h) + boff + n * 2048 + k * 1024); } while (0)
#define PG8_MMA(ai, bj, At, Bt) do { __builtin_amdgcn_s_setprio(1); _Pragma("unroll") for (int m = 0; m < 4; ++m) _Pragma("unroll") for (int n = 0; n < 2; ++n) _Pragma("unroll") for (int k = 0; k < 2; ++k) \
        acc[ai][bj][m][n] = __builtin_amdgcn_mfma_f32_16x16x32_bf16(Bt[n][k], At[m][k], acc[ai][bj][m][n], 0, 0, 0); __builtin_amdgcn_s_setprio(0); } while (0)
#define PG8_WAIT_V(n) asm volatile("s_waitcnt vmcnt(" #n ")" ::: "memory")
#define PG8_WAIT_L(n) asm volatile("s_waitcnt lgkmcnt(" #n ")" ::: "memory")
#define PG8_BAR __builtin_amdgcn_s_barrier()
#define PG8_SCHED __builtin_amdgcn_sched_barrier(0)
    Unit cur, nxt; int ui = 0;
    if (!S.next(0, cur)) return;
    f32x4 acc[2][2][4][2];
#pragma unroll
    for (int a = 0; a < 2; ++a)
#pragma unroll
        for (int b = 0; b < 2; ++b)
#pragma unroll
            for (int m = 0; m < 4; ++m)
#pragma unroll
                for (int n = 0; n < 2; ++n) acc[a][b][m][n] = (f32x4){0.f, 0.f, 0.f, 0.f};
    bf16x8 At[4][2], B0[2][2], B1[2][2];
    const char* cA = (const char*)g.A + (size_t)cur.pm * tstep; const char* cB = (const char*)g.Bt + (size_t)cur.pn * tstep;
    S.a_ready(cur);
    if constexpr (SP2) {
        PG8_STAGE(PG8_SB(0, 0), cB, voffB); PG8_STAGE(PG8_SB(0, 1), cB + hstep, voffB); PG8_STAGE(PG8_SA(0, 0), cA, voffA); PG8_STAGE(PG8_SA(0, 1), cA + hstep, voffA);
        if (wr == 1) PG8_BAR;
        PG8_WAIT_V(2); PG8_BAR;
        PG8_STAGE(PG8_SB(1, 0), cB + kstep, voffB); PG8_STAGE(PG8_SA(1, 0), cA + kstep, voffA); PG8_STAGE(PG8_SB(1, 1), cB + hstep + kstep, voffB);
        PG8_WAIT_V(6); PG8_BAR;
    } else {
        PG8_STAGE(PG8_SB(0, 0), cB, voffB); PG8_STAGE(PG8_SA(0, 0), cA, voffA); PG8_STAGE(PG8_SB(0, 1), cB + hstep, voffB); PG8_STAGE(PG8_SA(0, 1), cA + hstep, voffA);
        if (wr == 1) PG8_BAR;
        PG8_WAIT_V(4); PG8_BAR;
        PG8_STAGE(PG8_SB(1, 0), cB + kstep, voffB); PG8_STAGE(PG8_SA(1, 0), cA + kstep, voffA); PG8_STAGE(PG8_SB(1, 1), cB + hstep + kstep, voffB);
        PG8_WAIT_V(6); PG8_BAR;
    }
    for (;;) {
        const bool has_next = S.next(ui + 1, nxt);
        const char* nA = has_next ? (const char*)g.A + (size_t)nxt.pm * tstep : cA; const char* nB = has_next ? (const char*)g.Bt + (size_t)nxt.pn * tstep : cB;
        for (int t = 0; t < nt; t += 2) {
            const bool last = (t == nt - 2);
            const char* a1 = cA + (size_t)(t + 1) * kstep;
            const char* a2 = last ? nA : cA + (size_t)(t + 2) * kstep; const char* b2 = last ? nB : cB + (size_t)(t + 2) * kstep;
            const char* a3 = a2 + kstep; const char* b3 = b2 + kstep;
            if (last && has_next) S.a_ready(nxt);
            if constexpr (SP2) {
            PG8_LDB(B0, 0, 0); PG8_LDB(B1, 0, 1); PG8_SCHED; PG8_LDA(At, 0, 0); PG8_STAGE(PG8_SA(1, 1), a1 + hstep, voffA);
            PG8_WAIT_V(8); PG8_WAIT_L(0); PG8_BAR; PG8_MMA(0, 0, At, B0); PG8_MMA(0, 1, At, B1); PG8_BAR; PG8_SCHED;
            PG8_LDA(At, 0, 1); PG8_STAGE(PG8_SB(0, 0), b2, voffB); PG8_STAGE(PG8_SB(0, 1), b2 + hstep, voffB); PG8_STAGE(PG8_SA(0, 0), a2, voffA);
            PG8_WAIT_V(8); PG8_WAIT_L(0); PG8_BAR; PG8_MMA(1, 0, At, B0); PG8_MMA(1, 1, At, B1); PG8_BAR; PG8_SCHED;
            PG8_LDB(B0, 1, 0); PG8_LDB(B1, 1, 1); PG8_SCHED; PG8_LDA(At, 1, 0); PG8_STAGE(PG8_SA(0, 1), a2 + hstep, voffA);
            PG8_WAIT_V(8); PG8_WAIT_L(0); PG8_BAR; PG8_MMA(0, 0, At, B0); PG8_MMA(0, 1, At, B1); PG8_BAR; PG8_SCHED;
            PG8_LDA(At, 1, 1); PG8_STAGE(PG8_SB(1, 0), b3, voffB); PG8_STAGE(PG8_SB(1, 1), b3 + hstep, voffB); PG8_STAGE(PG8_SA(1, 0), a3, voffA);
            PG8_WAIT_V(8); PG8_WAIT_L(0); PG8_BAR; PG8_MMA(1, 0, At, B0); PG8_MMA(1, 1, At, B1); PG8_BAR; PG8_SCHED;
            } else {
            PG8_LDB(B0, 0, 0); PG8_SCHED; PG8_LDA(At, 0, 0); PG8_STAGE(PG8_SA(1, 1), a1 + hstep, voffA);
            PG8_WAIT_L(8); PG8_BAR; PG8_WAIT_L(0); PG8_MMA(0, 0, At, B0); PG8_BAR; PG8_SCHED;
            PG8_LDB(B1, 0, 1); PG8_STAGE(PG8_SB(0, 0), b2, voffB);
            PG8_BAR; PG8_WAIT_L(0); PG8_MMA(0, 1, At, B1); PG8_BAR;
            PG8_LDA(At, 0, 1); PG8_STAGE(PG8_SA(0, 0), a2, voffA);
            PG8_BAR; PG8_WAIT_L(0); PG8_MMA(1, 0, At, B0); PG8_BAR; PG8_SCHED;
            PG8_STAGE(PG8_SB(0, 1), b2 + hstep, voffB);
            PG8_WAIT_V(6); PG8_BAR; PG8_MMA(1, 1, At, B1); PG8_BAR;
            PG8_LDB(B0, 1, 0); PG8_SCHED; PG8_LDA(At, 1, 0); PG8_STAGE(PG8_SA(0, 1), a2 + hstep, voffA);
            PG8_WAIT_L(8); PG8_BAR; PG8_WAIT_L(0); PG8_MMA(0, 0, At, B0); PG8_BAR; PG8_SCHED;
            PG8_LDB(B1, 1, 1); PG8_STAGE(PG8_SB(1, 0), b3, voffB);
            PG8_BAR; PG8_WAIT_L(0); PG8_MMA(0, 1, At, B1); PG8_BAR;
            PG8_LDA(At, 1, 1); PG8_STAGE(PG8_SA(1, 0), a3, voffA);
            PG8_BAR; PG8_WAIT_L(0); PG8_MMA(1, 0, At, B0); PG8_BAR; PG8_SCHED;
            PG8_STAGE(PG8_SB(1, 1), b3 + hstep, voffB);
            PG8_WAIT_V(6); PG8_BAR; PG8_MMA(1, 1, At, B1); PG8_BAR;
            }
        }
        if constexpr (ALIGN_EPI) { if (wr == 0) PG8_BAR; }
        if constexpr (!Epi::AFTER_DRAIN) { E(acc, cur, wr, wc, fr, fq); S.done(cur); }
        if (!has_next) break;
        if (!E.keep(cur)) {
#pragma unroll
        for (int a = 0; a < 2; ++a)
#pragma unroll
            for (int b = 0; b < 2; ++b)
#pragma unroll
                for (int m = 0; m < 4; ++m)
#pragma unroll
                    for (int n = 0; n < 2; ++n) acc[a][b][m][n] = (f32x4){0.f, 0.f, 0.f, 0.f};
        }
        cur = nxt; cA = nA; cB = nB; ++ui;
        if constexpr (ALIGN_EPI) { if (wr == 1) PG8_BAR; }
    }
    PG8_WAIT_V(0);
    if constexpr (!ALIGN_EPI) { if (wr == 0) PG8_BAR; }
    PG8_BAR;
    if constexpr (Epi::AFTER_DRAIN) { E.fused(acc, cur, wr, wc, fr, fq, lds, wid, lane); S.done(cur); }
#undef PG8_SA
#undef PG8_SB
#undef PG8_STAGE
#undef PG8_LDA
#undef PG8_LDB
#undef PG8_MMA
#undef PG8_WAIT_V
#undef PG8_WAIT_L
#undef PG8_BAR
#undef PG8_SCHED
}
}

namespace {
struct InProjF {
    bf16_t* PROJ; const float* bias; float* out;
    __device__ __forceinline__ void operator()(int row, int col, float* v) const {
        const f32x4 b0 = *(const f32x4*)(bias + col), b1 = *(const f32x4*)(bias + col + 4);
        v[0] += b0[0]; v[1] += b0[1]; v[2] += b0[2]; v[3] += b0[3]; v[4] += b1[0]; v[5] += b1[1]; v[6] += b1[2]; v[7] += b1[3];
        store_bf16x8(PROJ + (size_t)row * NIN + col, v);
        if (col >= C_K && col < C_HQ) {
            const int kv = col - C_K, which = kv / 1536, rem = kv % 1536, g = rem >> 9, hd = rem & 511;
            const int W = g == 0 ? 128 : (g == 1 ? 512 : 2048);
            if (row < MP) { const int b = row >> 13, t = row & 8191;
                if (t >= SEQ - W) { float* pw = out + (g == 0 ? O_PW1 : (g == 1 ? O_PW2 : O_PW3)); store_f32x8(pw + (((size_t)b * W + (t - (SEQ - W))) * 2 + which) * 512 + hd, v); } }
            else { const int sb = (row - MP) >> 3, st = (row - MP) & 7; float* sw = out + (g == 0 ? O_SW1 : (g == 1 ? O_SW2 : O_SW3));
                store_f32x8(sw + (((size_t)sb * W + (W - 8 + st)) * 2 + which) * 512 + hd, v); }
        }
    }
};
__device__ __forceinline__ void phase_inproj(const Params& P, unsigned char* lds) {
    float* red = (float*)lds; unsigned char* ws = P.ws;
    const bf16_t* XN = (const bf16_t*)(ws + WS_XN); const bf16_t* WT = (const bf16_t*)(ws + WS_WIN_T);
    const InProjF f{(bf16_t*)(ws + WS_PROJ), P.in[14], P.out};
    {
        pg8::Gemm g{XN, WT, MP, NIN, D}; pg8::StaticOrder S; S.init(MP, NIN, (int)gridDim.x, (int)blockIdx.x);
        const pg8::Epi8<InProjF> E{f};
        pg8::gemm_phase<pg8::Epi8<InProjF>, pg8::StaticOrder, true, true>((PG8_LAS unsigned char*)lds, g, S, E);
    }
    constexpr int NU_S = 4 * (NIN / 64), NU_MEM = 8 * 16;
    for (int u = blockIdx.x; u < NU_S + NU_MEM; u += gridDim.x) {
        if (u < NU_S) { const int tr = 256 + (u & 3), tc = u >> 2; sgemm_unit(XN, D, WT, D, D, tr * 64, tc * 64, red, f); }
        else {
            const int q = u - NU_S, tr = q % 8, tc = q / 8;
            bf16_t* MEMKV = (bf16_t*)(ws + WS_MEMKV); float* out = P.out;
            sgemm_unit((const bf16_t*)(ws + WS_MEMN), D, (const bf16_t*)(ws + WS_WMEM_T), D, D, tr * 64, tc * 64, red, [&](int row, int col, float* v) {
                store_f32x8(out + O_PMEM + (size_t)row * 1024 + col, v); store_bf16x8(MEMKV + (size_t)row * 1024 + col, v); });
        }
    }
}

struct AttnUnit {
    const bf16_t* q; long q_rs; const bf16_t* k; long k_rs; const bf16_t* v; long v_rs; int k_valid_from;
    bf16_t* o; long o_rs; float* lse; long lse_rs; const float* bias;
};
struct AttnRegs { u32x4 kv[8], vv[8]; bf16x8 qa[4]; };
__device__ __forceinline__ void attn_load(const AttnUnit& U, AttnRegs& R) {
    const int tid = threadIdx.x, lane = tid & 63, wave = tid >> 6, fr = lane & 15, fq = lane >> 4;
#pragma unroll
    for (int it = 0; it < 8; ++it) { const int idx = tid + NTHR * it, j = idx >> 4, c = idx & 15;
        R.kv[it] = (u32x4){0u, 0u, 0u, 0u}; R.vv[it] = (u32x4){0u, 0u, 0u, 0u};
        if (j >= U.k_valid_from) { R.kv[it] = *(const u32x4*)(U.k + (long)j * U.k_rs + c * 8); R.vv[it] = *(const u32x4*)(U.v + (long)j * U.v_rs + c * 8); } }
    const bf16_t* qp = U.q + (long)(wave * 16 + fr) * U.q_rs + fq * 8;
#pragma unroll
    for (int kk = 0; kk < 4; ++kk) R.qa[kk] = *(const bf16x8*)(qp + kk * 32);
}
constexpr int ATT_KS = 136, ATT_VS = 144;
constexpr int ATT_VOFF = 256 * ATT_KS * 2, ATT_BOFF = ATT_VOFF + 256 * ATT_VS * 2;
typedef short v4i16_t __attribute__((ext_vector_type(4)));
__device__ __forceinline__ void attn_stage(const AttnRegs& R, const float* bias, unsigned char* lds) {
    bf16_t* Ks = (bf16_t*)lds; bf16_t* Vs = (bf16_t*)(lds + ATT_VOFF); float* btab = (float*)(lds + ATT_BOFF);
    const int tid = threadIdx.x;
#pragma unroll
    for (int it = 0; it < 8; ++it) { const int idx = tid + NTHR * it, j = idx >> 4, c = idx & 15;
        *(u32x4*)(Ks + j * ATT_KS + c * 8) = R.kv[it]; *(u32x4*)(Vs + j * ATT_VS + c * 8) = R.vv[it]; }
    if (bias && tid < 129) btab[tid] = bias[tid];
}
template <class Mid> __device__ __forceinline__ void attn_compute(const AttnUnit& U, const bf16x8 (&qa)[4], unsigned char* lds, const Mid& mid) {
    const bf16_t* Ks = (const bf16_t*)lds; const float* btab = (const float*)(lds + ATT_BOFF);
    const int tid = threadIdx.x, lane = tid & 63, wave = tid >> 6, fr = lane & 15, fq = lane >> 4;
    f32x4 s[16];
#pragma unroll
    for (int kb = 0; kb < 16; ++kb) { s[kb] = (f32x4){0.f, 0.f, 0.f, 0.f};
#pragma unroll
        for (int kk = 0; kk < 4; ++kk) { const bf16x8 kf = *(const bf16x8*)(Ks + (kb * 16 + fr) * ATT_KS + kk * 32 + fq * 8); s[kb] = __builtin_amdgcn_mfma_f32_16x16x32_bf16(kf, qa[kk], s[kb], 0, 0, 0); } }
    const float scale = 0.08838834764831845f;
    const bool banded = U.bias != nullptr; const int vfrom = U.k_valid_from; int qi = wave * 16 + fr;
    asm volatile("" : "+v"(qi));
    float mx = -3.0e38f;
#pragma unroll
    for (int kb = 0; kb < 16; ++kb)
#pragma unroll
        for (int r = 0; r < 4; ++r) { float x = s[kb][r] * scale;
            if (banded) { const int kj = kb * 16 + 4 * fq + r, lag = 128 + qi - kj; const bool ok = lag >= 0 && lag <= 128 && kj >= vfrom; x = ok ? x + btab[ok ? lag : 0] : -1.0e30f; }
            s[kb][r] = x; mx = fmaxf(mx, x); }
    mx = fmaxf(mx, __shfl_xor(mx, 16)); mx = fmaxf(mx, __shfl_xor(mx, 32));
    float sum = 0.f;
#pragma unroll
    for (int kb = 0; kb < 16; ++kb)
#pragma unroll
        for (int r = 0; r < 4; ++r) { const float p = __expf(s[kb][r] - mx); s[kb][r] = p; sum += p; }
    sum += __shfl_xor(sum, 16); sum += __shfl_xor(sum, 32);
    mid();
    f32x4 o[8];
#pragma unroll
    for (int db = 0; db < 8; ++db) o[db] = (f32x4){0.f, 0.f, 0.f, 0.f};
    typedef __attribute__((address_space(3))) v4i16_t* lds_v4;
    unsigned vaddr0 = (unsigned)(uintptr_t)(lds + ATT_VOFF) + (unsigned)((4 * fq + ((lane >> 2) & 3)) * (ATT_VS * 2) + (lane & 3) * 8);
    unsigned vaddr1 = vaddr0 + 4 * 32 * (ATT_VS * 2);
    asm volatile("" : "+v"(vaddr0), "+v"(vaddr1));
#pragma unroll
    for (int ks = 0; ks < 8; ++ks) {
        const unsigned vaddr = (ks < 4 ? vaddr0 : vaddr1) - (unsigned)((ks < 4 ? 0 : 4) * 32 * (ATT_VS * 2));
        u32x4 pw; pw.x = pk2(s[2 * ks][0], s[2 * ks][1]); pw.y = pk2(s[2 * ks][2], s[2 * ks][3]); pw.z = pk2(s[2 * ks + 1][0], s[2 * ks + 1][1]); pw.w = pk2(s[2 * ks + 1][2], s[2 * ks + 1][3]);
        const bf16x8 pf = __builtin_bit_cast(bf16x8, pw);
#pragma unroll
        for (int db = 0; db < 8; ++db) {
            const v4i16_t lo = __builtin_amdgcn_ds_read_tr16_b64_v4i16((lds_v4)(uintptr_t)(vaddr + ks * 32 * (ATT_VS * 2) + db * 32));
            const v4i16_t hi = __builtin_amdgcn_ds_read_tr16_b64_v4i16((lds_v4)(uintptr_t)(vaddr + (ks * 32 + 16) * (ATT_VS * 2) + db * 32));
            const bf16x8 vf = (bf16x8){lo[0], lo[1], lo[2], lo[3], hi[0], hi[1], hi[2], hi[3]};
            o[db] = __builtin_amdgcn_mfma_f32_16x16x32_bf16(pf, vf, o[db], 0, 0, 0); } }
#pragma unroll
    for (int r = 0; r < 4; ++r) { const float inv = 1.0f / __shfl(sum, 4 * fq + r); bf16_t* op = U.o + (long)(wave * 16 + 4 * fq + r) * U.o_rs + fr;
#pragma unroll
        for (int db = 0; db < 8; ++db) op[db * 16] = (bf16_t)f2bf(o[db][r] * inv); }
    if (U.lse && lane < 16) U.lse[(long)qi * U.lse_rs] = mx + __logf(sum);
}
__device__ __forceinline__ void attn_make_unit(const Params& P, int r, AttnUnit& U) {
    unsigned char* ws = P.ws; bf16_t* PROJ = (bf16_t*)(ws + WS_PROJ); const float* BT = (const float*)(ws + WS_TAB);
    constexpr int N_DIL = 3 * 2 * 4 * 64;
    if (r < N_DIL) {
        const int g = r / 512, b = (r >> 8) & 1, h = (r >> 6) & 3, rb = r & 63;
        const int dil = g == 0 ? 1 : (g == 1 ? 4 : 16); const int nbper = 64 / dil; const int res = rb / nbper, n = rb % nbper;
        const long base = (long)b * SEQ + (long)n * 128 * dil + res; const long kbase = base - (long)128 * dil;
        U.q = PROJ + base * NIN + C_Q + g * 512 + h * 128; U.q_rs = (long)dil * NIN;
        U.k = PROJ + kbase * NIN + C_K + g * 512 + h * 128; U.k_rs = (long)dil * NIN; U.v = PROJ + kbase * NIN + C_V + g * 512 + h * 128; U.v_rs = (long)dil * NIN;
        U.k_valid_from = n == 0 ? 128 : 0;
        U.o = (bf16_t*)(ws + WS_ATTO) + ((long)g * MT + base) * 512 + h * 128; U.o_rs = (long)dil * 512;
        U.lse = (float*)(ws + WS_LSE) + ((long)g * MT + base) * 4 + h; U.lse_rs = (long)dil * 4; U.bias = BT + (g * 4 + h) * 132;
    } else {
        const int q = r - N_DIL; const int b = q >> 8, h = (q >> 6) & 3, n = q & 63; const long base = (long)b * SEQ + (long)n * 128;
        const bf16_t* MEMKV = (const bf16_t*)(ws + WS_MEMKV);
        U.q = PROJ + base * NIN + C_MQ + h * 128; U.q_rs = NIN; U.k = MEMKV + (long)b * 256 * 1024 + h * 128; U.k_rs = 1024; U.v = U.k + 512; U.v_rs = 1024; U.k_valid_from = 0;
        U.o = (bf16_t*)(ws + WS_ABR) + ((long)2 * MT + base) * 512 + h * 128; U.o_rs = 512; U.lse = nullptr; U.lse_rs = 0; U.bias = nullptr;
    }
}
__device__ __forceinline__ void attn_units(const Params& P, unsigned char* lds) {
    constexpr int NU = 3 * 2 * 4 * 64 + 2 * 4 * 64;
    int it = blockIdx.x; if (it >= NU) return;
    AttnUnit U; AttnRegs R; attn_make_unit(P, it, U); attn_load(U, R);
    for (;;) {
        __syncthreads();
        attn_stage(R, U.bias, lds);
        bf16x8 qa[4];
#pragma unroll
        for (int kk = 0; kk < 4; ++kk) qa[kk] = R.qa[kk];
        __syncthreads();
        const int nx = it + gridDim.x;
        attn_compute(U, qa, lds, [&]() { if (nx < NU) { AttnUnit UN; attn_make_unit(P, nx, UN); attn_load(UN, R); } });
        if (nx >= NU) break;
        attn_make_unit(P, nx, U); it = nx;
    }
}

template <class KeyPtr, class ValPtr>
__device__ __forceinline__ void sample_attn_item(const bf16_t* qrow0  , int nk, const float* biastab  , KeyPtr kptr, ValPtr vptr,
                                                 bf16_t* orow0, long o_rs, float* lse0, long lse_rs, unsigned char* lds) {
    float* qs = (float*)lds;
    float* ps = qs + 1024;
    float* st = ps + 8 * 260;
    const int tid = threadIdx.x, lane = tid & 63, wave = tid >> 6;
    __syncthreads();
    for (int idx = tid; idx < 1024; idx += NTHR) { const int t = idx >> 7, d = idx & 127; qs[idx] = bf2f(qrow0[(long)t * NIN + d]) * 0.08838834764831845f; }
    __syncthreads();
    for (int idx = tid; idx < 8 * nk; idx += NTHR) { const int t = idx / nk, j = idx - t * nk; const f32x4* kp = (const f32x4*)kptr(t, j); const f32x4* qp = (const f32x4*)(qs + t * 128);
        float acc = 0.f;
#pragma unroll 8
        for (int d = 0; d < 32; ++d) { const f32x4 a = kp[d], b = qp[d]; acc += (a.x * b.x + a.y * b.y) + (a.z * b.z + a.w * b.w); }
        ps[t * 260 + j] = acc + (biastab ? biastab[j] : 0.f); }
    __syncthreads();
    { const int t = wave; float m = -3.0e38f;
      for (int j = lane; j < nk; j += 64) m = fmaxf(m, ps[t * 260 + j]);
#pragma unroll
      for (int o = 1; o < 64; o <<= 1) m = fmaxf(m, __shfl_xor(m, o));
      float s = 0.f;
      for (int j = lane; j < nk; j += 64) { const float p = __expf(ps[t * 260 + j] - m); ps[t * 260 + j] = p; s += p; }
      s = wave_sum(s);
      if (lane == 0) { st[t] = 1.0f / s; if (lse0) lse0[(long)t * lse_rs] = m + __logf(s); } }
    __syncthreads();
    { const int t = wave; f32x2 acc = (f32x2){0.f, 0.f};
      for (int j = 0; j < nk; ++j) { const float p = ps[t * 260 + j]; const f32x2 vv = ((const f32x2*)vptr(t, j))[lane]; acc.x += p * vv.x; acc.y += p * vv.y; }
      const float inv = st[t];
      *(unsigned*)(orow0 + (long)t * o_rs + 2 * lane) = pk2(acc.x * inv, acc.y * inv); }
}

__device__ __forceinline__ void sample_hgrn_item(const Params& P, int sb, int h, unsigned char* lds) {
    float* fs = (float*)lds;
    float* ks = fs + 1024;
    float* qs = ks + 1024;
    float* is_ = qs + 1024;
    float* part = is_ + 1024;
    float* osq = part + 512;
    const int tid = threadIdx.x, lane = tid & 63, wave = tid >> 6;
    const bf16_t* PROJ = (const bf16_t*)(P.ws + WS_PROJ); const float* LB = (const float*)(P.ws + WS_TAB) + 3 * 4 * 132;
    __syncthreads();
    for (int idx = tid; idx < 1024; idx += NTHR) { const int t = idx >> 7, k = idx & 127; const bf16_t* pr = PROJ + (size_t)(MP + sb * 8 + t) * NIN + h * 128 + k;
        const float lb = LB[h * 128 + k]; const float f = lb + (1.0f - lb) * sigmoidf_(bf2f(pr[C_HF]));
        fs[idx] = f; ks[idx] = 1.0f - f; qs[idx] = bf2f(pr[C_HQ]); is_[idx] = bf2f(pr[C_HI]); }
    const int v = tid & 127, kq = tid >> 7;
    const float* s_in = P.in[7] + ((size_t)(sb * 4 + h) * 128) * 128; float* s_out = P.out + O_SHG + ((size_t)(sb * 4 + h) * 128) * 128;
    float S[32];
#pragma unroll
    for (int i = 0; i < 32; ++i) S[i] = s_in[(size_t)(kq * 32 + i) * 128 + v];
    __syncthreads();
    const float gain = P.in[15][v];
    for (int t = 0; t < 8; ++t) {
        const float iv = is_[t * 128 + v]; float po = 0.f;
#pragma unroll
        for (int i = 0; i < 32; ++i) { const int k = kq * 32 + i; S[i] = fs[t * 128 + k] * S[i] + ks[t * 128 + k] * iv; po += S[i] * qs[t * 128 + k]; }
        part[kq * 128 + v] = po;
        __syncthreads();
        if (tid < 128) { const float o = (part[v] + part[128 + v]) + (part[256 + v] + part[384 + v]);
            const float ss = wave_sum(o * o); if (lane == 0) osq[wave] = ss;
            part[v] = o; }
        __syncthreads();
        if (tid < 128) { const float o = part[v]; const float r = rsqrtf((osq[0] + osq[1]) * (1.0f / 128.0f) + EPS);
            const size_t row = (size_t)(MP + sb * 8 + t); const float gate = sigmoidf_(bf2f(PROJ[row * NIN + C_HG + h * 128 + v]));
            ((bf16_t*)(P.ws + WS_ABR))[((size_t)1 * MT + row) * 512 + h * 128 + v] = (bf16_t)f2bf(o * r * gain * gate); }
        __syncthreads();
    }
#pragma unroll
    for (int i = 0; i < 32; ++i) s_out[(size_t)(kq * 32 + i) * 128 + v] = S[i];
}

__device__ __forceinline__ void hgrn_local_unit(const Params& P, int bh, int c, unsigned char* lds) {
    float* Gs = (float*)lds;
    float* Qs = Gs + 8192;
    float* Kk = Qs + 8192;
    float* Vs = Kk + 8192;
    float* Sc = Vs + 8192;
    const int tid = threadIdx.x, lane = tid & 63;
    const int b = bh >> 2, h = bh & 3; const size_t row0 = (size_t)b * SEQ + (size_t)c * 64;
    const bf16_t* PROJ = (const bf16_t*)(P.ws + WS_PROJ); const float* LB = (const float*)(P.ws + WS_TAB) + 3 * 4 * 132;
    __syncthreads();
    for (int idx = tid; idx < 8192; idx += NTHR) { const int t = idx >> 7, k = idx & 127; const bf16_t* pr = PROJ + (row0 + t) * NIN + h * 128 + k;
        const float lb = LB[h * 128 + k]; const float f = lb + (1.0f - lb) * sigmoidf_(bf2f(pr[C_HF]));
        Gs[idx] = logf(f); Kk[idx] = 1.0f - f; Qs[idx] = bf2f(pr[C_HQ]); Vs[idx] = bf2f(pr[C_HI]); }
    __syncthreads();
    if (tid < 128) { float a = 0.f; for (int t = 0; t < 64; ++t) { a += Gs[t * 128 + tid]; Gs[t * 128 + tid] = a; } }
    __syncthreads();
    { bf16_t* HQT = (bf16_t*)(P.ws + WS_HQT);
      for (int idx = tid; idx < 8192; idx += NTHR) { const int t = idx >> 7, k = idx & 127; HQT[(row0 + t) * 512 + h * 128 + k] = (bf16_t)f2bf(Qs[idx] * __expf(Gs[idx])); }
      if (tid < 128) ((float*)(P.ws + WS_DC))[((size_t)bh * 128 + c) * 128 + tid] = __expf(Gs[63 * 128 + tid]); }
    { const int t = tid >> 3, sub = tid & 7;
      for (int s = sub; s < 64; s += 8) { float acc = 0.f;
          if (s <= t) { for (int kk = 0; kk < 128; ++kk) { const int k = (kk + lane) & 127; acc += Qs[t * 128 + k] * Kk[s * 128 + k] * __expf(Gs[t * 128 + k] - Gs[s * 128 + k]); } }
          Sc[t * 64 + s] = acc; } }
    __syncthreads();
    { const int t = tid >> 3, v0 = (tid & 7) * 16; f32x4 o[4];
#pragma unroll
      for (int i = 0; i < 4; ++i) o[i] = (f32x4){0.f, 0.f, 0.f, 0.f};
      for (int s = 0; s <= t; ++s) { const float p = Sc[t * 64 + s]; const f32x4* vp = (const f32x4*)(Vs + s * 128 + v0);
#pragma unroll
          for (int i = 0; i < 4; ++i) o[i] += p * vp[i]; }
      f32x4* op = (f32x4*)((float*)(P.ws + WS_OINTRA) + (row0 + t) * 512 + h * 128 + v0);
#pragma unroll
      for (int i = 0; i < 4; ++i) op[i] = o[i]; }
    for (int idx = tid; idx < 8192; idx += NTHR) { const int k = idx & 127; Kk[idx] = Kk[idx] * __expf(Gs[63 * 128 + k] - Gs[idx]); }
    __syncthreads();
    { const int k = tid >> 2, v0 = (tid & 3) * 32; f32x4 u[8];
#pragma unroll
      for (int i = 0; i < 8; ++i) u[i] = (f32x4){0.f, 0.f, 0.f, 0.f};
      for (int s = 0; s < 64; ++s) { const float kt = Kk[s * 128 + k]; const f32x4* vp = (const f32x4*)(Vs + s * 128 + v0);
#pragma unroll
          for (int i = 0; i < 8; ++i) u[i] += kt * vp[i]; }
      f32x4* up = (f32x4*)((float*)(P.ws + WS_U) + ((size_t)bh * 128 + c) * 16384 + k * 128 + v0);
#pragma unroll
      for (int i = 0; i < 8; ++i) up[i] = u[i]; }
}

__device__ __forceinline__ void phase_mix1(const Params& P, unsigned char* lds) {
    unsigned char* ws = P.ws; bf16_t* PROJ = (bf16_t*)(ws + WS_PROJ);
    const float* BT = (const float*)(ws + WS_TAB);
    constexpr int N_DIL = 3 * 2 * 4 * 64, N_MEM = 2 * 4 * 64, N_HL = 8 * 128, N_SA = 32 * 3 * 4, N_SM = 32 * 4, N_SH = 32 * 4;
    constexpr int NTOT = N_HL + N_SA + N_SM + N_SH;
    if (MIX1_SEL & 1) attn_units(P, lds);
    for (int it = blockIdx.x; it < NTOT; it += gridDim.x) {
        int r = it;
        if (r < N_HL) { if (MIX1_SEL & 4) hgrn_local_unit(P, r >> 7, r & 127, lds); continue; }
        r -= N_HL;
        if (r < N_SA + N_SM) {
            int sb, g, h;
            if (r < N_SA) { sb = r / 12; g = (r / 4) % 3; h = r & 3; } else { const int q = r - N_SA; sb = q >> 2; g = 3; h = q & 3; }
            const int W = g == 0 ? 128 : (g == 1 ? 512 : (g == 2 ? 2048 : 256)), dil = g == 0 ? 1 : (g == 1 ? 4 : (g == 2 ? 16 : -1));
            const float* cache = (g == 0 ? P.in[3] : (g == 1 ? P.in[4] : (g == 2 ? P.in[5] : P.in[6]))) + (size_t)sb * W * 1024 + h * 128;
            const float* neu = P.out + (g == 0 ? O_SW1 : (g == 1 ? O_SW2 : O_SW3)) + ((size_t)sb * W + (W - 8)) * 1024 + h * 128;
            const long row0 = MP + sb * 8;
            const int tq = g < 3 ? 1 : 0, base_idx = g < 3 ? W : 0;
            auto kp = [&](int t, int j) { const int idx = base_idx + tq * t - dil * j; return idx < W ? cache + (size_t)idx * 1024 : neu + (size_t)(idx - W) * 1024; };
            bf16_t* op = g < 3 ? (bf16_t*)(ws + WS_ATTO) + ((long)g * MT + row0) * 512 + h * 128 : (bf16_t*)(ws + WS_ABR) + ((long)2 * MT + row0) * 512 + h * 128;
            if (MIX1_SEL & 8) sample_attn_item(PROJ + row0 * NIN + (g < 3 ? C_Q + g * 512 : C_MQ) + h * 128, g < 3 ? 129 : 256, g < 3 ? BT + (g * 4 + h) * 132 : nullptr,
                kp, [&](int t, int j) { return kp(t, j) + 512; }, op, 512, g < 3 ? (float*)(ws + WS_LSE) + ((long)g * MT + row0) * 4 + h : nullptr, 4, lds);
            continue; }
        r -= N_SA;
        r -= N_SM;
        if (MIX1_SEL & 32) sample_hgrn_item(P, r >> 2, r & 3, lds);
    }
}

__device__ __forceinline__ void phase_scan(const Params& P) {
    const float* __restrict__ U = (const float*)(P.ws + WS_U); const float* __restrict__ DC = (const float*)(P.ws + WS_DC); float* __restrict__ S0 = (float*)(P.ws + WS_S0);
    for (int e = blockIdx.x * NTHR + threadIdx.x; e < 8 * 16384; e += gridDim.x * NTHR) {
        const int bh = e >> 14, kv = e & 16383, k = kv >> 7; float S = 0.f;
        const float* up = U + (size_t)bh * 128 * 16384 + kv; const float* dp = DC + (size_t)bh * 128 * 128 + k; float* sp = S0 + (size_t)bh * 128 * 16384 + kv;
        for (int c0 = 0; c0 < 128; c0 += 16) {
            float u[16], d[16];
#pragma unroll
            for (int i = 0; i < 16; ++i) { u[i] = up[(size_t)(c0 + i) * 16384]; d[i] = dp[(c0 + i) * 128]; }
#pragma unroll
            for (int i = 0; i < 16; ++i) { sp[(size_t)(c0 + i) * 16384] = S; S = d[i] * S + u[i]; }
        }
        P.out[O_PHG + (size_t)bh * 16384 + kv] = S;
    }
}

__device__ __forceinline__ void hgrn_final_unit(const Params& P, int bh, int c, unsigned char* lds) {
    float* Ss = (float*)lds;
    float* Qt = Ss + 16384;
    const int tid = threadIdx.x; const int b = bh >> 2, h = bh & 3; const size_t row0 = (size_t)b * SEQ + (size_t)c * 64;
    __syncthreads();
    { const f32x4* s4 = (const f32x4*)((const float*)(P.ws + WS_S0) + ((size_t)bh * 128 + c) * 16384);
      for (int idx = tid; idx < 4096; idx += NTHR) ((f32x4*)Ss)[idx] = s4[idx];
      const bf16_t* HQT = (const bf16_t*)(P.ws + WS_HQT);
      for (int idx = tid; idx < 1024; idx += NTHR) { const int t = idx >> 4, c8 = (idx & 15) * 8; float v[8]; load_bf16x8(HQT + (row0 + t) * 512 + h * 128 + c8, v);
#pragma unroll
          for (int e = 0; e < 8; ++e) Qt[t * 128 + c8 + e] = v[e]; } }
    __syncthreads();
    const int t = tid >> 3, v0 = (tid & 7) * 16; const size_t row = row0 + t;
    f32x4 o[4];
    { const f32x4* oi = (const f32x4*)((const float*)(P.ws + WS_OINTRA) + row * 512 + h * 128 + v0);
#pragma unroll
      for (int i = 0; i < 4; ++i) o[i] = oi[i]; }
    for (int k = 0; k < 128; ++k) { const float q = Qt[t * 128 + k]; const f32x4* sp = (const f32x4*)(Ss + k * 128 + v0);
#pragma unroll
        for (int i = 0; i < 4; ++i) o[i] += q * sp[i]; }
    float ss = 0.f;
#pragma unroll
    for (int i = 0; i < 4; ++i) ss += (o[i].x * o[i].x + o[i].y * o[i].y) + (o[i].z * o[i].z + o[i].w * o[i].w);
    ss += __shfl_xor(ss, 1); ss += __shfl_xor(ss, 2); ss += __shfl_xor(ss, 4);
    const float r = rsqrtf(ss * (1.0f / 128.0f) + EPS);
    const float* gain = P.in[15] + v0; const bf16_t* gp = (const bf16_t*)(P.ws + WS_PROJ) + row * NIN + C_HG + h * 128 + v0;
    float gt[16]; load_bf16x8(gp, gt); load_bf16x8(gp + 8, gt + 8);
    float res[16];
#pragma unroll
    for (int i = 0; i < 4; ++i) { res[4 * i + 0] = o[i].x * r * gain[4 * i + 0] * sigmoidf_(gt[4 * i + 0]); res[4 * i + 1] = o[i].y * r * gain[4 * i + 1] * sigmoidf_(gt[4 * i + 1]);
        res[4 * i + 2] = o[i].z * r * gain[4 * i + 2] * sigmoidf_(gt[4 * i + 2]); res[4 * i + 3] = o[i].w * r * gain[4 * i + 3] * sigmoidf_(gt[4 * i + 3]); }
    bf16_t* op = (bf16_t*)(P.ws + WS_ABR) + ((size_t)1 * MT + row) * 512 + h * 128 + v0;
    store_bf16x8(op, res); store_bf16x8(op + 8, res + 8);
}
__device__ __forceinline__ void phase_mix2(const Params& P, unsigned char* lds) {
    for (int it = blockIdx.x; it < 1024; it += gridDim.x) hgrn_final_unit(P, it >> 7, it & 127, lds);
    const int lane = threadIdx.x & 63, wave = threadIdx.x >> 6; const int gw = blockIdx.x * NWAVES + wave, NGW = gridDim.x * NWAVES;
    const bf16_t* ATTO = (const bf16_t*)(P.ws + WS_ATTO); const float* LSE = (const float*)(P.ws + WS_LSE); bf16_t* ABR = (bf16_t*)(P.ws + WS_ABR);
    for (int row = gw; row < MT; row += NGW) {
        const int h = lane >> 4; const float l0 = LSE[((size_t)0 * MT + row) * 4 + h], l1 = LSE[((size_t)1 * MT + row) * 4 + h], l2 = LSE[((size_t)2 * MT + row) * 4 + h];
        const float m = fmaxf(l0, fmaxf(l1, l2)); float w0 = __expf(l0 - m), w1 = __expf(l1 - m), w2 = __expf(l2 - m); const float inv = 1.0f / (w0 + w1 + w2); w0 *= inv; w1 *= inv; w2 *= inv;
        float a[8], b2[8], c2[8], o[8];
        load_bf16x8(ATTO + ((size_t)0 * MT + row) * 512 + lane * 8, a); load_bf16x8(ATTO + ((size_t)1 * MT + row) * 512 + lane * 8, b2); load_bf16x8(ATTO + ((size_t)2 * MT + row) * 512 + lane * 8, c2);
#pragma unroll
        for (int e = 0; e < 8; ++e) o[e] = w0 * a[e] + w1 * b2[e] + w2 * c2[e];
        store_bf16x8(ABR + (size_t)row * 512 + lane * 8, o);
    }
}

struct BranchOrder {
    pg8::StaticOrder so;
    __device__ __forceinline__ bool next(int i, pg8::Unit& u) const { pg8::Unit t; if (!so.next(i / 3, t)) return false; const int br = i % 3; u.pm = br * (MT / 256) + t.pm; u.pn = br * 4 + t.pn; return true; }
    __device__ __forceinline__ void a_ready(const pg8::Unit&) const {}
    __device__ __forceinline__ void done(const pg8::Unit&) const {}
};
struct EpiBranch {
    static constexpr bool PERM = true, AFTER_DRAIN = false; const bf16_t* PROJ; bf16_t* MERGED;
    __device__ __forceinline__ bool keep(const pg8::Unit& u) const { return (u.pn >> 2) < 2; }
    __device__ __forceinline__ void operator()(f32x4 (&acc)[2][2][4][2], const pg8::Unit& u, int wr, int wc, int fr, int fq) const {
        const int br = u.pn >> 2, pn = u.pn & 3, pm = u.pm - br * (MT / 256);
        const int row0 = pm * 256 + wr * 64 + fr, col0 = pn * 256 + wc * 32 + 8 * fq;
        const int gc = br == 0 ? C_GA : (br == 1 ? C_GH : C_GM), gn = br == 0 ? C_GH : C_GM;
#pragma unroll
        for (int ai = 0; ai < 2; ++ai)
#pragma unroll
            for (int m = 0; m < 4; ++m)
#pragma unroll
                for (int bj = 0; bj < 2; ++bj) {
                    const int row = row0 + ai * 128 + m * 16, col = col0 + bj * 128; const bf16_t* pr = PROJ + (size_t)row * NIN + col;
                    float gcur[8], fac[8]; load_bf16x8(pr + gc, gcur);
                    if (br < 2) { float gnx[8]; load_bf16x8(pr + gn, gnx);
#pragma unroll
                        for (int e = 0; e < 8; ++e) fac[e] = (1.0f + __expf(-gnx[e])) / (1.0f + __expf(-gcur[e])); }
                    else {
#pragma unroll
                        for (int e = 0; e < 8; ++e) fac[e] = 1.0f / (1.0f + __expf(-gcur[e])); }
#pragma unroll
                    for (int e = 0; e < 4; ++e) { acc[ai][bj][m][0][e] *= fac[e]; acc[ai][bj][m][1][e] *= fac[4 + e]; }
                    if (br == 2) { const f32x4 a = acc[ai][bj][m][0], b = acc[ai][bj][m][1]; float v[8] = {a[0], a[1], a[2], a[3], b[0], b[1], b[2], b[3]}; store_bf16x8(MERGED + (size_t)row * 1024 + col, v); }
                }
    }
};
__device__ __forceinline__ void phase_branch(const Params& P, unsigned char* lds) {
    float* red = (float*)lds; unsigned char* ws = P.ws;
    const bf16_t* ABR = (const bf16_t*)(ws + WS_ABR); const bf16_t* WBR = (const bf16_t*)(ws + WS_WBR_T); const bf16_t* PROJ = (const bf16_t*)(ws + WS_PROJ); bf16_t* MERGED = (bf16_t*)(ws + WS_MERGED);
    {
        pg8::Gemm g{ABR, WBR, 3 * MT, 3 * 1024, 512}; BranchOrder S; S.so.init(MP, 1024, (int)gridDim.x, (int)blockIdx.x);
        const EpiBranch E{PROJ, MERGED};
        pg8::gemm_phase<EpiBranch, BranchOrder, false, true>((PG8_LAS unsigned char*)lds, g, S, E);
    }
    constexpr int NU = 4 * 16;
    for (int u = blockIdx.x; u < NU; u += gridDim.x) {
        const int tr = 256 + (u & 3), tc = u >> 2;
        float msum[8] = {0.f, 0.f, 0.f, 0.f, 0.f, 0.f, 0.f, 0.f};
#pragma unroll
        for (int br = 0; br < 3; ++br) {
            sgemm_unit(ABR + (size_t)br * MT * 512, 512, WBR + (size_t)br * 1024 * 512, 512, 512, tr * 64, tc * 64, red, [&](int row, int col, float* v) {
                float g[8]; load_bf16x8(PROJ + (size_t)row * NIN + (br == 0 ? C_GA : (br == 1 ? C_GH : C_GM)) + col, g);
#pragma unroll
                for (int e = 0; e < 8; ++e) msum[e] += sigmoidf_(g[e]) * v[e];
                if (br == 2) store_bf16x8(MERGED + (size_t)row * 1024 + col, msum); });
        }
    }
}
struct StoreF32x4 { float* C; __device__ __forceinline__ void operator()(int row, int col, const f32x4& v) const { *(f32x4*)(C + (size_t)row * 1024 + col) = v; } };
struct StoreBf16x8 { bf16_t* C; int ldc; __device__ __forceinline__ void operator()(int row, int col, float* v) const { store_bf16x8(C + (size_t)row * ldc + col, v); } };
__device__ __forceinline__ void phase_gemm_f32(const bf16_t* A, const bf16_t* Bt, int K, float* C, unsigned char* lds) {
    float* red = (float*)lds;
    {
        pg8::Gemm g{A, Bt, MP, 1024, K}; pg8::StaticOrder S; S.init(MP, 1024, (int)gridDim.x, (int)blockIdx.x);
        const pg8::Epi4<StoreF32x4> E{StoreF32x4{C}};
        pg8::gemm_phase<pg8::Epi4<StoreF32x4>, pg8::StaticOrder, false, true>((PG8_LAS unsigned char*)lds, g, S, E);
    }
    constexpr int NU = 4 * 16;
    for (int u = blockIdx.x; u < NU; u += gridDim.x) { const int tr = 256 + (u & 3), tc = u >> 2;
        sgemm_unit(A, K, Bt, K, K, tr * 64, tc * 64, red, [&](int row, int col, float* v) { store_f32x8(C + (size_t)row * 1024 + col, v); }); }
}
__device__ __forceinline__ void phase_ffn_up(const Params& P, unsigned char* lds) {
    float* red = (float*)lds; const bf16_t* XN = (const bf16_t*)(P.ws + WS_XN); const bf16_t* W = (const bf16_t*)(P.ws + WS_WAB_T); bf16_t* AB = (bf16_t*)(P.ws + WS_AB);
    const StoreBf16x8 f{AB, 8192};
    {
        pg8::Gemm g{XN, W, MP, 8192, D}; pg8::StaticOrder S; S.init(MP, 8192, (int)gridDim.x, (int)blockIdx.x);
        const pg8::Epi8<StoreBf16x8> E{f};
        pg8::gemm_phase<pg8::Epi8<StoreBf16x8>, pg8::StaticOrder, true, true>((PG8_LAS unsigned char*)lds, g, S, E);
    }
    constexpr int NU = 4 * 128;
    for (int u = blockIdx.x; u < NU; u += gridDim.x) { const int tr = 256 + (u & 3), tc = u >> 2; sgemm_unit(XN, D, W, D, D, tr * 64, tc * 64, red, f); }
}
__device__ __forceinline__ void phase_mid_norm(const Params& P) {
    const int lane = threadIdx.x & 63, wave = threadIdx.x >> 6; const int gw = blockIdx.x * NWAVES + wave, NGW = gridDim.x * NWAVES;
    const float* MIX = (const float*)(P.ws + WS_MIX); bf16_t* XN = (bf16_t*)(P.ws + WS_XN);
    for (int row = gw; row < MT; row += NGW) {
        const float* xr = row < MP ? P.in[0] + (size_t)row * D : P.in[1] + (size_t)(row - MP) * D; float* yr = P.out + (size_t)row * D;
        f32x4 m[4], x[4]; float s = 0.f;
#pragma unroll
        for (int j = 0; j < 4; ++j) { m[j] = ((const f32x4*)(MIX + (size_t)row * D))[lane + 64 * j]; s += (m[j].x * m[j].x + m[j].y * m[j].y) + (m[j].z * m[j].z + m[j].w * m[j].w); }
        const float r = rsqrtf(wave_sum(s) * (1.0f / 1024.0f) + EPS); float s2 = 0.f;
#pragma unroll
        for (int j = 0; j < 4; ++j) { const f32x4 g = ((const f32x4*)P.in[12])[lane + 64 * j]; x[j] = ((const f32x4*)xr)[lane + 64 * j] + m[j] * r * g; ((f32x4*)yr)[lane + 64 * j] = x[j];
            s2 += (x[j].x * x[j].x + x[j].y * x[j].y) + (x[j].z * x[j].z + x[j].w * x[j].w); }
        const float r2 = rsqrtf(wave_sum(s2) * (1.0f / 1024.0f) + EPS);
#pragma unroll
        for (int j = 0; j < 4; ++j) { const f32x4 g = ((const f32x4*)P.in[22])[lane + 64 * j]; u32x2 o; o.x = pk2(x[j].x * r2 * g.x, x[j].y * r2 * g.y); o.y = pk2(x[j].z * r2 * g.z, x[j].w * r2 * g.w);
            ((u32x2*)(XN + (size_t)row * D))[lane + 64 * j] = o; }
    }
}
__device__ __forceinline__ void phase_ffn_gate(const Params& P) {
    const bf16_t* AB = (const bf16_t*)(P.ws + WS_AB); bf16_t* H = (bf16_t*)(P.ws + WS_H);
    const float* cw = P.in[26]; const float* cb = P.in[27]; const float* cbuf = P.in[8];
    for (size_t idx = (size_t)blockIdx.x * NTHR + threadIdx.x; idx < (size_t)MT * 512; idx += (size_t)gridDim.x * NTHR) {
        const int row = (int)(idx >> 9), n = (int)(idx & 511) * 8; const int cofs = (n >> 7) * 256 + (n & 127);
        float a[8], b[8], a1[8], a2[8];
        load_bf16x8(AB + (size_t)row * 8192 + cofs, a); load_bf16x8(AB + (size_t)row * 8192 + cofs + 128, b);
        if (row < MP) { const int t = row & 8191;
            if (t >= 1) load_bf16x8(AB + (size_t)(row - 1) * 8192 + cofs, a1); else { for (int e = 0; e < 8; ++e) a1[e] = 0.f; }
            if (t >= 2) load_bf16x8(AB + (size_t)(row - 2) * 8192 + cofs, a2); else { for (int e = 0; e < 8; ++e) a2[e] = 0.f; }
            if (t >= SEQ - 2) store_f32x8(P.out + O_PCONV + ((size_t)(row >> 13) * 2 + (t - (SEQ - 2))) * DFF + n, a);
        } else { const int sb = (row - MP) >> 3, st = (row - MP) & 7; const float* cbb = cbuf + (size_t)sb * 2 * DFF + n;
            if (st >= 1) load_bf16x8(AB + (size_t)(row - 1) * 8192 + cofs, a1); else { for (int e = 0; e < 8; ++e) a1[e] = cbb[DFF + e]; }
            if (st >= 2) load_bf16x8(AB + (size_t)(row - 2) * 8192 + cofs, a2); else { for (int e = 0; e < 8; ++e) a2[e] = cbb[(st == 0 ? 0 : DFF) + e]; }
            if (st >= 6) store_f32x8(P.out + O_SCONV + ((size_t)sb * 2 + (st - 6)) * DFF + n, a);
        }
        float o[8];
#pragma unroll
        for (int e = 0; e < 8; ++e) { const float c = cb[n + e] + a2[e] * cw[n + e] + a1[e] * cw[DFF + n + e] + a[e] * cw[2 * DFF + n + e]; o[e] = c * sigmoidf_(c) * b[e]; }
        store_bf16x8(H + (size_t)row * DFF + n, o);
    }
}
__device__ __forceinline__ void phase_final_norm(const Params& P) {
    const int lane = threadIdx.x & 63, wave = threadIdx.x >> 6; const int gw = blockIdx.x * NWAVES + wave, NGW = gridDim.x * NWAVES;
    const float* Fm = (const float*)(P.ws + WS_MIX);
    for (int row = gw; row < MT; row += NGW) {
        float* yr = P.out + (size_t)row * D; f32x4 m[4]; float s = 0.f;
#pragma unroll
        for (int j = 0; j < 4; ++j) { m[j] = ((const f32x4*)(Fm + (size_t)row * D))[lane + 64 * j]; s += (m[j].x * m[j].x + m[j].y * m[j].y) + (m[j].z * m[j].z + m[j].w * m[j].w); }
        const float r = rsqrtf(wave_sum(s) * (1.0f / 1024.0f) + EPS);
#pragma unroll
        for (int j = 0; j < 4; ++j) { const f32x4 g = ((const f32x4*)P.in[23])[lane + 64 * j]; ((f32x4*)yr)[lane + 64 * j] = ((const f32x4*)yr)[lane + 64 * j] + m[j] * r * g; }
    }
}

constexpr int NPHASE = 12;
__global__ void __launch_bounds__(NTHR, 2) mega_fwd(Params P) {
    extern __shared__ __attribute__((aligned(16))) unsigned char lds[];
    volatile unsigned* MISC = (volatile unsigned*)(lds + LDS_BYTES - 64);
    if (threadIdx.x < 16) MISC[threadIdx.x] = 0u;
    __syncthreads();
    XcdBarrier bar; bar.bar = (unsigned*)(P.ws + WS_CTL) + 4096; bar.x = 0; bar.st = nullptr;
    const bool multi = (P.ph_hi - P.ph_lo) > 1;
    if (multi) bar = xcd_barrier_post((unsigned*)(P.ws + WS_CTL) + 4096, MISC);
    const int lo = P.ph_lo, hi = P.ph_hi;
#ifndef ONLY_PHASE
#define ONLY_PHASE (-1)
#endif
#define IN(k) (lo <= (k) && (k) < hi && (ONLY_PHASE < 0 || ONLY_PHASE == (k)))
#define SEAM(k) do { if (IN(k) && IN((k) + 1)) xcd_barrier(bar); } while (0)
    if (IN(0)) phase_prep(P, lds);
    SEAM(0);
    if (IN(1)) phase_inproj(P, lds);
    SEAM(1);
    if (IN(2)) phase_mix1(P, lds);
    SEAM(2);
    if (IN(3)) phase_scan(P);
    SEAM(3);
    if (IN(4)) phase_mix2(P, lds);
    SEAM(4);
    if (IN(5)) phase_branch(P, lds);
    SEAM(5);
    if (IN(6)) phase_gemm_f32((const bf16_t*)(P.ws + WS_MERGED), (const bf16_t*)(P.ws + WS_WOUT_T), 1024, (float*)(P.ws + WS_MIX), lds);
    SEAM(6);
    if (IN(7)) phase_mid_norm(P);
    SEAM(7);
    if (IN(8)) phase_ffn_up(P, lds);
    SEAM(8);
    if (IN(9)) phase_ffn_gate(P);
    SEAM(9);
    if (IN(10)) phase_gemm_f32((const bf16_t*)(P.ws + WS_H), (const bf16_t*)(P.ws + WS_WD_T), 4096, (float*)(P.ws + WS_MIX), lds);
    SEAM(10);
    if (IN(11)) phase_final_norm(P);
#undef IN
#undef SEAM
}
}

extern "C" void kernel_launch(void* const* d_in, const int* in_sizes, int n_in, void* d_out, int out_size, void* d_ws, size_t ws_size, hipStream_t stream) {
    static int ready = 0;
    if (ready == 0) {
        if (n_in != 29 || (size_t)out_size != O_END || ws_size < WS_END) { fprintf(stderr, "kernel_launch: unexpected shapes (n_in %d out %d ws %zu)\n", n_in, out_size, ws_size); ready = -1; return; }
        if (hipFuncSetAttribute((const void*)mega_fwd, hipFuncAttributeMaxDynamicSharedMemorySize, LDS_BYTES) != hipSuccess) { fprintf(stderr, "kernel_launch: hipFuncSetAttribute failed\n"); ready = -1; return; }
        ready = 1;
    }
    if (ready < 0) return;
    (void)hipMemsetAsync((char*)d_ws + WS_CTL, 0, CTL_BYTES, stream);
    Params p{};
    for (int i = 0; i < 29; ++i) p.in[i] = (const float*)d_in[i];
    p.out = (float*)d_out; p.ws = (unsigned char*)d_ws;
#if MK_ONE_LAUNCH
    p.ph_lo = 0; p.ph_hi = NPHASE;
    hipLaunchKernelGGL(mega_fwd, dim3(256), dim3(NTHR), LDS_BYTES, stream, p);
#else
    for (int ph = 0; ph < NPHASE; ++ph) { p.ph_lo = ph; p.ph_hi = ph + 1; hipLaunchKernelGGL(mega_fwd, dim3(256), dim3(NTHR), LDS_BYTES, stream, p); }
#endif
}
```

```cpp
#include <hip/hip_runtime.h>
#include <cstdio>
#include <cstdint>

#ifndef PROBE_SEL
#define PROBE_SEL 63
#endif
#ifndef PROBE_REPEAT
#define PROBE_REPEAT (-1)
#endif
#ifndef MIX1_SEL
#define MIX1_SEL 63
#endif
#ifndef MK_ONE_LAUNCH
#define MK_ONE_LAUNCH 1
#endif

namespace {
typedef unsigned short bf16_t;
typedef short bf16x8 __attribute__((ext_vector_type(8)));
typedef float f32x4 __attribute__((ext_vector_type(4)));
typedef float f32x2 __attribute__((ext_vector_type(2)));
typedef unsigned u32x4 __attribute__((ext_vector_type(4)));
typedef unsigned u32x2 __attribute__((ext_vector_type(2)));

constexpr int NTHR = 512, NWAVES = 8;
constexpr int D = 1024, SEQ = 8192, NB = 2, MP = NB * SEQ, SBATCH = 32, STOK = 8, MS = SBATCH * STOK, MT = MP + MS;
constexpr int NIN = 10240, DFF = 4096;
constexpr int C_Q = 0, C_K = 1536, C_V = 3072, C_HQ = 4608, C_HF = 5120, C_HI = 5632, C_HG = 6144, C_MQ = 6656, C_GA = 7168, C_GH = 8192, C_GM = 9216;
constexpr float EPS = 1e-6f;

constexpr size_t O_YP = 0, O_YS = 16777216, O_PW1 = 17039360, O_PW2 = 17301504, O_PW3 = 18350080, O_PHG = 22544384, O_PCONV = 22675456, O_PMEM = 22691840,
                 O_SW1 = 23216128, O_SW2 = 27410432, O_SW3 = 44187648, O_SHG = 111296512, O_SCONV = 113393664, O_END = 113655808;

constexpr size_t MiB = 1u << 20;
constexpr size_t WS_CTL = 0, CTL_BYTES = 1 * MiB;
constexpr size_t WS_TAB = 1 * MiB;
constexpr size_t WS_WIN_T = 2 * MiB;
constexpr size_t WS_WMEM_T = 22 * MiB;
constexpr size_t WS_WBR_T = 24 * MiB;
constexpr size_t WS_WOUT_T = 27 * MiB;
constexpr size_t WS_WAB_T = 29 * MiB;
constexpr size_t WS_WD_T = 45 * MiB;
constexpr size_t WS_XN = 54 * MiB;
constexpr size_t WS_MEMN = 87 * MiB;
constexpr size_t WS_MEMKV = 88 * MiB;
constexpr size_t WS_PROJ = 90 * MiB;
constexpr size_t WS_ATTO = 416 * MiB;
constexpr size_t WS_LSE = 465 * MiB;
constexpr size_t WS_ABR = 466 * MiB;
constexpr size_t WS_HQT = 515 * MiB;
constexpr size_t WS_OINTRA = 531 * MiB;
constexpr size_t WS_U = 563 * MiB;
constexpr size_t WS_DC = 627 * MiB;
constexpr size_t WS_S0 = 628 * MiB;
constexpr size_t WS_MERGED = 692 * MiB;
constexpr size_t WS_MIX = 725 * MiB;
constexpr size_t WS_H = 790 * MiB;
constexpr size_t WS_AB = WS_PROJ;
constexpr size_t WS_END = 920 * MiB;

constexpr int LDS_BYTES = 155648;

struct Params { const float* in[29]; float* out; unsigned char* ws; int ph_lo, ph_hi; };

__device__ __forceinline__ unsigned f2bf(float f) { unsigned u = __float_as_uint(f); return (u + 0x7fffu + ((u >> 16) & 1u)) >> 16; }
__device__ __forceinline__ float bf2f(unsigned h) { return __uint_as_float(h << 16); }
__device__ __forceinline__ unsigned pk2(float lo, float hi) { return f2bf(lo) | (f2bf(hi) << 16); }
__device__ __forceinline__ float wave_sum(float v) {
#pragma unroll
    for (int o = 1; o < 64; o <<= 1) v += __shfl_xor(v, o);
    return v;
}
__device__ __forceinline__ float sigmoidf_(float x) { return 1.0f / (1.0f + __expf(-x)); }
#define LDS_WAIT() asm volatile("s_waitcnt lgkmcnt(0)" ::: "memory")

#define XB_TMO      128
#define XB_XCNT(j)  (256  + 64 * (j))
#define XB_XSUB(j)  (1280 + 64 * (j))
#define XB_XGEN(j)  (2304 + 64 * (j))
#define XB_TOP      3328
#define XB_TOPGEN   3392
#define XB_SPIN_CAP (1u << 22)
__device__ __forceinline__ unsigned xb_ld(unsigned* p)              { return __hip_atomic_load(p, __ATOMIC_RELAXED, __HIP_MEMORY_SCOPE_AGENT); }
__device__ __forceinline__ unsigned xb_add(unsigned* p, unsigned v) { return __hip_atomic_fetch_add(p, v, __ATOMIC_RELAXED, __HIP_MEMORY_SCOPE_AGENT); }
__device__ __forceinline__ unsigned xb_xcc_id() { return (unsigned)__builtin_amdgcn_s_getreg((3 << 11) | 20) & 0xFu; }
#define XB_SPIN(cond, bar) do { unsigned _sp = 0; while (cond) { __builtin_amdgcn_s_sleep(1); \
    if ((++_sp & 255u) == 0u) { if (xb_ld(&(bar)[XB_TMO])) break; if (_sp > XB_SPIN_CAP) { atomicAdd(&(bar)[XB_TMO], 1u); break; } } } } while (0)
struct XcdBarrier { unsigned* bar; unsigned x; volatile unsigned* st; };
__device__ __forceinline__ XcdBarrier xcd_barrier_post(unsigned* bar, volatile unsigned* st) {
    XcdBarrier b; b.bar = bar; b.x = xb_xcc_id(); b.st = st;
    if (threadIdx.x == 0) (void)xb_add(&bar[XB_XCNT(b.x)], 1u);
    return b;
}
__device__ __forceinline__ void xcd_barrier_complete(unsigned* bar, unsigned x, unsigned& nloc, unsigned& nx) {
    const unsigned G = gridDim.x;
    unsigned sum, cnt, mine, sp = 0u;
    for (;;) {
        sum = 0u; cnt = 0u; mine = 0u;
#pragma unroll
        for (unsigned j = 0; j < 16; ++j) { const unsigned c = xb_ld(&bar[XB_XCNT(j)]); sum += c; cnt += (c > 0u) ? 1u : 0u; mine = (j == x) ? c : mine; }
        if (sum == G) break;
        __builtin_amdgcn_s_sleep(1);
        if ((++sp & 255u) == 0u) { if (xb_ld(&bar[XB_TMO])) break; if (sp > XB_SPIN_CAP) { atomicAdd(&bar[XB_TMO], 1u); break; } }
    }
    nloc = mine > 0u ? mine : 1u; nx = cnt > 0u ? cnt : 1u;
}
__device__ __forceinline__ void xcd_barrier(const XcdBarrier& b) {
    asm volatile("s_waitcnt vmcnt(0)" ::: "memory");
    __syncthreads();
    if (threadIdx.x == 0) {
        unsigned* bar = b.bar;
        __builtin_amdgcn_s_waitcnt(0);
        unsigned nloc = b.st[0], nx = b.st[1];
        if (nloc == 0u) { xcd_barrier_complete(bar, b.x, nloc, nx); b.st[0] = nloc; b.st[1] = nx; }
        const unsigned old = xb_add(&bar[XB_XSUB(b.x)], 1u);
        const unsigned gen = old / nloc;
        if (old + 1u == (gen + 1u) * nloc) {
            __builtin_amdgcn_fence(__ATOMIC_RELEASE, "agent");
            asm volatile("s_waitcnt vmcnt(0)" ::: "memory");
            const unsigned og = xb_add(&bar[XB_TOP], 1u);
            const unsigned tg = og / nx;
            if (og + 1u == (tg + 1u) * nx) xb_add(&bar[XB_TOPGEN], 1u);
            else XB_SPIN(xb_ld(&bar[XB_TOPGEN]) == tg, bar);
            __builtin_amdgcn_fence(__ATOMIC_ACQUIRE, "agent");
            xb_add(&bar[XB_XGEN(b.x)], 1u);
            asm volatile("s_waitcnt vmcnt(0)" ::: "memory");
        } else {
            XB_SPIN(xb_ld(&bar[XB_XGEN(b.x)]) == gen, bar);
            __builtin_amdgcn_fence(__ATOMIC_ACQUIRE, "agent");
            asm volatile("s_waitcnt vmcnt(0)" ::: "memory");
        }
    }
    __syncthreads();
}

__device__ __forceinline__ int dest_row(int n, int kind, int row_off) { return kind == 0 ? row_off + n : ((n >> 7) * 256 + (n & 127) + (kind == 2 ? 128 : 0)); }
__device__ __forceinline__ void transpose_item(const float* __restrict__ W, int K, int N, bf16_t* __restrict__ WT, int kind, int row_off, float* scr, int item, int lane) {
    const int nblk = N / 32, kb = item / nblk, nb = item % nblk, k0 = 64 * kb, n0 = 32 * nb;
#pragma unroll 8
    for (int i = 0; i < 32; ++i) { const int kk = 2 * i + (lane >> 5); scr[kk * 33 + (lane & 31)] = W[(size_t)(k0 + kk) * N + n0 + (lane & 31)]; }
    LDS_WAIT();
    const int c = lane & 7;
#pragma unroll
    for (int j = 0; j < 4; ++j) { const int n = (lane >> 3) + 8 * j; const float* s = scr + (8 * c) * 33 + n;
        u32x4 o; o.x = pk2(s[0 * 33], s[1 * 33]); o.y = pk2(s[2 * 33], s[3 * 33]); o.z = pk2(s[4 * 33], s[5 * 33]); o.w = pk2(s[6 * 33], s[7 * 33]);
        *(u32x4*)(WT + (size_t)dest_row(n0 + n, kind, row_off) * K + k0 + 8 * c) = o; }
    LDS_WAIT();
}
__device__ __forceinline__ void rms_row_bf16(const float* __restrict__ xr, const float* __restrict__ gain, bf16_t* __restrict__ orow, int lane) {
    f32x4 v[4]; float s = 0.f;
#pragma unroll
    for (int j = 0; j < 4; ++j) { v[j] = ((const f32x4*)xr)[lane + 64 * j]; s += (v[j].x * v[j].x + v[j].y * v[j].y) + (v[j].z * v[j].z + v[j].w * v[j].w); }
    const float r = rsqrtf(wave_sum(s) * (1.0f / 1024.0f) + EPS);
#pragma unroll
    for (int j = 0; j < 4; ++j) { const f32x4 g = ((const f32x4*)gain)[lane + 64 * j];
        u32x2 o; o.x = pk2(v[j].x * r * g.x, v[j].y * r * g.y); o.y = pk2(v[j].z * r * g.z, v[j].w * r * g.w);
        ((u32x2*)orow)[lane + 64 * j] = o; }
}
__device__ __forceinline__ void phase_prep(const Params& P, unsigned char* lds) {
    const int tid = threadIdx.x, lane = tid & 63, wave = tid >> 6;
    const int gw = blockIdx.x * NWAVES + wave, NGW = gridDim.x * NWAVES;
    unsigned char* ws = P.ws;
    float* scr = (float*)lds + wave * (64 * 33);
    {
        constexpr int I_IN = 16 * 320, I_MEM = 16 * 32, I_BR = 8 * 32, I_OUT = 16 * 32, I_A = 16 * 128, I_D = 64 * 32;
        constexpr int NIT = I_IN + I_MEM + 3 * I_BR + I_OUT + 2 * I_A + I_D;
        for (int it = gw; it < NIT; it += NGW) {
            int r = it;
            if (r < I_IN) { transpose_item(P.in[13], 1024, NIN, (bf16_t*)(ws + WS_WIN_T), 0, 0, scr, r, lane); continue; } r -= I_IN;
            if (r < I_MEM) { transpose_item(P.in[17], 1024, 1024, (bf16_t*)(ws + WS_WMEM_T), 0, 0, scr, r, lane); continue; } r -= I_MEM;
            if (r < I_BR) { transpose_item(P.in[18], 512, 1024, (bf16_t*)(ws + WS_WBR_T), 0, 0, scr, r, lane); continue; } r -= I_BR;
            if (r < I_BR) { transpose_item(P.in[19], 512, 1024, (bf16_t*)(ws + WS_WBR_T), 0, 1024, scr, r, lane); continue; } r -= I_BR;
            if (r < I_BR) { transpose_item(P.in[20], 512, 1024, (bf16_t*)(ws + WS_WBR_T), 0, 2048, scr, r, lane); continue; } r -= I_BR;
            if (r < I_OUT) { transpose_item(P.in[21], 1024, 1024, (bf16_t*)(ws + WS_WOUT_T), 0, 0, scr, r, lane); continue; } r -= I_OUT;
            if (r < I_A) { transpose_item(P.in[24], 1024, DFF, (bf16_t*)(ws + WS_WAB_T), 1, 0, scr, r, lane); continue; } r -= I_A;
            if (r < I_A) { transpose_item(P.in[25], 1024, DFF, (bf16_t*)(ws + WS_WAB_T), 2, 0, scr, r, lane); continue; } r -= I_A;
            transpose_item(P.in[28], DFF, 1024, (bf16_t*)(ws + WS_WD_T), 0, 0, scr, r, lane);
        }
    }
    {
        bf16_t* XN = (bf16_t*)(ws + WS_XN); bf16_t* MEMN = (bf16_t*)(ws + WS_MEMN);
        for (int m = gw; m < MT + 512; m += NGW) {
            if (m < MP) rms_row_bf16(P.in[0] + (size_t)m * D, P.in[11], XN + (size_t)m * D, lane);
            else if (m < MT) rms_row_bf16(P.in[1] + (size_t)(m - MP) * D, P.in[11], XN + (size_t)m * D, lane);
            else rms_row_bf16(P.in[2] + (size_t)(m - MT) * D, P.in[16], MEMN + (size_t)(m - MT) * D, lane);
        }
    }
    {
        constexpr int R1 = 32 * 120, R2 = 32 * 504, R3 = 32 * 2040;
        for (int r = gw; r < R1 + R2 + R3; r += NGW) {
            int q = r, W; const float* src; float* dst;
            if (q < R1) { W = 128; src = P.in[3]; dst = P.out + O_SW1; }
            else if (q < R1 + R2) { q -= R1; W = 512; src = P.in[4]; dst = P.out + O_SW2; }
            else { q -= R1 + R2; W = 2048; src = P.in[5]; dst = P.out + O_SW3; }
            const int b = q / (W - 8), i = q % (W - 8);
            const f32x4* s4 = (const f32x4*)(src + ((size_t)b * W + i + 8) * 1024); f32x4* d4 = (f32x4*)(dst + ((size_t)b * W + i) * 1024);
            f32x4 t0 = s4[lane], t1 = s4[lane + 64], t2 = s4[lane + 128], t3 = s4[lane + 192];
            d4[lane] = t0; d4[lane + 64] = t1; d4[lane + 128] = t2; d4[lane + 192] = t3;
        }
    }
    if (blockIdx.x == 0) {
        float* BT = (float*)(ws + WS_TAB); float* LB = BT + 3 * 4 * 132;
        const float* rel_bias = P.in[9];
        for (int e = tid; e < 3 * 4 * 129; e += NTHR) {
            const int g = e / (4 * 129), h = (e / 129) % 4, j = e % 129;
            const int dil = g == 0 ? 1 : (g == 1 ? 4 : 16);
            const int dist = j * dil; int bucket;
            if (dist < 16) bucket = dist;
            else { const float d = (float)dist; int large = 16 + (int)(logf(d / 16.0f) / logf(128.0f) * 16.0f); bucket = large < 31 ? large : 31; }
            BT[(g * 4 + h) * 132 + j] = rel_bias[bucket * 12 + g * 4 + h];
        }
        for (int e = tid; e < 512; e += NTHR) { const float l0 = P.in[10][e], l1 = P.in[10][512 + e]; LB[e] = 1.0f / (1.0f + expf(l1 - l0)); }
    }
}

template <class Epi>
__device__ __forceinline__ void sgemm_unit(const bf16_t* __restrict__ A, int lda, const bf16_t* __restrict__ Bt, int ldb, int K, int row0, int col0, float* red, const Epi& epi) {
    const int tid = threadIdx.x, lane = tid & 63, wave = tid >> 6, kq = wave >> 1, ch = wave & 1, fr = lane & 15, fq = lane >> 4;
    f32x4 acc[4][2];
#pragma unroll
    for (int i = 0; i < 4; ++i)
#pragma unroll
        for (int j = 0; j < 2; ++j) acc[i][j] = (f32x4){0.f, 0.f, 0.f, 0.f};
    const int kbeg = kq * (K >> 2), kend = kbeg + (K >> 2);
    const bf16_t* ap = A + (size_t)(row0 + fr) * lda + fq * 8;
    const bf16_t* bp = Bt + (size_t)(col0 + ch * 32 + fr) * ldb + fq * 8;
#pragma unroll 4
    for (int k = kbeg; k < kend; k += 32) {
        bf16x8 a[4], b[2];
#pragma unroll
        for (int i = 0; i < 4; ++i) a[i] = *(const bf16x8*)(ap + (size_t)i * 16 * lda + k);
#pragma unroll
        for (int j = 0; j < 2; ++j) b[j] = *(const bf16x8*)(bp + (size_t)j * 16 * ldb + k);
#pragma unroll
        for (int i = 0; i < 4; ++i)
#pragma unroll
            for (int j = 0; j < 2; ++j) acc[i][j] = __builtin_amdgcn_mfma_f32_16x16x32_bf16(a[i], b[j], acc[i][j], 0, 0, 0);
    }
    __syncthreads();
#pragma unroll
    for (int i = 0; i < 4; ++i)
#pragma unroll
        for (int j = 0; j < 2; ++j)
#pragma unroll
            for (int r = 0; r < 4; ++r) red[(kq * 64 + i * 16 + 4 * fq + r) * 65 + ch * 32 + j * 16 + fr] = acc[i][j][r];
    __syncthreads();
    const int row = tid >> 3, c8 = (tid & 7) * 8;
    float v[8];
#pragma unroll
    for (int e = 0; e < 8; ++e) v[e] = (red[(0 * 64 + row) * 65 + c8 + e] + red[(1 * 64 + row) * 65 + c8 + e]) + (red[(2 * 64 + row) * 65 + c8 + e] + red[(3 * 64 + row) * 65 + c8 + e]);
    epi(row0 + row, col0 + c8, v);
}
__device__ __forceinline__ void store_bf16x8(bf16_t* p, const float* v) { u32x4 o; o.x = pk2(v[0], v[1]); o.y = pk2(v[2], v[3]); o.z = pk2(v[4], v[5]); o.w = pk2(v[6], v[7]); *(u32x4*)p = o; }
__device__ __forceinline__ void store_f32x8(float* p, const float* v) { ((f32x4*)p)[0] = (f32x4){v[0], v[1], v[2], v[3]}; ((f32x4*)p)[1] = (f32x4){v[4], v[5], v[6], v[7]}; }
__device__ __forceinline__ void load_bf16x8(const bf16_t* p, float* v) { const u32x4 w = *(const u32x4*)p;
    v[0] = bf2f(w.x & 0xffffu); v[1] = bf2f(w.x >> 16); v[2] = bf2f(w.y & 0xffffu); v[3] = bf2f(w.y >> 16); v[4] = bf2f(w.z & 0xffffu); v[5] = bf2f(w.z >> 16); v[6] = bf2f(w.w & 0xffffu); v[7] = bf2f(w.w >> 16); }

}
namespace pg8 {
#define PG8_LAS __attribute__((address_space(3)))
typedef unsigned short bf16_t;
typedef short bf16x8 __attribute__((ext_vector_type(8)));
typedef float f32x4 __attribute__((ext_vector_type(4)));
typedef unsigned u32x4 __attribute__((ext_vector_type(4)));
constexpr int BM = 256, BK = 64, HALF = 128, HTB = HALF * BK * 2  , STAGE_BYTES = 8 * HTB, NXCD = 8, WGM = 8;

__host__ __device__ __forceinline__ int lds_byte(int r, int c) { const int st = (r >> 4) * 2 + (c >> 5), rr = r & 15, cc = c & 31, ob = rr * 64 + cc * 2; return st * 1024 + (ob ^ (((ob >> 9) & 1) << 5)); }
__host__ __device__ __forceinline__ void stage_rc(int b, int& R, int& C) { const int st = b / 1024, sb = b % 1024, swz = sb ^ (((sb >> 9) & 1) << 5); R = (st >> 1) * 16 + swz / 64; C = (st & 1) * 32 + (swz % 64) / 2; }
__host__ __device__ __forceinline__ int perm32(int rho) { const int n = rho >> 4, i = rho & 15; return 8 * (i >> 2) + 4 * n + (i & 3); }

struct Unit { int pm, pn; };
struct Gemm { const bf16_t* A; const bf16_t* Bt; int M, N, K; };

struct StaticOrder {
    int nM, nN, nwg, G, c;
    __host__ __device__ void init(int M, int N, int G_, int c_) { nM = M / BM; nN = N / BM; nwg = nM * nN; G = G_; c = c_; }
    __host__ __device__ bool next(int i, Unit& u) const {
        const long L = (long)i * G + c; if (L >= nwg) return false;
        int wgid = (int)L; { const int q = nwg / NXCD, r = nwg % NXCD, xcd = wgid % NXCD, off = wgid / NXCD; wgid = (xcd < r ? xcd * (q + 1) : r * (q + 1) + (xcd - r) * q) + off; }
        const int nig = WGM * nN, gid = wgid / nig, fm = gid * WGM, gsz = (nM - fm) < WGM ? (nM - fm) : WGM;
        u.pm = fm + ((wgid % nig) % gsz); u.pn = (wgid % nig) / gsz; return true;
    }
    __device__ __forceinline__ void a_ready(const Unit&) const {}
    __device__ __forceinline__ void done(const Unit&) const {}
};
__device__ __forceinline__ unsigned cvt_pk_bf16(float lo, float hi) { unsigned r; asm volatile("v_cvt_pk_bf16_f32 %0, %1, %2" : "=v"(r) : "v"(lo), "v"(hi)); return r; }
typedef float f32x2 __attribute__((ext_vector_type(2)));

template <class F> struct Epi8 {
    static constexpr bool PERM = true, AFTER_DRAIN = false; F f;
    __device__ __forceinline__ bool keep(const Unit&) const { return false; }
    __device__ __forceinline__ void operator()(f32x4 (&acc)[2][2][4][2], const Unit& u, int wr, int wc, int fr, int fq) const {
        const int row0 = u.pm * BM + wr * 64 + fr, col0 = u.pn * BM + wc * 32 + 8 * fq;
#pragma unroll
        for (int ai = 0; ai < 2; ++ai)
#pragma unroll
            for (int m = 0; m < 4; ++m)
#pragma unroll
                for (int bj = 0; bj < 2; ++bj) { const f32x4 a = acc[ai][bj][m][0], b = acc[ai][bj][m][1]; float v[8] = {a[0], a[1], a[2], a[3], b[0], b[1], b[2], b[3]};
                    f(row0 + ai * HALF + m * 16, col0 + bj * HALF, v); }
    }
};
template <class F> struct Epi4 {
    static constexpr bool PERM = false, AFTER_DRAIN = false; F f;
    __device__ __forceinline__ bool keep(const Unit&) const { return false; }
    __device__ __forceinline__ void operator()(f32x4 (&acc)[2][2][4][2], const Unit& u, int wr, int wc, int fr, int fq) const {
        const int row0 = u.pm * BM + wr * 64 + fr, col0 = u.pn * BM + wc * 32 + 4 * fq;
#pragma unroll
        for (int ai = 0; ai < 2; ++ai)
#pragma unroll
            for (int m = 0; m < 4; ++m)
#pragma unroll
                for (int bj = 0; bj < 2; ++bj)
#pragma unroll
                    for (int n = 0; n < 2; ++n) f(row0 + ai * HALF + m * 16, col0 + bj * HALF + n * 16, acc[ai][bj][m][n]);
    }
};
template <class Epi, class Sched, bool ALIGN_EPI = false, bool SP2 = false>
__device__ __forceinline__ void gemm_phase(PG8_LAS unsigned char* lds, const Gemm g, const Sched& S, const Epi& E) {
    const int tid = threadIdx.x, wid = __builtin_amdgcn_readfirstlane(tid >> 6), lane = tid & 63, wr = wid >> 2, wc = wid & 3, fr = lane & 15, fq = lane >> 4;
    const int K = g.K, nt = K / BK;
    unsigned voffA[2], voffB[2];
#pragma unroll
    for (int i = 0; i < 2; ++i) { int R, C; stage_rc(tid * 16 + i * 8192, R, C); const int Rb = Epi::PERM ? ((R & ~31) + perm32(R & 31)) : R;
        voffA[i] = (unsigned)(R * K + C) * 2u; voffB[i] = (unsigned)(Rb * K + C) * 2u; }
    const size_t kstep = (size_t)(BK * 2);
    const size_t hstep = (size_t)HALF * K * 2;
    const size_t tstep = 2 * hstep;
    const unsigned ldsw = (unsigned)wid * 1024u;
    const int aoff = lds_byte(wr * 64 + fr, fq * 8), boff = lds_byte(wc * 32 + fr, fq * 8);
#define PG8_SA(b, h) (((b) * 2 + (h)) * HTB)
#define PG8_SB(b, h) ((4 + (b) * 2 + (h)) * HTB)
#define PG8_STAGE(bufoff, gbase, voff) do { _Pragma("unroll") for (int _i = 0; _i < 2; ++_i) \
        __builtin_amdgcn_global_load_lds((const unsigned*)((const char*)(gbase) + (voff)[_i]), (PG8_LAS unsigned*)(lds + (bufoff) + ldsw + _i * 8192), 16, 0, 0); } while (0)
#define PG8_LDA(dst, b, h) do { _Pragma("unroll") for (int m = 0; m < 4; ++m) _Pragma("unroll") for (int k = 0; k < 2; ++k) dst[m][k] = *(const PG8_LAS bf16x8*)(lds + PG8_SA(b, h) + aoff + m * 2048 + k * 1024); } while (0)
#define PG8_LDB(dst, b, h) do { _Pragma("unroll") for (int n = 0; n < 2; ++n) _Pragma("unroll") for (int k = 0; k < 2; ++k) dst[n][k] = *(const PG8_LAS bf16x8*)(lds + PG8_SB(b, h) + boff + n * 2048 + k * 1024); } while (0)
#define PG8_MMA(ai, bj, At, Bt) do { __builtin_amdgcn_s_setprio(1); _Pragma("unroll") for (int m = 0; m < 4; ++m) _Pragma("unroll") for (int n = 0; n < 2; ++n) _Pragma("unroll") for (int k = 0; k < 2; ++k) \
        acc[ai][bj][m][n] = __builtin_amdgcn_mfma_f32_16x16x32_bf16(Bt[n][k], At[m][k], acc[ai][bj][m][n], 0, 0, 0); __builtin_amdgcn_s_setprio(0); } while (0)
#define PG8_WAIT_V(n) asm volatile("s_waitcnt vmcnt(" #n ")" ::: "memory")
#define PG8_WAIT_L(n) asm volatile("s_waitcnt lgkmcnt(" #n ")" ::: "memory")
#define PG8_BAR __builtin_amdgcn_s_barrier()
#define PG8_SCHED __builtin_amdgcn_sched_barrier(0)
    Unit cur, nxt; int ui = 0;
    if (!S.next(0, cur)) return;
    f32x4 acc[2][2][4][2];
#pragma unroll
    for (int a = 0; a < 2; ++a)
#pragma unroll
        for (int b = 0; b < 2; ++b)
#pragma unroll
            for (int m = 0; m < 4; ++m)
#pragma unroll
                for (int n = 0; n < 2; ++n) acc[a][b][m][n] = (f32x4){0.f, 0.f, 0.f, 0.f};
    bf16x8 At[4][2], B0[2][2], B1[2][2];
    const char* cA = (const char*)g.A + (size_t)cur.pm * tstep; const char* cB = (const char*)g.Bt + (size_t)cur.pn * tstep;
    S.a_ready(cur);
    if constexpr (SP2) {
        PG8_STAGE(PG8_SB(0, 0), cB, voffB); PG8_STAGE(PG8_SB(0, 1), cB + hstep, voffB); PG8_STAGE(PG8_SA(0, 0), cA, voffA); PG8_STAGE(PG8_SA(0, 1), cA + hstep, voffA);
        if (wr == 1) PG8_BAR;
        PG8_WAIT_V(2); PG8_BAR;
        PG8_STAGE(PG8_SB(1, 0), cB + kstep, voffB); PG8_STAGE(PG8_SA(1, 0), cA + kstep, voffA); PG8_STAGE(PG8_SB(1, 1), cB + hstep + kstep, voffB);
        PG8_WAIT_V(6); PG8_BAR;
    } else {
        PG8_STAGE(PG8_SB(0, 0), cB, voffB); PG8_STAGE(PG8_SA(0, 0), cA, voffA); PG8_STAGE(PG8_SB(0, 1), cB + hstep, voffB); PG8_STAGE(PG8_SA(0, 1), cA + hstep, voffA);
        if (wr == 1) PG8_BAR;
        PG8_WAIT_V(4); PG8_BAR;
        PG8_STAGE(PG8_SB(1, 0), cB + kstep, voffB); PG8_STAGE(PG8_SA(1, 0), cA + kstep, voffA); PG8_STAGE(PG8_SB(1, 1), cB + hstep + kstep, voffB);
        PG8_WAIT_V(6); PG8_BAR;
    }
    for (;;) {
        const bool has_next = S.next(ui + 1, nxt);
        const char* nA = has_next ? (const char*)g.A + (size_t)nxt.pm * tstep : cA; const char* nB = has_next ? (const char*)g.Bt + (size_t)nxt.pn * tstep : cB;
        for (int t = 0; t < nt; t += 2) {
            const bool last = (t == nt - 2);
            const char* a1 = cA + (size_t)(t + 1) * kstep;
            const char* a2 = last ? nA : cA + (size_t)(t + 2) * kstep; const char* b2 = last ? nB : cB + (size_t)(t + 2) * kstep;
            const char* a3 = a2 + kstep; const char* b3 = b2 + kstep;
            if (last && has_next) S.a_ready(nxt);
            if constexpr (SP2) {
            PG8_LDB(B0, 0, 0); PG8_LDB(B1, 0, 1); PG8_SCHED; PG8_LDA(At, 0, 0); PG8_STAGE(PG8_SA(1, 1), a1 + hstep, voffA);
            PG8_WAIT_V(8); PG8_WAIT_L(0); PG8_BAR; PG8_MMA(0, 0, At, B0); PG8_MMA(0, 1, At, B1); PG8_BAR; PG8_SCHED;
            PG8_LDA(At, 0, 1); PG8_STAGE(PG8_SB(0, 0), b2, voffB); PG8_STAGE(PG8_SB(0, 1), b2 + hstep, voffB); PG8_STAGE(PG8_SA(0, 0), a2, voffA);
            PG8_WAIT_V(8); PG8_WAIT_L(0); PG8_BAR; PG8_MMA(1, 0, At, B0); PG8_MMA(1, 1, At, B1); PG8_BAR; PG8_SCHED;
            PG8_LDB(B0, 1, 0); PG8_LDB(B1, 1, 1); PG8_SCHED; PG8_LDA(At, 1, 0); PG8_STAGE(PG8_SA(0, 1), a2 + hstep, voffA);
            PG8_WAIT_V(8); PG8_WAIT_L(0); PG8_BAR; PG8_MMA(0, 0, At, B0); PG8_MMA(0, 1, At, B1); PG8_BAR; PG8_SCHED;
            PG8_LDA(At, 1, 1); PG8_STAGE(PG8_SB(1, 0), b3, voffB); PG8_STAGE(PG8_SB(1, 1), b3 + hstep, voffB); PG8_STAGE(PG8_SA(1, 0), a3, voffA);
            PG8_WAIT_V(8); PG8_WAIT_L(0); PG8_BAR; PG8_MMA(1, 0, At, B0); PG8_MMA(1, 1, At, B1); PG8_BAR; PG8_SCHED;
            } else {
            PG8_LDB(B0, 0, 0); PG8_SCHED; PG8_LDA(At, 0, 0); PG8_STAGE(PG8_SA(1, 1), a1 + hstep, voffA);
            PG8_WAIT_L(8); PG8_BAR; PG8_WAIT_L(0); PG8_MMA(0, 0, At, B0); PG8_BAR; PG8_SCHED;
            PG8_LDB(B1, 0, 1); PG8_STAGE(PG8_SB(0, 0), b2, voffB);
            PG8_BAR; PG8_WAIT_L(0); PG8_MMA(0, 1, At, B1); PG8_BAR;
            PG8_LDA(At, 0, 1); PG8_STAGE(PG8_SA(0, 0), a2, voffA);
            PG8_BAR; PG8_WAIT_L(0); PG8_MMA(1, 0, At, B0); PG8_BAR; PG8_SCHED;
            PG8_STAGE(PG8_SB(0, 1), b2 + hstep, voffB);
            PG8_WAIT_V(6); PG8_BAR; PG8_MMA(1, 1, At, B1); PG8_BAR;
            PG8_LDB(B0, 1, 0); PG8_SCHED; PG8_LDA(At, 1, 0); PG8_STAGE(PG8_SA(0, 1), a2 + hstep, voffA);
            PG8_WAIT_L(8); PG8_BAR; PG8_WAIT_L(0); PG8_MMA(0, 0, At, B0); PG8_BAR; PG8_SCHED;
            PG8_LDB(B1, 1, 1); PG8_STAGE(PG8_SB(1, 0), b3, voffB);
            PG8_BAR; PG8_WAIT_L(0); PG8_MMA(0, 1, At, B1); PG8_BAR;
            PG8_LDA(At, 1, 1); PG8_STAGE(PG8_SA(1, 0), a3, voffA);
            PG8_BAR; PG8_WAIT_L(0); PG8_MMA(1, 0, At, B0); PG8_BAR; PG8_SCHED;
            PG8_STAGE(PG8_SB(1, 1), b3 + hstep, voffB);
            PG8_WAIT_V(6); PG8_BAR; PG8_MMA(1, 1, At, B1); PG8_BAR;
            }
        }
        if constexpr (ALIGN_EPI) { if (wr == 0) PG8_BAR; }
        if constexpr (!Epi::AFTER_DRAIN) { E(acc, cur, wr, wc, fr, fq); S.done(cur); }
        if (!has_next) break;
        if (!E.keep(cur)) {
#pragma unroll
        for (int a = 0; a < 2; ++a)
#pragma unroll
            for (int b = 0; b < 2; ++b)
#pragma unroll
                for (int m = 0; m < 4; ++m)
#pragma unroll
                    for (int n = 0; n < 2; ++n) acc[a][b][m][n] = (f32x4){0.f, 0.f, 0.f, 0.f};
        }
        cur = nxt; cA = nA; cB = nB; ++ui;
        if constexpr (ALIGN_EPI) { if (wr == 1) PG8_BAR; }
    }
    PG8_WAIT_V(0);
    if constexpr (!ALIGN_EPI) { if (wr == 0) PG8_BAR; }
    PG8_BAR;
    if constexpr (Epi::AFTER_DRAIN) { E.fused(acc, cur, wr, wc, fr, fq, lds, wid, lane); S.done(cur); }
#undef PG8_SA
#undef PG8_SB
#undef PG8_STAGE
#undef PG8_LDA
#undef PG8_LDB
#undef PG8_MMA
#undef PG8_WAIT_V
#undef PG8_WAIT_L
#undef PG8_BAR
#undef PG8_SCHED
}
}

namespace {
struct InProjF {
    bf16_t* PROJ; const float* bias; float* out;
    __device__ __forceinline__ void operator()(int row, int col, float* v) const {
        const f32x4 b0 = *(const f32x4*)(bias + col), b1 = *(const f32x4*)(bias + col + 4);
        v[0] += b0[0]; v[1] += b0[1]; v[2] += b0[2]; v[3] += b0[3]; v[4] += b1[0]; v[5] += b1[1]; v[6] += b1[2]; v[7] += b1[3];
        store_bf16x8(PROJ + (size_t)row * NIN + col, v);
        if (col >= C_K && col < C_HQ) {
            const int kv = col - C_K, which = kv / 1536, rem = kv % 1536, g = rem >> 9, hd = rem & 511;
            const int W = g == 0 ? 128 : (g == 1 ? 512 : 2048);
            if (row < MP) { const int b = row >> 13, t = row & 8191;
                if (t >= SEQ - W) { float* pw = out + (g == 0 ? O_PW1 : (g == 1 ? O_PW2 : O_PW3)); store_f32x8(pw + (((size_t)b * W + (t - (SEQ - W))) * 2 + which) * 512 + hd, v); } }
            else { const int sb = (row - MP) >> 3, st = (row - MP) & 7; float* sw = out + (g == 0 ? O_SW1 : (g == 1 ? O_SW2 : O_SW3));
                store_f32x8(sw + (((size_t)sb * W + (W - 8 + st)) * 2 + which) * 512 + hd, v); }
        }
    }
};
__device__ __forceinline__ void phase_inproj(const Params& P, unsigned char* lds) {
    float* red = (float*)lds; unsigned char* ws = P.ws;
    const bf16_t* XN = (const bf16_t*)(ws + WS_XN); const bf16_t* WT = (const bf16_t*)(ws + WS_WIN_T);
    const InProjF f{(bf16_t*)(ws + WS_PROJ), P.in[14], P.out};
    {
        pg8::Gemm g{XN, WT, MP, NIN, D}; pg8::StaticOrder S; S.init(MP, NIN, (int)gridDim.x, (int)blockIdx.x);
        const pg8::Epi8<InProjF> E{f};
        pg8::gemm_phase<pg8::Epi8<InProjF>, pg8::StaticOrder, true, true>((PG8_LAS unsigned char*)lds, g, S, E);
    }
    constexpr int NU_S = 4 * (NIN / 64), NU_MEM = 8 * 16;
    for (int u = blockIdx.x; u < NU_S + NU_MEM; u += gridDim.x) {
        if (u < NU_S) { const int tr = 256 + (u & 3), tc = u >> 2; sgemm_unit(XN, D, WT, D, D, tr * 64, tc * 64, red, f); }
        else {
            const int q = u - NU_S, tr = q % 8, tc = q / 8;
            bf16_t* MEMKV = (bf16_t*)(ws + WS_MEMKV); float* out = P.out;
            sgemm_unit((const bf16_t*)(ws + WS_MEMN), D, (const bf16_t*)(ws + WS_WMEM_T), D, D, tr * 64, tc * 64, red, [&](int row, int col, float* v) {
                store_f32x8(out + O_PMEM + (size_t)row * 1024 + col, v); store_bf16x8(MEMKV + (size_t)row * 1024 + col, v); });
        }
    }
}

struct AttnUnit {
    const bf16_t* q; long q_rs; const bf16_t* k; long k_rs; const bf16_t* v; long v_rs; int k_valid_from;
    bf16_t* o; long o_rs; float* lse; long lse_rs; const float* bias;
};
struct AttnRegs { u32x4 kv[8], vv[8]; bf16x8 qa[4]; };
__device__ __forceinline__ void attn_load(const AttnUnit& U, AttnRegs& R) {
    const int tid = threadIdx.x, lane = tid & 63, wave = tid >> 6, fr = lane & 15, fq = lane >> 4;
#pragma unroll
    for (int it = 0; it < 8; ++it) { const int idx = tid + NTHR * it, j = idx >> 4, c = idx & 15;
        R.kv[it] = (u32x4){0u, 0u, 0u, 0u}; R.vv[it] = (u32x4){0u, 0u, 0u, 0u};
        if (j >= U.k_valid_from) { R.kv[it] = *(const u32x4*)(U.k + (long)j * U.k_rs + c * 8); R.vv[it] = *(const u32x4*)(U.v + (long)j * U.v_rs + c * 8); } }
    const bf16_t* qp = U.q + (long)(wave * 16 + fr) * U.q_rs + fq * 8;
#pragma unroll
    for (int kk = 0; kk < 4; ++kk) R.qa[kk] = *(const bf16x8*)(qp + kk * 32);
}
constexpr int ATT_KS = 136, ATT_VS = 144;
constexpr int ATT_VOFF = 256 * ATT_KS * 2, ATT_BOFF = ATT_VOFF + 256 * ATT_VS * 2;
typedef short v4i16_t __attribute__((ext_vector_type(4)));
__device__ __forceinline__ void attn_stage(const AttnRegs& R, const float* bias, unsigned char* lds) {
    bf16_t* Ks = (bf16_t*)lds; bf16_t* Vs = (bf16_t*)(lds + ATT_VOFF); float* btab = (float*)(lds + ATT_BOFF);
    const int tid = threadIdx.x;
#pragma unroll
    for (int it = 0; it < 8; ++it) { const int idx = tid + NTHR * it, j = idx >> 4, c = idx & 15;
        *(u32x4*)(Ks + j * ATT_KS + c * 8) = R.kv[it]; *(u32x4*)(Vs + j * ATT_VS + c * 8) = R.vv[it]; }
    if (bias && tid < 129) btab[tid] = bias[tid];
}
template <class Mid> __device__ __forceinline__ void attn_compute(const AttnUnit& U, const bf16x8 (&qa)[4], unsigned char* lds, const Mid& mid) {
    const bf16_t* Ks = (const bf16_t*)lds; const float* btab = (const float*)(lds + ATT_BOFF);
    const int tid = threadIdx.x, lane = tid & 63, wave = tid >> 6, fr = lane & 15, fq = lane >> 4;
    f32x4 s[16];
#pragma unroll
    for (int kb = 0; kb < 16; ++kb) { s[kb] = (f32x4){0.f, 0.f, 0.f, 0.f};
#pragma unroll
        for (int kk = 0; kk < 4; ++kk) { const bf16x8 kf = *(const bf16x8*)(Ks + (kb * 16 + fr) * ATT_KS + kk * 32 + fq * 8); s[kb] = __builtin_amdgcn_mfma_f32_16x16x32_bf16(kf, qa[kk], s[kb], 0, 0, 0); } }
    const float scale = 0.08838834764831845f;
    const bool banded = U.bias != nullptr; const int vfrom = U.k_valid_from; int qi = wave * 16 + fr;
    asm volatile("" : "+v"(qi));
    float mx = -3.0e38f;
#pragma unroll
    for (int kb = 0; kb < 16; ++kb)
#pragma unroll
        for (int r = 0; r < 4; ++r) { float x = s[kb][r] * scale;
            if (banded) { const int kj = kb * 16 + 4 * fq + r, lag = 128 + qi - kj; const bool ok = lag >= 0 && lag <= 128 && kj >= vfrom; x = ok ? x + btab[ok ? lag : 0] : -1.0e30f; }
            s[kb][r] = x; mx = fmaxf(mx, x); }
    mx = fmaxf(mx, __shfl_xor(mx, 16)); mx = fmaxf(mx, __shfl_xor(mx, 32));
    float sum = 0.f;
#pragma unroll
    for (int kb = 0; kb < 16; ++kb)
#pragma unroll
        for (int r = 0; r < 4; ++r) { const float p = __expf(s[kb][r] - mx); s[kb][r] = p; sum += p; }
    sum += __shfl_xor(sum, 16); sum += __shfl_xor(sum, 32);
    mid();
    f32x4 o[8];
#pragma unroll
    for (int db = 0; db < 8; ++db) o[db] = (f32x4){0.f, 0.f, 0.f, 0.f};
    typedef __attribute__((address_space(3))) v4i16_t* lds_v4;
    unsigned vaddr0 = (unsigned)(uintptr_t)(lds + ATT_VOFF) + (unsigned)((4 * fq + ((lane >> 2) & 3)) * (ATT_VS * 2) + (lane & 3) * 8);
    unsigned vaddr1 = vaddr0 + 4 * 32 * (ATT_VS * 2);
    asm volatile("" : "+v"(vaddr0), "+v"(vaddr1));
#pragma unroll
    for (int ks = 0; ks < 8; ++ks) {
        const unsigned vaddr = (ks < 4 ? vaddr0 : vaddr1) - (unsigned)((ks < 4 ? 0 : 4) * 32 * (ATT_VS * 2));
        u32x4 pw; pw.x = pk2(s[2 * ks][0], s[2 * ks][1]); pw.y = pk2(s[2 * ks][2], s[2 * ks][3]); pw.z = pk2(s[2 * ks + 1][0], s[2 * ks + 1][1]); pw.w = pk2(s[2 * ks + 1][2], s[2 * ks + 1][3]);
        const bf16x8 pf = __builtin_bit_cast(bf16x8, pw);
#pragma unroll
        for (int db = 0; db < 8; ++db) {
            const v4i16_t lo = __builtin_amdgcn_ds_read_tr16_b64_v4i16((lds_v4)(uintptr_t)(vaddr + ks * 32 * (ATT_VS * 2) + db * 32));
            const v4i16_t hi = __builtin_amdgcn_ds_read_tr16_b64_v4i16((lds_v4)(uintptr_t)(vaddr + (ks * 32 + 16) * (ATT_VS * 2) + db * 32));
            const bf16x8 vf = (bf16x8){lo[0], lo[1], lo[2], lo[3], hi[0], hi[1], hi[2], hi[3]};
            o[db] = __builtin_amdgcn_mfma_f32_16x16x32_bf16(pf, vf, o[db], 0, 0, 0); } }
#pragma unroll
    for (int r = 0; r < 4; ++r) { const float inv = 1.0f / __shfl(sum, 4 * fq + r); bf16_t* op = U.o + (long)(wave * 16 + 4 * fq + r) * U.o_rs + fr;
#pragma unroll
        for (int db = 0; db < 8; ++db) op[db * 16] = (bf16_t)f2bf(o[db][r] * inv); }
    if (U.lse && lane < 16) U.lse[(long)qi * U.lse_rs] = mx + __logf(sum);
}
__device__ __forceinline__ void attn_make_unit(const Params& P, int r, AttnUnit& U) {
    unsigned char* ws = P.ws; bf16_t* PROJ = (bf16_t*)(ws + WS_PROJ); const float* BT = (const float*)(ws + WS_TAB);
    constexpr int N_DIL = 3 * 2 * 4 * 64;
    if (r < N_DIL) {
        const int g = r / 512, b = (r >> 8) & 1, h = (r >> 6) & 3, rb = r & 63;
        const int dil = g == 0 ? 1 : (g == 1 ? 4 : 16); const int nbper = 64 / dil; const int res = rb / nbper, n = rb % nbper;
        const long base = (long)b * SEQ + (long)n * 128 * dil + res; const long kbase = base - (long)128 * dil;
        U.q = PROJ + base * NIN + C_Q + g * 512 + h * 128; U.q_rs = (long)dil * NIN;
        U.k = PROJ + kbase * NIN + C_K + g * 512 + h * 128; U.k_rs = (long)dil * NIN; U.v = PROJ + kbase * NIN + C_V + g * 512 + h * 128; U.v_rs = (long)dil * NIN;
        U.k_valid_from = n == 0 ? 128 : 0;
        U.o = (bf16_t*)(ws + WS_ATTO) + ((long)g * MT + base) * 512 + h * 128; U.o_rs = (long)dil * 512;
        U.lse = (float*)(ws + WS_LSE) + ((long)g * MT + base) * 4 + h; U.lse_rs = (long)dil * 4; U.bias = BT + (g * 4 + h) * 132;
    } else {
        const int q = r - N_DIL; const int b = q >> 8, h = (q >> 6) & 3, n = q & 63; const long base = (long)b * SEQ + (long)n * 128;
        const bf16_t* MEMKV = (const bf16_t*)(ws + WS_MEMKV);
        U.q = PROJ + base * NIN + C_MQ + h * 128; U.q_rs = NIN; U.k = MEMKV + (long)b * 256 * 1024 + h * 128; U.k_rs = 1024; U.v = U.k + 512; U.v_rs = 1024; U.k_valid_from = 0;
        U.o = (bf16_t*)(ws + WS_ABR) + ((long)2 * MT + base) * 512 + h * 128; U.o_rs = 512; U.lse = nullptr; U.lse_rs = 0; U.bias = nullptr;
    }
}
__device__ __forceinline__ void attn_units(const Params& P, unsigned char* lds) {
    constexpr int NU = 3 * 2 * 4 * 64 + 2 * 4 * 64;
    int it = blockIdx.x; if (it >= NU) return;
    AttnUnit U; AttnRegs R; attn_make_unit(P, it, U); attn_load(U, R);
    for (;;) {
        __syncthreads();
        attn_stage(R, U.bias, lds);
        bf16x8 qa[4];
#pragma unroll
        for (int kk = 0; kk < 4; ++kk) qa[kk] = R.qa[kk];
        __syncthreads();
        const int nx = it + gridDim.x;
        attn_compute(U, qa, lds, [&]() { if (nx < NU) { AttnUnit UN; attn_make_unit(P, nx, UN); attn_load(UN, R); } });
        if (nx >= NU) break;
        attn_make_unit(P, nx, U); it = nx;
    }
}

template <class KeyPtr>
__device__ __forceinline__ void sample_attn_item(const bf16_t* qrow0  , int nk, const float* biastab  , KeyPtr kptr,
                                                 bf16_t* orow0, long o_rs, float* lse0, long lse_rs, unsigned char* lds) {
    float* qs = (float*)lds;
    float* ps = qs + 1024;
    float* st = ps + 8 * 272;
    const int tid = threadIdx.x, lane = tid & 63, wave = tid >> 6, sub = lane >> 4, l16 = lane & 15;
    __syncthreads();
    for (int idx = tid; idx < 1024; idx += NTHR) { const int t = idx >> 7, d = idx & 127; qs[idx] = bf2f(qrow0[(long)t * NIN + d]) * 0.08838834764831845f; }
    __syncthreads();
    const int npair = 8 * nk;
    for (int p0 = wave * 4 + sub; p0 < npair; p0 += 32 * 4) {
        f32x4 ka[4], kb[4]; int tt[4], jj[4];
#pragma unroll
        for (int u = 0; u < 4; ++u) { int p = p0 + 32 * u; if (p >= npair) p = npair - 1; const int t = p / nk, j = p - t * nk; tt[u] = t; jj[u] = j;
            const f32x4* kp = (const f32x4*)kptr(t, j) + l16 * 2; ka[u] = kp[0]; kb[u] = kp[1]; }
#pragma unroll
        for (int u = 0; u < 4; ++u) { const f32x4* qp = (const f32x4*)(qs + tt[u] * 128) + l16 * 2; const f32x4 qa = qp[0], qb = qp[1];
            float acc = (ka[u].x * qa.x + ka[u].y * qa.y) + (ka[u].z * qa.z + ka[u].w * qa.w) + (kb[u].x * qb.x + kb[u].y * qb.y) + (kb[u].z * qb.z + kb[u].w * qb.w);
            acc += __shfl_xor(acc, 1); acc += __shfl_xor(acc, 2); acc += __shfl_xor(acc, 4); acc += __shfl_xor(acc, 8);
            if (l16 == 0 && p0 + 32 * u < npair) ps[tt[u] * 272 + jj[u]] = acc + (biastab ? biastab[jj[u]] : 0.f); }
    }
    __syncthreads();
    { const int t = wave; float m = -3.0e38f;
      for (int j = lane; j < nk; j += 64) m = fmaxf(m, ps[t * 272 + j]);
#pragma unroll
      for (int o = 1; o < 64; o <<= 1) m = fmaxf(m, __shfl_xor(m, o));
      float s = 0.f;
      for (int j = lane; j < nk; j += 64) { const float p = __expf(ps[t * 272 + j] - m); ps[t * 272 + j] = p; s += p; }
      s = wave_sum(s);
      if (lane == 0) { st[t] = 1.0f / s; if (lse0) lse0[(long)t * lse_rs] = m + __logf(s); }
      if (lane < 16) ps[t * 272 + nk + lane] = 0.f;
    }
    __syncthreads();
    { const int t = wave; f32x2 acc = (f32x2){0.f, 0.f};
      for (int j0 = 0; j0 < nk; j0 += 16) {
          f32x2 vv[16];
#pragma unroll
          for (int u = 0; u < 16; ++u) { int j = j0 + u; if (j >= nk) j = nk - 1; vv[u] = ((const f32x2*)(kptr(t, j) + 512))[lane]; }
#pragma unroll
          for (int u = 0; u < 16; ++u) { const float p = ps[t * 272 + j0 + u]; acc.x += p * vv[u].x; acc.y += p * vv[u].y; } }
      const float inv = st[t];
      *(unsigned*)(orow0 + (long)t * o_rs + 2 * lane) = pk2(acc.x * inv, acc.y * inv); }
}

__device__ __forceinline__ void sample_hgrn_item(const Params& P, int sb, int h, unsigned char* lds) {
    float* fs = (float*)lds;
    float* ks = fs + 1024;
    float* qs = ks + 1024;
    float* is_ = qs + 1024;
    float* part = is_ + 1024;
    float* osq = part + 512;
    const int tid = threadIdx.x, lane = tid & 63, wave = tid >> 6;
    const bf16_t* PROJ = (const bf16_t*)(P.ws + WS_PROJ); const float* LB = (const float*)(P.ws + WS_TAB) + 3 * 4 * 132;
    __syncthreads();
    for (int idx = tid; idx < 1024; idx += NTHR) { const int t = idx >> 7, k = idx & 127; const bf16_t* pr = PROJ + (size_t)(MP + sb * 8 + t) * NIN + h * 128 + k;
        const float lb = LB[h * 128 + k]; const float f = lb + (1.0f - lb) * sigmoidf_(bf2f(pr[C_HF]));
        fs[idx] = f; ks[idx] = 1.0f - f; qs[idx] = bf2f(pr[C_HQ]); is_[idx] = bf2f(pr[C_HI]); }
    const int v = tid & 127, kq = tid >> 7;
    const float* s_in = P.in[7] + ((size_t)(sb * 4 + h) * 128) * 128; float* s_out = P.out + O_SHG + ((size_t)(sb * 4 + h) * 128) * 128;
    float S[32];
#pragma unroll
    for (int i = 0; i < 32; ++i) S[i] = s_in[(size_t)(kq * 32 + i) * 128 + v];
    __syncthreads();
    const float gain = P.in[15][v];
    for (int t = 0; t < 8; ++t) {
        const float iv = is_[t * 128 + v]; float po = 0.f;
#pragma unroll
        for (int i = 0; i < 32; ++i) { const int k = kq * 32 + i; S[i] = fs[t * 128 + k] * S[i] + ks[t * 128 + k] * iv; po += S[i] * qs[t * 128 + k]; }
        part[kq * 128 + v] = po;
        __syncthreads();
        if (tid < 128) { const float o = (part[v] + part[128 + v]) + (part[256 + v] + part[384 + v]);
            const float ss = wave_sum(o * o); if (lane == 0) osq[wave] = ss;
            part[v] = o; }
        __syncthreads();
        if (tid < 128) { const float o = part[v]; const float r = rsqrtf((osq[0] + osq[1]) * (1.0f / 128.0f) + EPS);
            const size_t row = (size_t)(MP + sb * 8 + t); const float gate = sigmoidf_(bf2f(PROJ[row * NIN + C_HG + h * 128 + v]));
            ((bf16_t*)(P.ws + WS_ABR))[((size_t)1 * MT + row) * 512 + h * 128 + v] = (bf16_t)f2bf(o * r * gain * gate); }
        __syncthreads();
    }
#pragma unroll
    for (int i = 0; i < 32; ++i) s_out[(size_t)(kq * 32 + i) * 128 + v] = S[i];
}

constexpr int HL_QS = 136, HL_VS = 144;
constexpr int HL_KI = 64 * HL_QS * 2, HL_KT = HL_KI + 160 * HL_QS * 2, HL_VV = HL_KT + 64 * HL_VS * 2, HL_TT = HL_VV + 64 * HL_VS * 2;
typedef __attribute__((address_space(3))) v4i16_t* lds_v4p;
__device__ __forceinline__ bf16x8 tr_pair(unsigned a_lo, unsigned a_hi) {
    const v4i16_t lo = __builtin_amdgcn_ds_read_tr16_b64_v4i16((lds_v4p)(uintptr_t)a_lo), hi = __builtin_amdgcn_ds_read_tr16_b64_v4i16((lds_v4p)(uintptr_t)a_hi);
    return (bf16x8){lo[0], lo[1], lo[2], lo[3], hi[0], hi[1], hi[2], hi[3]};
}
__device__ __forceinline__ void hgrn_local_unit(const Params& P, int bh, int c, unsigned char* lds) {
    bf16_t* QI = (bf16_t*)lds; bf16_t* KI = (bf16_t*)(lds + HL_KI); bf16_t* KT = (bf16_t*)(lds + HL_KT); bf16_t* VV = (bf16_t*)(lds + HL_VV); float* TT = (float*)(lds + HL_TT);
    const int tid = threadIdx.x, lane = tid & 63, wave = tid >> 6, fr = lane & 15, fq = lane >> 4;
    const int b = bh >> 2, h = bh & 3; const size_t row0 = (size_t)b * SEQ + (size_t)c * 64;
    const bf16_t* PROJ = (const bf16_t*)(P.ws + WS_PROJ); const float* LB = (const float*)(P.ws + WS_TAB) + 3 * 4 * 132;
    __syncthreads();
    {
#pragma unroll
        for (int it = 0; it < 2; ++it) { const int idx = tid + NTHR * it, sr = idx >> 4, ch = idx & 15;
            *(u32x4*)(VV + sr * HL_VS + ch * 8) = *(const u32x4*)(PROJ + (row0 + sr) * NIN + C_HI + h * 128 + ch * 8); }
    }
    const int k = tid & 127, I = tid >> 7;
    float Gl[16], qv[16], kk[16];
    {
        const bf16_t* pr = PROJ + (row0 + 16 * I) * NIN + h * 128 + k; const float lb = LB[h * 128 + k]; float run = 0.f;
#pragma unroll
        for (int j = 0; j < 16; ++j) { const float x = bf2f(pr[(size_t)j * NIN + C_HF]); const float f = lb + (1.0f - lb) * sigmoidf_(x); run += __logf(f); Gl[j] = run; kk[j] = 1.0f - f; qv[j] = bf2f(pr[(size_t)j * NIN + C_HQ]); }
        TT[I * 128 + k] = run;
    }
    __syncthreads();
    {
        const float T0 = TT[k], T1 = TT[128 + k], T2 = TT[256 + k], T3 = TT[384 + k];
        const float rI = I == 0 ? 0.f : (I == 1 ? T0 : (I == 2 ? T0 + T1 : T0 + T1 + T2));
        const float TI = I == 0 ? T0 : (I == 1 ? T1 : (I == 2 ? T2 : T3));
        const float gend = (T0 + T1) + (T2 + T3);
        const float eR = __expf(rI);
        const float Tn1 = I == 0 ? T1 : (I == 1 ? T2 : T3), Tn2 = I == 0 ? T2 : T3;
        const float f2 = __expf(Tn1), f3 = __expf(Tn1 + Tn2);
        const float fT = __expf(gend - (rI + TI));
        const int ibase0 = 0, ibase1 = 16, ibase2 = 48, ibase3 = 96;
        const int dbase = I == 0 ? ibase0 : (I == 1 ? ibase1 : (I == 2 ? ibase2 : ibase3));
        bf16_t* HQT = (bf16_t*)(P.ws + WS_HQT) + (row0 + 16 * I) * 512 + h * 128 + k;
#pragma unroll
        for (int j = 0; j < 16; ++j) {
            const int t = 16 * I + j;
            const float qi = qv[j] * __expf(Gl[j]);
            QI[t * HL_QS + k] = (bf16_t)f2bf(qi); HQT[(size_t)j * 512] = (bf16_t)f2bf(qi * eR);
            KI[(dbase + t) * HL_QS + k] = (bf16_t)f2bf(kk[j] * __expf(-Gl[j]));
            const float kh = kk[j] * __expf(TI - Gl[j]);
            if (I == 0) { KI[(ibase1 + t) * HL_QS + k] = (bf16_t)f2bf(kh); KI[(ibase2 + t) * HL_QS + k] = (bf16_t)f2bf(kh * f2); KI[(ibase3 + t) * HL_QS + k] = (bf16_t)f2bf(kh * f3); }
            else if (I == 1) { KI[(ibase2 + t) * HL_QS + k] = (bf16_t)f2bf(kh); KI[(ibase3 + t) * HL_QS + k] = (bf16_t)f2bf(kh * f2); }
            else if (I == 2) { KI[(ibase3 + t) * HL_QS + k] = (bf16_t)f2bf(kh); }
            KT[t * HL_VS + k] = (bf16_t)f2bf(kh * fT);
        }
        if (I == 3) ((float*)(P.ws + WS_DC))[((size_t)bh * 128 + c) * 128 + k] = __expf(gend);
    }
    __syncthreads();
    const unsigned lbase = (unsigned)(uintptr_t)lds;
    const unsigned trow = (unsigned)(4 * fq + ((lane >> 2) & 3)), tcol = (unsigned)((lane & 3) * 8);
    {
        const int I2 = wave >> 1, vh = wave & 1;
        const int ib = I2 == 0 ? 0 : (I2 == 1 ? 16 : (I2 == 2 ? 48 : 96));
        f32x4 sT[4];
#pragma unroll
        for (int J = 0; J < 4; ++J) { sT[J] = (f32x4){0.f, 0.f, 0.f, 0.f};
            if (J <= I2) {
#pragma unroll
                for (int q4 = 0; q4 < 4; ++q4) { const bf16x8 a = *(const bf16x8*)(KI + (ib + 16 * J + fr) * HL_QS + q4 * 32 + fq * 8); const bf16x8 bb = *(const bf16x8*)(QI + (16 * I2 + fr) * HL_QS + q4 * 32 + fq * 8);
                    sT[J] = __builtin_amdgcn_mfma_f32_16x16x32_bf16(a, bb, sT[J], 0, 0, 0); }
                if (J == I2) {
#pragma unroll
                    for (int r = 0; r < 4; ++r) if (4 * fq + r > fr) sT[J][r] = 0.f; }
            } }
        u32x4 p0, p1; p0.x = pk2(sT[0][0], sT[0][1]); p0.y = pk2(sT[0][2], sT[0][3]); p0.z = pk2(sT[1][0], sT[1][1]); p0.w = pk2(sT[1][2], sT[1][3]);
        p1.x = pk2(sT[2][0], sT[2][1]); p1.y = pk2(sT[2][2], sT[2][3]); p1.z = pk2(sT[3][0], sT[3][1]); p1.w = pk2(sT[3][2], sT[3][3]);
        const bf16x8 pa0 = __builtin_bit_cast(bf16x8, p0), pa1 = __builtin_bit_cast(bf16x8, p1);
        float* OI = (float*)(P.ws + WS_OINTRA) + (row0 + 16 * I2 + 4 * fq) * 512 + h * 128 + fr;
#pragma unroll
        for (int vb = 0; vb < 4; ++vb) { const int vblk = vh * 4 + vb;
            const unsigned va = lbase + HL_VV + trow * (HL_VS * 2) + tcol + vblk * 32;
            f32x4 o = (f32x4){0.f, 0.f, 0.f, 0.f};
            o = __builtin_amdgcn_mfma_f32_16x16x32_bf16(pa0, tr_pair(va, va + 16 * (HL_VS * 2)), o, 0, 0, 0);
            if (I2 >= 2) o = __builtin_amdgcn_mfma_f32_16x16x32_bf16(pa1, tr_pair(va + 32 * (HL_VS * 2), va + 48 * (HL_VS * 2)), o, 0, 0, 0);
#pragma unroll
            for (int r = 0; r < 4; ++r) OI[(size_t)r * 512 + vblk * 16] = o[r]; }
    }
    {
        float* Up = (float*)(P.ws + WS_U) + ((size_t)bh * 128 + c) * 16384 + (16 * wave + 4 * fq) * 128 + fr;
        const unsigned ka = lbase + HL_KT + trow * (HL_VS * 2) + tcol + wave * 32;
        const bf16x8 a0 = tr_pair(ka, ka + 16 * (HL_VS * 2)), a1 = tr_pair(ka + 32 * (HL_VS * 2), ka + 48 * (HL_VS * 2));
#pragma unroll
        for (int vblk = 0; vblk < 8; ++vblk) { const unsigned va = lbase + HL_VV + trow * (HL_VS * 2) + tcol + vblk * 32;
            f32x4 u = (f32x4){0.f, 0.f, 0.f, 0.f};
            u = __builtin_amdgcn_mfma_f32_16x16x32_bf16(a0, tr_pair(va, va + 16 * (HL_VS * 2)), u, 0, 0, 0);
            u = __builtin_amdgcn_mfma_f32_16x16x32_bf16(a1, tr_pair(va + 32 * (HL_VS * 2), va + 48 * (HL_VS * 2)), u, 0, 0, 0);
#pragma unroll
            for (int r = 0; r < 4; ++r) Up[(size_t)r * 128 + vblk * 16] = u[r]; }
    }
}

template <int SEL> __device__ __forceinline__ void phase_mix1(const Params& P, unsigned char* lds) {
    unsigned char* ws = P.ws; bf16_t* PROJ = (bf16_t*)(ws + WS_PROJ);
    const float* BT = (const float*)(ws + WS_TAB);
    constexpr int N_DIL = 3 * 2 * 4 * 64, N_MEM = 2 * 4 * 64, N_HL = 8 * 128, N_SA = 32 * 3 * 4, N_SM = 32 * 4, N_SH = 32 * 4;
    constexpr int NTOT = N_HL + N_SA + N_SM + N_SH;
    if (SEL & 1) attn_units(P, lds);
    for (int it = blockIdx.x; it < NTOT; it += gridDim.x) {
        int r = it;
        if (r < N_HL) { if (SEL & 4) hgrn_local_unit(P, r >> 7, r & 127, lds); continue; }
        r -= N_HL;
        if (r < N_SA + N_SM) {
            int sb, g, h;
            if (r < N_SA) { sb = r / 12; g = (r / 4) % 3; h = r & 3; } else { const int q = r - N_SA; sb = q >> 2; g = 3; h = q & 3; }
            const int W = g == 0 ? 128 : (g == 1 ? 512 : (g == 2 ? 2048 : 256)), dil = g == 0 ? 1 : (g == 1 ? 4 : (g == 2 ? 16 : -1));
            const float* cache = (g == 0 ? P.in[3] : (g == 1 ? P.in[4] : (g == 2 ? P.in[5] : P.in[6]))) + (size_t)sb * W * 1024 + h * 128;
            const float* neu = P.out + (g == 0 ? O_SW1 : (g == 1 ? O_SW2 : O_SW3)) + ((size_t)sb * W + (W - 8)) * 1024 + h * 128;
            const long row0 = MP + sb * 8;
            const int tq = g < 3 ? 1 : 0, base_idx = g < 3 ? W : 0;
            auto kp = [&](int t, int j) { const int idx = base_idx + tq * t - dil * j; return idx < W ? cache + (size_t)idx * 1024 : neu + (size_t)(idx - W) * 1024; };
            bf16_t* op = g < 3 ? (bf16_t*)(ws + WS_ATTO) + ((long)g * MT + row0) * 512 + h * 128 : (bf16_t*)(ws + WS_ABR) + ((long)2 * MT + row0) * 512 + h * 128;
            if (SEL & 8) sample_attn_item(PROJ + row0 * NIN + (g < 3 ? C_Q + g * 512 : C_MQ) + h * 128, g < 3 ? 129 : 256, g < 3 ? BT + (g * 4 + h) * 132 : nullptr,
                kp, op, 512, g < 3 ? (float*)(ws + WS_LSE) + ((long)g * MT + row0) * 4 + h : nullptr, 4, lds);
            continue; }
        r -= N_SA;
        r -= N_SM;
        if (SEL & 32) sample_hgrn_item(P, r >> 2, r & 3, lds);
    }
}

__device__ __forceinline__ void phase_scan(const Params& P) {
    const float* __restrict__ U = (const float*)(P.ws + WS_U); const float* __restrict__ DC = (const float*)(P.ws + WS_DC); bf16_t* __restrict__ S0 = (bf16_t*)(P.ws + WS_S0);
    for (int e = blockIdx.x * NTHR + threadIdx.x; e < 8 * 16384; e += gridDim.x * NTHR) {
        const int bh = e >> 14, kv = e & 16383, k = kv >> 7; float S = 0.f;
        const float* up = U + (size_t)bh * 128 * 16384 + kv; const float* dp = DC + (size_t)bh * 128 * 128 + k; bf16_t* sp = S0 + (size_t)bh * 128 * 16384 + kv;
        for (int c0 = 0; c0 < 128; c0 += 16) {
            float u[16], d[16];
#pragma unroll
            for (int i = 0; i < 16; ++i) { u[i] = up[(size_t)(c0 + i) * 16384]; d[i] = dp[(c0 + i) * 128]; }
#pragma unroll
            for (int i = 0; i < 16; ++i) { sp[(size_t)(c0 + i) * 16384] = (bf16_t)f2bf(S); S = d[i] * S + u[i]; }
        }
        P.out[O_PHG + (size_t)bh * 16384 + kv] = S;
    }
}

constexpr int HF_SS = 144, HF_QS = 136, HF_QT = 128 * HF_SS * 2, HF_SSQ = HF_QT + 64 * HF_QS * 2;
__device__ __forceinline__ void hgrn_final_unit(const Params& P, int bh, int c, unsigned char* lds) {
    bf16_t* Ss = (bf16_t*)lds; bf16_t* Qt = (bf16_t*)(lds + HF_QT); float* ssq = (float*)(lds + HF_SSQ);
    const int tid = threadIdx.x, lane = tid & 63, wave = tid >> 6, fr = lane & 15, fq = lane >> 4;
    const int b = bh >> 2, h = bh & 3; const size_t row0 = (size_t)b * SEQ + (size_t)c * 64;
    __syncthreads();
    { const bf16_t* s0 = (const bf16_t*)(P.ws + WS_S0) + ((size_t)bh * 128 + c) * 16384;
#pragma unroll
      for (int it = 0; it < 4; ++it) { const int idx = tid + NTHR * it, kr = idx >> 4, ch = idx & 15; *(u32x4*)(Ss + kr * HF_SS + ch * 8) = *(const u32x4*)(s0 + kr * 128 + ch * 8); }
      const bf16_t* HQT = (const bf16_t*)(P.ws + WS_HQT);
#pragma unroll
      for (int it = 0; it < 2; ++it) { const int idx = tid + NTHR * it, tr = idx >> 4, ch = idx & 15; *(u32x4*)(Qt + tr * HF_QS + ch * 8) = *(const u32x4*)(HQT + (row0 + tr) * 512 + h * 128 + ch * 8); } }
    __syncthreads();
    const int I = wave & 3, vh = wave >> 2;
    const unsigned lbase = (unsigned)(uintptr_t)lds;
    const unsigned trow = (unsigned)(4 * fq + ((lane >> 2) & 3)), tcol = (unsigned)((lane & 3) * 8);
    bf16x8 af[4];
#pragma unroll
    for (int kk = 0; kk < 4; ++kk) { const u32x2 lo = *(const u32x2*)(Qt + (16 * I + fr) * HF_QS + kk * 32 + 4 * fq), hi = *(const u32x2*)(Qt + (16 * I + fr) * HF_QS + kk * 32 + 16 + 4 * fq);
        u32x4 w; w.x = lo.x; w.y = lo.y; w.z = hi.x; w.w = hi.y; af[kk] = __builtin_bit_cast(bf16x8, w); }
    const size_t rowb = row0 + 16 * I + 4 * fq;
    f32x4 o[4]; float part[4] = {0.f, 0.f, 0.f, 0.f};
#pragma unroll
    for (int vb = 0; vb < 4; ++vb) { const int vblk = vh * 4 + vb;
        const float* oi = (const float*)(P.ws + WS_OINTRA) + rowb * 512 + h * 128 + vblk * 16 + fr;
        o[vb] = (f32x4){oi[0], oi[512], oi[1024], oi[1536]};
#pragma unroll
        for (int kk = 0; kk < 4; ++kk) { const unsigned sa = lbase + (trow + 32 * kk) * (HF_SS * 2) + tcol + vblk * 32;
            o[vb] = __builtin_amdgcn_mfma_f32_16x16x32_bf16(af[kk], tr_pair(sa, sa + 16 * (HF_SS * 2)), o[vb], 0, 0, 0); }
#pragma unroll
        for (int r = 0; r < 4; ++r) part[r] += o[vb][r] * o[vb][r]; }
#pragma unroll
    for (int r = 0; r < 4; ++r) { part[r] += __shfl_xor(part[r], 1); part[r] += __shfl_xor(part[r], 2); part[r] += __shfl_xor(part[r], 4); part[r] += __shfl_xor(part[r], 8);
        if (fr == 0) ssq[vh * 64 + 16 * I + 4 * fq + r] = part[r]; }
    __syncthreads();
    const float* gain = P.in[15];
#pragma unroll
    for (int r = 0; r < 4; ++r) { const int t = 16 * I + 4 * fq + r; const float rs = rsqrtf((ssq[t] + ssq[64 + t]) * (1.0f / 128.0f) + EPS);
        const size_t row = row0 + t; const bf16_t* gp = (const bf16_t*)(P.ws + WS_PROJ) + row * NIN + C_HG + h * 128 + fr; bf16_t* op = (bf16_t*)(P.ws + WS_ABR) + ((size_t)1 * MT + row) * 512 + h * 128 + fr;
#pragma unroll
        for (int vb = 0; vb < 4; ++vb) { const int v = (vh * 4 + vb) * 16; op[v] = (bf16_t)f2bf(o[vb][r] * rs * gain[v + fr] * sigmoidf_(bf2f(gp[v]))); } }
}
__device__ __forceinline__ void phase_mix2(const Params& P, unsigned char* lds) {
    for (int it = blockIdx.x; it < 1024; it += gridDim.x) hgrn_final_unit(P, it >> 7, it & 127, lds);
    const int lane = threadIdx.x & 63, wave = threadIdx.x >> 6; const int gw = blockIdx.x * NWAVES + wave, NGW = gridDim.x * NWAVES;
    const bf16_t* ATTO = (const bf16_t*)(P.ws + WS_ATTO); const float* LSE = (const float*)(P.ws + WS_LSE); bf16_t* ABR = (bf16_t*)(P.ws + WS_ABR);
    for (int row = gw; row < MT; row += NGW) {
        const int h = lane >> 4; const float l0 = LSE[((size_t)0 * MT + row) * 4 + h], l1 = LSE[((size_t)1 * MT + row) * 4 + h], l2 = LSE[((size_t)2 * MT + row) * 4 + h];
        const float m = fmaxf(l0, fmaxf(l1, l2)); float w0 = __expf(l0 - m), w1 = __expf(l1 - m), w2 = __expf(l2 - m); const float inv = 1.0f / (w0 + w1 + w2); w0 *= inv; w1 *= inv; w2 *= inv;
        float a[8], b2[8], c2[8], o[8];
        load_bf16x8(ATTO + ((size_t)0 * MT + row) * 512 + lane * 8, a); load_bf16x8(ATTO + ((size_t)1 * MT + row) * 512 + lane * 8, b2); load_bf16x8(ATTO + ((size_t)2 * MT + row) * 512 + lane * 8, c2);
#pragma unroll
        for (int e = 0; e < 8; ++e) o[e] = w0 * a[e] + w1 * b2[e] + w2 * c2[e];
        store_bf16x8(ABR + (size_t)row * 512 + lane * 8, o);
    }
}

struct BranchOrder {
    pg8::StaticOrder so;
    __device__ __forceinline__ bool next(int i, pg8::Unit& u) const { pg8::Unit t; if (!so.next(i / 3, t)) return false; const int br = i % 3; u.pm = br * (MT / 256) + t.pm; u.pn = br * 4 + t.pn; return true; }
    __device__ __forceinline__ void a_ready(const pg8::Unit&) const {}
    __device__ __forceinline__ void done(const pg8::Unit&) const {}
};
struct EpiBranch {
    static constexpr bool PERM = true, AFTER_DRAIN = false; const bf16_t* PROJ; bf16_t* MERGED;
    __device__ __forceinline__ bool keep(const pg8::Unit& u) const { return (u.pn >> 2) < 2; }
    __device__ __forceinline__ void operator()(f32x4 (&acc)[2][2][4][2], const pg8::Unit& u, int wr, int wc, int fr, int fq) const {
        const int br = u.pn >> 2, pn = u.pn & 3, pm = u.pm - br * (MT / 256);
        const int row0 = pm * 256 + wr * 64 + fr, col0 = pn * 256 + wc * 32 + 8 * fq;
        const int gc = br == 0 ? C_GA : (br == 1 ? C_GH : C_GM), gn = br == 0 ? C_GH : C_GM;
#pragma unroll
        for (int ai = 0; ai < 2; ++ai)
#pragma unroll
            for (int m = 0; m < 4; ++m)
#pragma unroll
                for (int bj = 0; bj < 2; ++bj) {
                    const int row = row0 + ai * 128 + m * 16, col = col0 + bj * 128; const bf16_t* pr = PROJ + (size_t)row * NIN + col;
                    float gcur[8], fac[8]; load_bf16x8(pr + gc, gcur);
                    if (br < 2) { float gnx[8]; load_bf16x8(pr + gn, gnx);
#pragma unroll
                        for (int e = 0; e < 8; ++e) fac[e] = (1.0f + __expf(-gnx[e])) / (1.0f + __expf(-gcur[e])); }
                    else {
#pragma unroll
                        for (int e = 0; e < 8; ++e) fac[e] = 1.0f / (1.0f + __expf(-gcur[e])); }
#pragma unroll
                    for (int e = 0; e < 4; ++e) { acc[ai][bj][m][0][e] *= fac[e]; acc[ai][bj][m][1][e] *= fac[4 + e]; }
                    if (br == 2) { const f32x4 a = acc[ai][bj][m][0], b = acc[ai][bj][m][1]; float v[8] = {a[0], a[1], a[2], a[3], b[0], b[1], b[2], b[3]}; store_bf16x8(MERGED + (size_t)row * 1024 + col, v); }
                }
    }
};
__device__ __forceinline__ void phase_branch(const Params& P, unsigned char* lds) {
    float* red = (float*)lds; unsigned char* ws = P.ws;
    const bf16_t* ABR = (const bf16_t*)(ws + WS_ABR); const bf16_t* WBR = (const bf16_t*)(ws + WS_WBR_T); const bf16_t* PROJ = (const bf16_t*)(ws + WS_PROJ); bf16_t* MERGED = (bf16_t*)(ws + WS_MERGED);
    {
        pg8::Gemm g{ABR, WBR, 3 * MT, 3 * 1024, 512}; BranchOrder S; S.so.init(MP, 1024, (int)gridDim.x, (int)blockIdx.x);
        const EpiBranch E{PROJ, MERGED};
        pg8::gemm_phase<EpiBranch, BranchOrder, false, true>((PG8_LAS unsigned char*)lds, g, S, E);
    }
    constexpr int NU = 4 * 16;
    for (int u = blockIdx.x; u < NU; u += gridDim.x) {
        const int tr = 256 + (u & 3), tc = u >> 2;
        float msum[8] = {0.f, 0.f, 0.f, 0.f, 0.f, 0.f, 0.f, 0.f};
#pragma unroll
        for (int br = 0; br < 3; ++br) {
            sgemm_unit(ABR + (size_t)br * MT * 512, 512, WBR + (size_t)br * 1024 * 512, 512, 512, tr * 64, tc * 64, red, [&](int row, int col, float* v) {
                float g[8]; load_bf16x8(PROJ + (size_t)row * NIN + (br == 0 ? C_GA : (br == 1 ? C_GH : C_GM)) + col, g);
#pragma unroll
                for (int e = 0; e < 8; ++e) msum[e] += sigmoidf_(g[e]) * v[e];
                if (br == 2) store_bf16x8(MERGED + (size_t)row * 1024 + col, msum); });
        }
    }
}
struct StoreF32x4 { float* C; __device__ __forceinline__ void operator()(int row, int col, const f32x4& v) const { *(f32x4*)(C + (size_t)row * 1024 + col) = v; } };
struct StoreBf16x8 { bf16_t* C; int ldc; __device__ __forceinline__ void operator()(int row, int col, float* v) const { store_bf16x8(C + (size_t)row * ldc + col, v); } };
__device__ __forceinline__ void phase_gemm_f32(const bf16_t* A, const bf16_t* Bt, int K, float* C, unsigned char* lds) {
    float* red = (float*)lds;
    {
        pg8::Gemm g{A, Bt, MP, 1024, K}; pg8::StaticOrder S; S.init(MP, 1024, (int)gridDim.x, (int)blockIdx.x);
        const pg8::Epi4<StoreF32x4> E{StoreF32x4{C}};
        pg8::gemm_phase<pg8::Epi4<StoreF32x4>, pg8::StaticOrder, false, true>((PG8_LAS unsigned char*)lds, g, S, E);
    }
    constexpr int NU = 4 * 16;
    for (int u = blockIdx.x; u < NU; u += gridDim.x) { const int tr = 256 + (u & 3), tc = u >> 2;
        sgemm_unit(A, K, Bt, K, K, tr * 64, tc * 64, red, [&](int row, int col, float* v) { store_f32x8(C + (size_t)row * 1024 + col, v); }); }
}
__device__ __forceinline__ void phase_ffn_up(const Params& P, unsigned char* lds) {
    float* red = (float*)lds; const bf16_t* XN = (const bf16_t*)(P.ws + WS_XN); const bf16_t* W = (const bf16_t*)(P.ws + WS_WAB_T); bf16_t* AB = (bf16_t*)(P.ws + WS_AB);
    const StoreBf16x8 f{AB, 8192};
    {
        pg8::Gemm g{XN, W, MP, 8192, D}; pg8::StaticOrder S; S.init(MP, 8192, (int)gridDim.x, (int)blockIdx.x);
        const pg8::Epi8<StoreBf16x8> E{f};
        pg8::gemm_phase<pg8::Epi8<StoreBf16x8>, pg8::StaticOrder, true, true>((PG8_LAS unsigned char*)lds, g, S, E);
    }
    constexpr int NU = 4 * 128;
    for (int u = blockIdx.x; u < NU; u += gridDim.x) { const int tr = 256 + (u & 3), tc = u >> 2; sgemm_unit(XN, D, W, D, D, tr * 64, tc * 64, red, f); }
}
__device__ __forceinline__ void phase_mid_norm(const Params& P) {
    const int lane = threadIdx.x & 63, wave = threadIdx.x >> 6; const int gw = blockIdx.x * NWAVES + wave, NGW = gridDim.x * NWAVES;
    const float* MIX = (const float*)(P.ws + WS_MIX); bf16_t* XN = (bf16_t*)(P.ws + WS_XN);
    for (int row = gw; row < MT; row += NGW) {
        const float* xr = row < MP ? P.in[0] + (size_t)row * D : P.in[1] + (size_t)(row - MP) * D; float* yr = P.out + (size_t)row * D;
        f32x4 m[4], x[4]; float s = 0.f;
#pragma unroll
        for (int j = 0; j < 4; ++j) { m[j] = ((const f32x4*)(MIX + (size_t)row * D))[lane + 64 * j]; s += (m[j].x * m[j].x + m[j].y * m[j].y) + (m[j].z * m[j].z + m[j].w * m[j].w); }
        const float r = rsqrtf(wave_sum(s) * (1.0f / 1024.0f) + EPS); float s2 = 0.f;
#pragma unroll
        for (int j = 0; j < 4; ++j) { const f32x4 g = ((const f32x4*)P.in[12])[lane + 64 * j]; x[j] = ((const f32x4*)xr)[lane + 64 * j] + m[j] * r * g; ((f32x4*)yr)[lane + 64 * j] = x[j];
            s2 += (x[j].x * x[j].x + x[j].y * x[j].y) + (x[j].z * x[j].z + x[j].w * x[j].w); }
        const float r2 = rsqrtf(wave_sum(s2) * (1.0f / 1024.0f) + EPS);
#pragma unroll
        for (int j = 0; j < 4; ++j) { const f32x4 g = ((const f32x4*)P.in[22])[lane + 64 * j]; u32x2 o; o.x = pk2(x[j].x * r2 * g.x, x[j].y * r2 * g.y); o.y = pk2(x[j].z * r2 * g.z, x[j].w * r2 * g.w);
            ((u32x2*)(XN + (size_t)row * D))[lane + 64 * j] = o; }
    }
}
__device__ __forceinline__ void phase_ffn_gate(const Params& P) {
    const bf16_t* AB = (const bf16_t*)(P.ws + WS_AB); bf16_t* H = (bf16_t*)(P.ws + WS_H);
    const float* cw = P.in[26]; const float* cb = P.in[27]; const float* cbuf = P.in[8];
    for (size_t idx = (size_t)blockIdx.x * NTHR + threadIdx.x; idx < (size_t)MT * 512; idx += (size_t)gridDim.x * NTHR) {
        const int row = (int)(idx >> 9), n = (int)(idx & 511) * 8; const int cofs = (n >> 7) * 256 + (n & 127);
        float a[8], b[8], a1[8], a2[8];
        load_bf16x8(AB + (size_t)row * 8192 + cofs, a); load_bf16x8(AB + (size_t)row * 8192 + cofs + 128, b);
        if (row < MP) { const int t = row & 8191;
            if (t >= 1) load_bf16x8(AB + (size_t)(row - 1) * 8192 + cofs, a1); else { for (int e = 0; e < 8; ++e) a1[e] = 0.f; }
            if (t >= 2) load_bf16x8(AB + (size_t)(row - 2) * 8192 + cofs, a2); else { for (int e = 0; e < 8; ++e) a2[e] = 0.f; }
            if (t >= SEQ - 2) store_f32x8(P.out + O_PCONV + ((size_t)(row >> 13) * 2 + (t - (SEQ - 2))) * DFF + n, a);
        } else { const int sb = (row - MP) >> 3, st = (row - MP) & 7; const float* cbb = cbuf + (size_t)sb * 2 * DFF + n;
            if (st >= 1) load_bf16x8(AB + (size_t)(row - 1) * 8192 + cofs, a1); else { for (int e = 0; e < 8; ++e) a1[e] = cbb[DFF + e]; }
            if (st >= 2) load_bf16x8(AB + (size_t)(row - 2) * 8192 + cofs, a2); else { for (int e = 0; e < 8; ++e) a2[e] = cbb[(st == 0 ? 0 : DFF) + e]; }
            if (st >= 6) store_f32x8(P.out + O_SCONV + ((size_t)sb * 2 + (st - 6)) * DFF + n, a);
        }
        float o[8];
#pragma unroll
        for (int e = 0; e < 8; ++e) { const float c = cb[n + e] + a2[e] * cw[n + e] + a1[e] * cw[DFF + n + e] + a[e] * cw[2 * DFF + n + e]; o[e] = c * sigmoidf_(c) * b[e]; }
        store_bf16x8(H + (size_t)row * DFF + n, o);
    }
}
__device__ __forceinline__ void phase_final_norm(const Params& P) {
    const int lane = threadIdx.x & 63, wave = threadIdx.x >> 6; const int gw = blockIdx.x * NWAVES + wave, NGW = gridDim.x * NWAVES;
    const float* Fm = (const float*)(P.ws + WS_MIX);
    for (int row = gw; row < MT; row += NGW) {
        float* yr = P.out + (size_t)row * D; f32x4 m[4]; float s = 0.f;
#pragma unroll
        for (int j = 0; j < 4; ++j) { m[j] = ((const f32x4*)(Fm + (size_t)row * D))[lane + 64 * j]; s += (m[j].x * m[j].x + m[j].y * m[j].y) + (m[j].z * m[j].z + m[j].w * m[j].w); }
        const float r = rsqrtf(wave_sum(s) * (1.0f / 1024.0f) + EPS);
#pragma unroll
        for (int j = 0; j < 4; ++j) { const f32x4 g = ((const f32x4*)P.in[23])[lane + 64 * j]; ((f32x4*)yr)[lane + 64 * j] = ((const f32x4*)yr)[lane + 64 * j] + m[j] * r * g; }
    }
}

constexpr int NPHASE = 12;
__global__ void __launch_bounds__(NTHR, 2) mega_fwd(Params P) {
    extern __shared__ __attribute__((aligned(16))) unsigned char lds[];
    volatile unsigned* MISC = (volatile unsigned*)(lds + LDS_BYTES - 64);
    if (threadIdx.x < 16) MISC[threadIdx.x] = 0u;
    __syncthreads();
    XcdBarrier bar; bar.bar = (unsigned*)(P.ws + WS_CTL) + 4096; bar.x = 0; bar.st = nullptr;
    const bool multi = (P.ph_hi - P.ph_lo) > 1;
    if (multi) bar = xcd_barrier_post((unsigned*)(P.ws + WS_CTL) + 4096, MISC);
    const int lo = P.ph_lo, hi = P.ph_hi;
#ifndef ONLY_PHASE
#define ONLY_PHASE (-1)
#endif
#define IN(k) (lo <= (k) && (k) < hi && (ONLY_PHASE < 0 || ONLY_PHASE == (k)))
#define SEAM(k) do { if (IN(k) && IN((k) + 1)) xcd_barrier(bar); } while (0)
    if (IN(0)) phase_prep(P, lds);
#if PROBE_REPEAT == 0
    xcd_barrier(bar); phase_prep(P, lds);
#endif
    SEAM(0);
    if (IN(1)) phase_inproj(P, lds);
    SEAM(1);
    if (IN(2)) phase_mix1<63>(P, lds);
#if PROBE_REPEAT == 2
    xcd_barrier(bar); phase_mix1<PROBE_SEL>(P, lds);
#endif
    SEAM(2);
    if (IN(3)) phase_scan(P);
#if PROBE_REPEAT == 3
    xcd_barrier(bar); phase_scan(P);
#endif
    SEAM(3);
    if (IN(4)) phase_mix2(P, lds);
#if PROBE_REPEAT == 4
    xcd_barrier(bar); phase_mix2(P, lds);
#endif
    SEAM(4);
    if (IN(5)) phase_branch(P, lds);
    SEAM(5);
    if (IN(6)) phase_gemm_f32((const bf16_t*)(P.ws + WS_MERGED), (const bf16_t*)(P.ws + WS_WOUT_T), 1024, (float*)(P.ws + WS_MIX), lds);
    SEAM(6);
    if (IN(7)) phase_mid_norm(P);
    SEAM(7);
    if (IN(8)) phase_ffn_up(P, lds);
    SEAM(8);
    if (IN(9)) phase_ffn_gate(P);
#if PROBE_REPEAT == 9
    xcd_barrier(bar); phase_ffn_gate(P);
#endif
    SEAM(9);
    if (IN(10)) phase_gemm_f32((const bf16_t*)(P.ws + WS_H), (const bf16_t*)(P.ws + WS_WD_T), 4096, (float*)(P.ws + WS_MIX), lds);
    SEAM(10);
    if (IN(11)) phase_final_norm(P);
#undef IN
#undef SEAM
}
}

extern "C" void kernel_launch(void* const* d_in, const int* in_sizes, int n_in, void* d_out, int out_size, void* d_ws, size_t ws_size, hipStream_t stream) {
    static int ready = 0;
    if (ready == 0) {
        if (n_in != 29 || (size_t)out_size != O_END || ws_size < WS_END) { fprintf(stderr, "kernel_launch: unexpected shapes (n_in %d out %d ws %zu)\n", n_in, out_size, ws_size); ready = -1; return; }
        if (hipFuncSetAttribute((const void*)mega_fwd, hipFuncAttributeMaxDynamicSharedMemorySize, LDS_BYTES) != hipSuccess) { fprintf(stderr, "kernel_launch: hipFuncSetAttribute failed\n"); ready = -1; return; }
        ready = 1;
    }
    if (ready < 0) return;
    (void)hipMemsetAsync((char*)d_ws + WS_CTL, 0, CTL_BYTES, stream);
    Params p{};
    for (int i = 0; i < 29; ++i) p.in[i] = (const float*)d_in[i];
    p.out = (float*)d_out; p.ws = (unsigned char*)d_ws;
#if MK_ONE_LAUNCH
    p.ph_lo = 0; p.ph_hi = NPHASE;
    hipLaunchKernelGGL(mega_fwd, dim3(256), dim3(NTHR), LDS_BYTES, stream, p);
#else
    for (int ph = 0; ph < NPHASE; ++ph) { p.ph_lo = ph; p.ph_hi = ph + 1; hipLaunchKernelGGL(mega_fwd, dim3(256), dim3(NTHR), LDS_BYTES, stream, p); }
#endif
}
```

```cpp
#include <hip/hip_runtime.h>
#include <cstdio>
#include <cstdint>

#ifndef PROBE_SEL
#define PROBE_SEL 63
#endif
#ifndef PROBE_REPEAT
#define PROBE_REPEAT (-1)
#endif
#ifndef MIX1_SEL
#define MIX1_SEL 63
#endif
#ifndef MK_ONE_LAUNCH
#define MK_ONE_LAUNCH 1
#endif

namespace {
typedef unsigned short bf16_t;
typedef short bf16x8 __attribute__((ext_vector_type(8)));
typedef float f32x4 __attribute__((ext_vector_type(4)));
typedef float f32x2 __attribute__((ext_vector_type(2)));
typedef unsigned u32x4 __attribute__((ext_vector_type(4)));
typedef unsigned u32x2 __attribute__((ext_vector_type(2)));

constexpr int NTHR = 512, NWAVES = 8;
constexpr int D = 1024, SEQ = 8192, NB = 2, MP = NB * SEQ, SBATCH = 32, STOK = 8, MS = SBATCH * STOK, MT = MP + MS;
constexpr int NIN = 10240, DFF = 4096;
constexpr int C_Q = 0, C_K = 1536, C_V = 3072, C_HQ = 4608, C_HF = 5120, C_HI = 5632, C_HG = 6144, C_MQ = 6656, C_GA = 7168, C_GH = 8192, C_GM = 9216;
constexpr float EPS = 1e-6f;

constexpr size_t O_YP = 0, O_YS = 16777216, O_PW1 = 17039360, O_PW2 = 17301504, O_PW3 = 18350080, O_PHG = 22544384, O_PCONV = 22675456, O_PMEM = 22691840,
                 O_SW1 = 23216128, O_SW2 = 27410432, O_SW3 = 44187648, O_SHG = 111296512, O_SCONV = 113393664, O_END = 113655808;

constexpr size_t MiB = 1u << 20;
constexpr size_t WS_CTL = 0, CTL_BYTES = 1 * MiB;
constexpr size_t WS_TAB = 1 * MiB;
constexpr size_t WS_WIN_T = 2 * MiB;
constexpr size_t WS_WMEM_T = 22 * MiB;
constexpr size_t WS_WBR_T = 24 * MiB;
constexpr size_t WS_WOUT_T = 27 * MiB;
constexpr size_t WS_WAB_T = 29 * MiB;
constexpr size_t WS_WD_T = 45 * MiB;
constexpr size_t WS_XN = 54 * MiB;
constexpr size_t WS_MEMN = 87 * MiB;
constexpr size_t WS_MEMKV = 88 * MiB;
constexpr size_t WS_PROJ = 90 * MiB;
constexpr size_t WS_ATTO = 416 * MiB;
constexpr size_t WS_LSE = 465 * MiB;
constexpr size_t WS_ABR = 466 * MiB;
constexpr size_t WS_HQT = 515 * MiB;
constexpr size_t WS_OINTRA = 531 * MiB;
constexpr size_t WS_U = 563 * MiB;
constexpr size_t WS_DC = 627 * MiB;
constexpr size_t WS_S0 = 628 * MiB;
constexpr size_t WS_MERGED = 692 * MiB;
constexpr size_t WS_MIX = 725 * MiB;
constexpr size_t WS_H = 790 * MiB;
constexpr size_t WS_AB = WS_PROJ;
constexpr size_t WS_END = 920 * MiB;

constexpr int LDS_BYTES = 155648;

struct Params { const float* in[29]; float* out; unsigned char* ws; int ph_lo, ph_hi; };

__device__ __forceinline__ unsigned f2bf(float f) { unsigned u = __float_as_uint(f); return (u + 0x7fffu + ((u >> 16) & 1u)) >> 16; }
__device__ __forceinline__ float bf2f(unsigned h) { return __uint_as_float(h << 16); }
__device__ __forceinline__ unsigned pk2(float lo, float hi) { return f2bf(lo) | (f2bf(hi) << 16); }
__device__ __forceinline__ float wave_sum(float v) {
#pragma unroll
    for (int o = 1; o < 64; o <<= 1) v += __shfl_xor(v, o);
    return v;
}
__device__ __forceinline__ float sigmoidf_(float x) { return 1.0f / (1.0f + __expf(-x)); }
#define LDS_WAIT() asm volatile("s_waitcnt lgkmcnt(0)" ::: "memory")

#define XB_TMO      128
#define XB_XCNT(j)  (256  + 64 * (j))
#define XB_XSUB(j)  (1280 + 64 * (j))
#define XB_XGEN(j)  (2304 + 64 * (j))
#define XB_TOP      3328
#define XB_TOPGEN   3392
#define XB_SPIN_CAP (1u << 22)
__device__ __forceinline__ unsigned xb_ld(unsigned* p)              { return __hip_atomic_load(p, __ATOMIC_RELAXED, __HIP_MEMORY_SCOPE_AGENT); }
__device__ __forceinline__ unsigned xb_add(unsigned* p, unsigned v) { return __hip_atomic_fetch_add(p, v, __ATOMIC_RELAXED, __HIP_MEMORY_SCOPE_AGENT); }
__device__ __forceinline__ unsigned xb_xcc_id() { return (unsigned)__builtin_amdgcn_s_getreg((3 << 11) | 20) & 0xFu; }
#define XB_SPIN(cond, bar) do { unsigned _sp = 0; while (cond) { __builtin_amdgcn_s_sleep(1); \
    if ((++_sp & 255u) == 0u) { if (xb_ld(&(bar)[XB_TMO])) break; if (_sp > XB_SPIN_CAP) { atomicAdd(&(bar)[XB_TMO], 1u); break; } } } } while (0)
struct XcdBarrier { unsigned* bar; unsigned x; volatile unsigned* st; };
__device__ __forceinline__ XcdBarrier xcd_barrier_post(unsigned* bar, volatile unsigned* st) {
    XcdBarrier b; b.bar = bar; b.x = xb_xcc_id(); b.st = st;
    if (threadIdx.x == 0) (void)xb_add(&bar[XB_XCNT(b.x)], 1u);
    return b;
}
__device__ __forceinline__ void xcd_barrier_complete(unsigned* bar, unsigned x, unsigned& nloc, unsigned& nx) {
    const unsigned G = gridDim.x;
    unsigned sum, cnt, mine, sp = 0u;
    for (;;) {
        sum = 0u; cnt = 0u; mine = 0u;
#pragma unroll
        for (unsigned j = 0; j < 16; ++j) { const unsigned c = xb_ld(&bar[XB_XCNT(j)]); sum += c; cnt += (c > 0u) ? 1u : 0u; mine = (j == x) ? c : mine; }
        if (sum == G) break;
        __builtin_amdgcn_s_sleep(1);
        if ((++sp & 255u) == 0u) { if (xb_ld(&bar[XB_TMO])) break; if (sp > XB_SPIN_CAP) { atomicAdd(&bar[XB_TMO], 1u); break; } }
    }
    nloc = mine > 0u ? mine : 1u; nx = cnt > 0u ? cnt : 1u;
}
__device__ __forceinline__ void xcd_barrier(const XcdBarrier& b) {
    asm volatile("s_waitcnt vmcnt(0)" ::: "memory");
    __syncthreads();
    if (threadIdx.x == 0) {
        unsigned* bar = b.bar;
        __builtin_amdgcn_s_waitcnt(0);
        unsigned nloc = b.st[0], nx = b.st[1];
        if (nloc == 0u) { xcd_barrier_complete(bar, b.x, nloc, nx); b.st[0] = nloc; b.st[1] = nx; }
        const unsigned old = xb_add(&bar[XB_XSUB(b.x)], 1u);
        const unsigned gen = old / nloc;
        if (old + 1u == (gen + 1u) * nloc) {
            __builtin_amdgcn_fence(__ATOMIC_RELEASE, "agent");
            asm volatile("s_waitcnt vmcnt(0)" ::: "memory");
            const unsigned og = xb_add(&bar[XB_TOP], 1u);
            const unsigned tg = og / nx;
            if (og + 1u == (tg + 1u) * nx) xb_add(&bar[XB_TOPGEN], 1u);
            else XB_SPIN(xb_ld(&bar[XB_TOPGEN]) == tg, bar);
            __builtin_amdgcn_fence(__ATOMIC_ACQUIRE, "agent");
            xb_add(&bar[XB_XGEN(b.x)], 1u);
            asm volatile("s_waitcnt vmcnt(0)" ::: "memory");
        } else {
            XB_SPIN(xb_ld(&bar[XB_XGEN(b.x)]) == gen, bar);
            __builtin_amdgcn_fence(__ATOMIC_ACQUIRE, "agent");
            asm volatile("s_waitcnt vmcnt(0)" ::: "memory");
        }
    }
    __syncthreads();
}

__device__ __forceinline__ int dest_row(int n, int kind, int row_off) { return kind == 0 ? row_off + n : ((n >> 7) * 256 + (n & 127) + (kind == 2 ? 128 : 0)); }
__device__ __forceinline__ void transpose_item(const float* __restrict__ W, int K, int N, bf16_t* __restrict__ WT, int kind, int row_off, float* scr, int item, int lane) {
    const int nblk = N / 32, kb = item / nblk, nb = item % nblk, k0 = 64 * kb, n0 = 32 * nb;
#pragma unroll 8
    for (int i = 0; i < 32; ++i) { const int kk = 2 * i + (lane >> 5); scr[kk * 33 + (lane & 31)] = W[(size_t)(k0 + kk) * N + n0 + (lane & 31)]; }
    LDS_WAIT();
    const int c = lane & 7;
#pragma unroll
    for (int j = 0; j < 4; ++j) { const int n = (lane >> 3) + 8 * j; const float* s = scr + (8 * c) * 33 + n;
        u32x4 o; o.x = pk2(s[0 * 33], s[1 * 33]); o.y = pk2(s[2 * 33], s[3 * 33]); o.z = pk2(s[4 * 33], s[5 * 33]); o.w = pk2(s[6 * 33], s[7 * 33]);
        *(u32x4*)(WT + (size_t)dest_row(n0 + n, kind, row_off) * K + k0 + 8 * c) = o; }
    LDS_WAIT();
}
__device__ __forceinline__ void rms_row_bf16(const float* __restrict__ xr, const float* __restrict__ gain, bf16_t* __restrict__ orow, int lane) {
    f32x4 v[4]; float s = 0.f;
#pragma unroll
    for (int j = 0; j < 4; ++j) { v[j] = ((const f32x4*)xr)[lane + 64 * j]; s += (v[j].x * v[j].x + v[j].y * v[j].y) + (v[j].z * v[j].z + v[j].w * v[j].w); }
    const float r = rsqrtf(wave_sum(s) * (1.0f / 1024.0f) + EPS);
#pragma unroll
    for (int j = 0; j < 4; ++j) { const f32x4 g = ((const f32x4*)gain)[lane + 64 * j];
        u32x2 o; o.x = pk2(v[j].x * r * g.x, v[j].y * r * g.y); o.y = pk2(v[j].z * r * g.z, v[j].w * r * g.w);
        ((u32x2*)orow)[lane + 64 * j] = o; }
}
__device__ __forceinline__ void phase_prep(const Params& P, unsigned char* lds) {
    const int tid = threadIdx.x, lane = tid & 63, wave = tid >> 6;
    const int gw = blockIdx.x * NWAVES + wave, NGW = gridDim.x * NWAVES;
    unsigned char* ws = P.ws;
    float* scr = (float*)lds + wave * (64 * 33);
    {
        constexpr int I_IN = 16 * 320, I_MEM = 16 * 32, I_BR = 8 * 32, I_OUT = 16 * 32, I_A = 16 * 128, I_D = 64 * 32;
        constexpr int NIT = I_IN + I_MEM + 3 * I_BR + I_OUT + 2 * I_A + I_D;
        for (int it = gw; it < NIT; it += NGW) {
            int r = it;
            if (r < I_IN) { transpose_item(P.in[13], 1024, NIN, (bf16_t*)(ws + WS_WIN_T), 0, 0, scr, r, lane); continue; } r -= I_IN;
            if (r < I_MEM) { transpose_item(P.in[17], 1024, 1024, (bf16_t*)(ws + WS_WMEM_T), 0, 0, scr, r, lane); continue; } r -= I_MEM;
            if (r < I_BR) { transpose_item(P.in[18], 512, 1024, (bf16_t*)(ws + WS_WBR_T), 0, 0, scr, r, lane); continue; } r -= I_BR;
            if (r < I_BR) { transpose_item(P.in[19], 512, 1024, (bf16_t*)(ws + WS_WBR_T), 0, 1024, scr, r, lane); continue; } r -= I_BR;
            if (r < I_BR) { transpose_item(P.in[20], 512, 1024, (bf16_t*)(ws + WS_WBR_T), 0, 2048, scr, r, lane); continue; } r -= I_BR;
            if (r < I_OUT) { transpose_item(P.in[21], 1024, 1024, (bf16_t*)(ws + WS_WOUT_T), 0, 0, scr, r, lane); continue; } r -= I_OUT;
            if (r < I_A) { transpose_item(P.in[24], 1024, DFF, (bf16_t*)(ws + WS_WAB_T), 1, 0, scr, r, lane); continue; } r -= I_A;
            if (r < I_A) { transpose_item(P.in[25], 1024, DFF, (bf16_t*)(ws + WS_WAB_T), 2, 0, scr, r, lane); continue; } r -= I_A;
            transpose_item(P.in[28], DFF, 1024, (bf16_t*)(ws + WS_WD_T), 0, 0, scr, r, lane);
        }
    }
    {
        bf16_t* XN = (bf16_t*)(ws + WS_XN); bf16_t* MEMN = (bf16_t*)(ws + WS_MEMN);
        for (int m = gw; m < MT + 512; m += NGW) {
            if (m < MP) rms_row_bf16(P.in[0] + (size_t)m * D, P.in[11], XN + (size_t)m * D, lane);
            else if (m < MT) rms_row_bf16(P.in[1] + (size_t)(m - MP) * D, P.in[11], XN + (size_t)m * D, lane);
            else rms_row_bf16(P.in[2] + (size_t)(m - MT) * D, P.in[16], MEMN + (size_t)(m - MT) * D, lane);
        }
    }
    {
        constexpr int R1 = 32 * 120, R2 = 32 * 504, R3 = 32 * 2040;
        for (int r = gw; r < R1 + R2 + R3; r += NGW) {
            int q = r, W; const float* src; float* dst;
            if (q < R1) { W = 128; src = P.in[3]; dst = P.out + O_SW1; }
            else if (q < R1 + R2) { q -= R1; W = 512; src = P.in[4]; dst = P.out + O_SW2; }
            else { q -= R1 + R2; W = 2048; src = P.in[5]; dst = P.out + O_SW3; }
            const int b = q / (W - 8), i = q % (W - 8);
            const f32x4* s4 = (const f32x4*)(src + ((size_t)b * W + i + 8) * 1024); f32x4* d4 = (f32x4*)(dst + ((size_t)b * W + i) * 1024);
            f32x4 t0 = s4[lane], t1 = s4[lane + 64], t2 = s4[lane + 128], t3 = s4[lane + 192];
            d4[lane] = t0; d4[lane + 64] = t1; d4[lane + 128] = t2; d4[lane + 192] = t3;
        }
    }
    if (blockIdx.x == 0) {
        float* BT = (float*)(ws + WS_TAB); float* LB = BT + 3 * 4 * 132;
        const float* rel_bias = P.in[9];
        for (int e = tid; e < 3 * 4 * 129; e += NTHR) {
            const int g = e / (4 * 129), h = (e / 129) % 4, j = e % 129;
            const int dil = g == 0 ? 1 : (g == 1 ? 4 : 16);
            const int dist = j * dil; int bucket;
            if (dist < 16) bucket = dist;
            else { const float d = (float)dist; int large = 16 + (int)(logf(d / 16.0f) / logf(128.0f) * 16.0f); bucket = large < 31 ? large : 31; }
            BT[(g * 4 + h) * 132 + j] = rel_bias[bucket * 12 + g * 4 + h];
        }
        for (int e = tid; e < 512; e += NTHR) { const float l0 = P.in[10][e], l1 = P.in[10][512 + e]; LB[e] = 1.0f / (1.0f + expf(l1 - l0)); }
    }
}

template <class Epi>
__device__ __forceinline__ void sgemm_unit(const bf16_t* __restrict__ A, int lda, const bf16_t* __restrict__ Bt, int ldb, int K, int row0, int col0, float* red, const Epi& epi) {
    const int tid = threadIdx.x, lane = tid & 63, wave = tid >> 6, kq = wave >> 1, ch = wave & 1, fr = lane & 15, fq = lane >> 4;
    f32x4 acc[4][2];
#pragma unroll
    for (int i = 0; i < 4; ++i)
#pragma unroll
        for (int j = 0; j < 2; ++j) acc[i][j] = (f32x4){0.f, 0.f, 0.f, 0.f};
    const int kbeg = kq * (K >> 2), kend = kbeg + (K >> 2);
    const bf16_t* ap = A + (size_t)(row0 + fr) * lda + fq * 8;
    const bf16_t* bp = Bt + (size_t)(col0 + ch * 32 + fr) * ldb + fq * 8;
#pragma unroll 4
    for (int k = kbeg; k < kend; k += 32) {
        bf16x8 a[4], b[2];
#pragma unroll
        for (int i = 0; i < 4; ++i) a[i] = *(const bf16x8*)(ap + (size_t)i * 16 * lda + k);
#pragma unroll
        for (int j = 0; j < 2; ++j) b[j] = *(const bf16x8*)(bp + (size_t)j * 16 * ldb + k);
#pragma unroll
        for (int i = 0; i < 4; ++i)
#pragma unroll
            for (int j = 0; j < 2; ++j) acc[i][j] = __builtin_amdgcn_mfma_f32_16x16x32_bf16(a[i], b[j], acc[i][j], 0, 0, 0);
    }
    __syncthreads();
#pragma unroll
    for (int i = 0; i < 4; ++i)
#pragma unroll
        for (int j = 0; j < 2; ++j)
#pragma unroll
            for (int r = 0; r < 4; ++r) red[(kq * 64 + i * 16 + 4 * fq + r) * 65 + ch * 32 + j * 16 + fr] = acc[i][j][r];
    __syncthreads();
    const int row = tid >> 3, c8 = (tid & 7) * 8;
    float v[8];
#pragma unroll
    for (int e = 0; e < 8; ++e) v[e] = (red[(0 * 64 + row) * 65 + c8 + e] + red[(1 * 64 + row) * 65 + c8 + e]) + (red[(2 * 64 + row) * 65 + c8 + e] + red[(3 * 64 + row) * 65 + c8 + e]);
    epi(row0 + row, col0 + c8, v);
}
__device__ __forceinline__ void store_bf16x8(bf16_t* p, const float* v) { u32x4 o; o.x = pk2(v[0], v[1]); o.y = pk2(v[2], v[3]); o.z = pk2(v[4], v[5]); o.w = pk2(v[6], v[7]); *(u32x4*)p = o; }
__device__ __forceinline__ void store_f32x8(float* p, const float* v) { ((f32x4*)p)[0] = (f32x4){v[0], v[1], v[2], v[3]}; ((f32x4*)p)[1] = (f32x4){v[4], v[5], v[6], v[7]}; }
__device__ __forceinline__ void load_bf16x8(const bf16_t* p, float* v) { const u32x4 w = *(const u32x4*)p;
    v[0] = bf2f(w.x & 0xffffu); v[1] = bf2f(w.x >> 16); v[2] = bf2f(w.y & 0xffffu); v[3] = bf2f(w.y >> 16); v[4] = bf2f(w.z & 0xffffu); v[5] = bf2f(w.z >> 16); v[6] = bf2f(w.w & 0xffffu); v[7] = bf2f(w.w >> 16); }

}
namespace pg8 {
#define PG8_LAS __attribute__((address_space(3)))
typedef unsigned short bf16_t;
typedef short bf16x8 __attribute__((ext_vector_type(8)));
typedef float f32x4 __attribute__((ext_vector_type(4)));
typedef unsigned u32x4 __attribute__((ext_vector_type(4)));
constexpr int BM = 256, BK = 64, HALF = 128, HTB = HALF * BK * 2  , STAGE_BYTES = 8 * HTB, NXCD = 8, WGM = 8;

__host__ __device__ __forceinline__ int lds_byte(int r, int c) { const int st = (r >> 4) * 2 + (c >> 5), rr = r & 15, cc = c & 31, ob = rr * 64 + cc * 2; return st * 1024 + (ob ^ (((ob >> 9) & 1) << 5)); }
__host__ __device__ __forceinline__ void stage_rc(int b, int& R, int& C) { const int st = b / 1024, sb = b % 1024, swz = sb ^ (((sb >> 9) & 1) << 5); R = (st >> 1) * 16 + swz / 64; C = (st & 1) * 32 + (swz % 64) / 2; }
__host__ __device__ __forceinline__ int perm32(int rho) { const int n = rho >> 4, i = rho & 15; return 8 * (i >> 2) + 4 * n + (i & 3); }

struct Unit { int pm, pn; };
struct Gemm { const bf16_t* A; const bf16_t* Bt; int M, N, K; };

struct StaticOrder {
    int nM, nN, nwg, G, c;
    __host__ __device__ void init(int M, int N, int G_, int c_) { nM = M / BM; nN = N / BM; nwg = nM * nN; G = G_; c = c_; }
    __host__ __device__ bool next(int i, Unit& u) const {
        const long L = (long)i * G + c; if (L >= nwg) return false;
        int wgid = (int)L; { const int q = nwg / NXCD, r = nwg % NXCD, xcd = wgid % NXCD, off = wgid / NXCD; wgid = (xcd < r ? xcd * (q + 1) : r * (q + 1) + (xcd - r) * q) + off; }
        const int nig = WGM * nN, gid = wgid / nig, fm = gid * WGM, gsz = (nM - fm) < WGM ? (nM - fm) : WGM;
        u.pm = fm + ((wgid % nig) % gsz); u.pn = (wgid % nig) / gsz; return true;
    }
    __device__ __forceinline__ void a_ready(const Unit&) const {}
    __device__ __forceinline__ void done(const Unit&) const {}
};
__device__ __forceinline__ unsigned cvt_pk_bf16(float lo, float hi) { unsigned r; asm volatile("v_cvt_pk_bf16_f32 %0, %1, %2" : "=v"(r) : "v"(lo), "v"(hi)); return r; }
typedef float f32x2 __attribute__((ext_vector_type(2)));

template <class F> struct Epi8 {
    static constexpr bool PERM = true, AFTER_DRAIN = false; F f;
    __device__ __forceinline__ bool keep(const Unit&) const { return false; }
    __device__ __forceinline__ void operator()(f32x4 (&acc)[2][2][4][2], const Unit& u, int wr, int wc, int fr, int fq) const {
        const int row0 = u.pm * BM + wr * 64 + fr, col0 = u.pn * BM + wc * 32 + 8 * fq;
#pragma unroll
        for (int ai = 0; ai < 2; ++ai)
#pragma unroll
            for (int m = 0; m < 4; ++m)
#pragma unroll
                for (int bj = 0; bj < 2; ++bj) { const f32x4 a = acc[ai][bj][m][0], b = acc[ai][bj][m][1]; float v[8] = {a[0], a[1], a[2], a[3], b[0], b[1], b[2], b[3]};
                    f(row0 + ai * HALF + m * 16, col0 + bj * HALF, v); }
    }
};
template <class F> struct Epi4 {
    static constexpr bool PERM = false, AFTER_DRAIN = false; F f;
    __device__ __forceinline__ bool keep(const Unit&) const { return false; }
    __device__ __forceinline__ void operator()(f32x4 (&acc)[2][2][4][2], const Unit& u, int wr, int wc, int fr, int fq) const {
        const int row0 = u.pm * BM + wr * 64 + fr, col0 = u.pn * BM + wc * 32 + 4 * fq;
#pragma unroll
        for (int ai = 0; ai < 2; ++ai)
#pragma unroll
            for (int m = 0; m < 4; ++m)
#pragma unroll
                for (int bj = 0; bj < 2; ++bj)
#pragma unroll
                    for (int n = 0; n < 2; ++n) f(row0 + ai * HALF + m * 16, col0 + bj * HALF + n * 16, acc[ai][bj][m][n]);
    }
};
template <class Epi, class Sched, bool ALIGN_EPI = false, bool SP2 = false>
__device__ __forceinline__ void gemm_phase(PG8_LAS unsigned char* lds, const Gemm g, const Sched& S, const Epi& E) {
    const int tid = threadIdx.x, wid = __builtin_amdgcn_readfirstlane(tid >> 6), lane = tid & 63, wr = wid >> 2, wc = wid & 3, fr = lane & 15, fq = lane >> 4;
    const int K = g.K, nt = K / BK;
    unsigned voffA[2], voffB[2];
#pragma unroll
    for (int i = 0; i < 2; ++i) { int R, C; stage_rc(tid * 16 + i * 8192, R, C); const int Rb = Epi::PERM ? ((R & ~31) + perm32(R & 31)) : R;
        voffA[i] = (unsigned)(R * K + C) * 2u; voffB[i] = (unsigned)(Rb * K + C) * 2u; }
    const size_t kstep = (size_t)(BK * 2);
    const size_t hstep = (size_t)HALF * K * 2;
    const size_t tstep = 2 * hstep;
    const unsigned ldsw = (unsigned)wid * 1024u;
    const int aoff = lds_byte(wr * 64 + fr, fq * 8), boff = lds_byte(wc * 32 + fr, fq * 8);
#define PG8_SA(b, h) (((b) * 2 + (h)) * HTB)
#define PG8_SB(b, h) ((4 + (b) * 2 + (h)) * HTB)
#define PG8_STAGE(bufoff, gbase, voff) do { _Pragma("unroll") for (int _i = 0; _i < 2; ++_i) \
        __builtin_amdgcn_global_load_lds((const unsigned*)((const char*)(gbase) + (voff)[_i]), (PG8_LAS unsigned*)(lds + (bufoff) + ldsw + _i * 8192), 16, 0, 0); } while (0)
#define PG8_LDA(dst, b, h) do { _Pragma("unroll") for (int m = 0; m < 4; ++m) _Pragma("unroll") for (int k = 0; k < 2; ++k) dst[m][k] = *(const PG8_LAS bf16x8*)(lds + PG8_SA(b, h) + aoff + m * 2048 + k * 1024); } while (0)
#define PG8_LDB(dst, b, h) do { _Pragma("unroll") for (int n = 0; n < 2; ++n) _Pragma("unroll") for (int k = 0; k < 2; ++k) dst[n][k] = *(const PG8_LAS bf16x8*)(lds + PG8_SB(b, h) + boff + n * 2048 + k * 1024); } while (0)
#define PG8_MMA(ai, bj, At, Bt) do { __builtin_amdgcn_s_setprio(1); _Pragma("unroll") for (int m = 0; m < 4; ++m) _Pragma("unroll") for (int n = 0; n < 2; ++n) _Pragma("unroll") for (int k = 0; k < 2; ++k) \
        acc[ai][bj][m][n] = __builtin_amdgcn_mfma_f32_16x16x32_bf16(Bt[n][k], At[m][k], acc[ai][bj][m][n], 0, 0, 0); __builtin_amdgcn_s_setprio(0); } while (0)
#define PG8_WAIT_V(n) asm volatile("s_waitcnt vmcnt(" #n ")" ::: "memory")
#define PG8_WAIT_L(n) asm volatile("s_waitcnt lgkmcnt(" #n ")" ::: "memory")
#define PG8_BAR __builtin_amdgcn_s_barrier()
#define PG8_SCHED __builtin_amdgcn_sched_barrier(0)
    Unit cur, nxt; int ui = 0;
    if (!S.next(0, cur)) return;
    f32x4 acc[2][2][4][2];
#pragma unroll
    for (int a = 0; a < 2; ++a)
#pragma unroll
        for (int b = 0; b < 2; ++b)
#pragma unroll
            for (int m = 0; m < 4; ++m)
#pragma unroll
                for (int n = 0; n < 2; ++n) acc[a][b][m][n] = (f32x4){0.f, 0.f, 0.f, 0.f};
    bf16x8 At[4][2], B0[2][2], B1[2][2];
    const char* cA = (const char*)g.A + (size_t)cur.pm * tstep; const char* cB = (const char*)g.Bt + (size_t)cur.pn * tstep;
    S.a_ready(cur);
    if constexpr (SP2) {
        PG8_STAGE(PG8_SB(0, 0), cB, voffB); PG8_STAGE(PG8_SB(0, 1), cB + hstep, voffB); PG8_STAGE(PG8_SA(0, 0), cA, voffA); PG8_STAGE(PG8_SA(0, 1), cA + hstep, voffA);
        if (wr == 1) PG8_BAR;
        PG8_WAIT_V(2); PG8_BAR;
        PG8_STAGE(PG8_SB(1, 0), cB + kstep, voffB); PG8_STAGE(PG8_SA(1, 0), cA + kstep, voffA); PG8_STAGE(PG8_SB(1, 1), cB + hstep + kstep, voffB);
        PG8_WAIT_V(6); PG8_BAR;
    } else {
        PG8_STAGE(PG8_SB(0, 0), cB, voffB); PG8_STAGE(PG8_SA(0, 0), cA, voffA); PG8_STAGE(PG8_SB(0, 1), cB + hstep, voffB); PG8_STAGE(PG8_SA(0, 1), cA + hstep, voffA);
        if (wr == 1) PG8_BAR;
        PG8_WAIT_V(4); PG8_BAR;
        PG8_STAGE(PG8_SB(1, 0), cB + kstep, voffB); PG8_STAGE(PG8_SA(1, 0), cA + kstep, voffA); PG8_STAGE(PG8_SB(1, 1), cB + hstep + kstep, voffB);
        PG8_WAIT_V(6); PG8_BAR;
    }
    for (;;) {
        const bool has_next = S.next(ui + 1, nxt);
        const char* nA = has_next ? (const char*)g.A + (size_t)nxt.pm * tstep : cA; const char* nB = has_next ? (const char*)g.Bt + (size_t)nxt.pn * tstep : cB;
        for (int t = 0; t < nt; t += 2) {
            const bool last = (t == nt - 2);
            const char* a1 = cA + (size_t)(t + 1) * kstep;
            const char* a2 = last ? nA : cA + (size_t)(t + 2) * kstep; const char* b2 = last ? nB : cB + (size_t)(t + 2) * kstep;
            const char* a3 = a2 + kstep; const char* b3 = b2 + kstep;
            if (last && has_next) S.a_ready(nxt);
            if constexpr (SP2) {
            PG8_LDB(B0, 0, 0); PG8_LDB(B1, 0, 1); PG8_SCHED; PG8_LDA(At, 0, 0); PG8_STAGE(PG8_SA(1, 1), a1 + hstep, voffA);
            PG8_WAIT_V(8); PG8_WAIT_L(0); PG8_BAR; PG8_MMA(0, 0, At, B0); PG8_MMA(0, 1, At, B1); PG8_BAR; PG8_SCHED;
            PG8_LDA(At, 0, 1); PG8_STAGE(PG8_SB(0, 0), b2, voffB); PG8_STAGE(PG8_SB(0, 1), b2 + hstep, voffB); PG8_STAGE(PG8_SA(0, 0), a2, voffA);
            PG8_WAIT_V(8); PG8_WAIT_L(0); PG8_BAR; PG8_MMA(1, 0, At, B0); PG8_MMA(1, 1, At, B1); PG8_BAR; PG8_SCHED;
            PG8_LDB(B0, 1, 0); PG8_LDB(B1, 1, 1); PG8_SCHED; PG8_LDA(At, 1, 0); PG8_STAGE(PG8_SA(0, 1), a2 + hstep, voffA);
            PG8_WAIT_V(8); PG8_WAIT_L(0); PG8_BAR; PG8_MMA(0, 0, At, B0); PG8_MMA(0, 1, At, B1); PG8_BAR; PG8_SCHED;
            PG8_LDA(At, 1, 1); PG8_STAGE(PG8_SB(1, 0), b3, voffB); PG8_STAGE(PG8_SB(1, 1), b3 + hstep, voffB); PG8_STAGE(PG8_SA(1, 0), a3, voffA);
            PG8_WAIT_V(8); PG8_WAIT_L(0); PG8_BAR; PG8_MMA(1, 0, At, B0); PG8_MMA(1, 1, At, B1); PG8_BAR; PG8_SCHED;
            } else {
            PG8_LDB(B0, 0, 0); PG8_SCHED; PG8_LDA(At, 0, 0); PG8_STAGE(PG8_SA(1, 1), a1 + hstep, voffA);
            PG8_WAIT_L(8); PG8_BAR; PG8_WAIT_L(0); PG8_MMA(0, 0, At, B0); PG8_BAR; PG8_SCHED;
            PG8_LDB(B1, 0, 1); PG8_STAGE(PG8_SB(0, 0), b2, voffB);
            PG8_BAR; PG8_WAIT_L(0); PG8_MMA(0, 1, At, B1); PG8_BAR;
            PG8_LDA(At, 0, 1); PG8_STAGE(PG8_SA(0, 0), a2, voffA);
            PG8_BAR; PG8_WAIT_L(0); PG8_MMA(1, 0, At, B0); PG8_BAR; PG8_SCHED;
            PG8_STAGE(PG8_SB(0, 1), b2 + hstep, voffB);
            PG8_WAIT_V(6); PG8_BAR; PG8_MMA(1, 1, At, B1); PG8_BAR;
            PG8_LDB(B0, 1, 0); PG8_SCHED; PG8_LDA(At, 1, 0); PG8_STAGE(PG8_SA(0, 1), a2 + hstep, voffA);
            PG8_WAIT_L(8); PG8_BAR; PG8_WAIT_L(0); PG8_MMA(0, 0, At, B0); PG8_BAR; PG8_SCHED;
            PG8_LDB(B1, 1, 1); PG8_STAGE(PG8_SB(1, 0), b3, voffB);
            PG8_BAR; PG8_WAIT_L(0); PG8_MMA(0, 1, At, B1); PG8_BAR;
            PG8_LDA(At, 1, 1); PG8_STAGE(PG8_SA(1, 0), a3, voffA);
            PG8_BAR; PG8_WAIT_L(0); PG8_MMA(1, 0, At, B0); PG8_BAR; PG8_SCHED;
            PG8_STAGE(PG8_SB(1, 1), b3 + hstep, voffB);
            PG8_WAIT_V(6); PG8_BAR; PG8_MMA(1, 1, At, B1); PG8_BAR;
            }
        }
        if constexpr (ALIGN_EPI) { if (wr == 0) PG8_BAR; }
        if constexpr (!Epi::AFTER_DRAIN) { E(acc, cur, wr, wc, fr, fq); S.done(cur); }
        if (!has_next) break;
        if (!E.keep(cur)) {
#pragma unroll
        for (int a = 0; a < 2; ++a)
#pragma unroll
            for (int b = 0; b < 2; ++b)
#pragma unroll
                for (int m = 0; m < 4; ++m)
#pragma unroll
                    for (int n = 0; n < 2; ++n) acc[a][b][m][n] = (f32x4){0.f, 0.f, 0.f, 0.f};
        }
        cur = nxt; cA = nA; cB = nB; ++ui;
        if constexpr (ALIGN_EPI) { if (wr == 1) PG8_BAR; }
    }
    PG8_WAIT_V(0);
    if constexpr (!ALIGN_EPI) { if (wr == 0) PG8_BAR; }
    PG8_BAR;
    if constexpr (Epi::AFTER_DRAIN) { E.fused(acc, cur, wr, wc, fr, fq, lds, wid, lane); S.done(cur); }
#undef PG8_SA
#undef PG8_SB
#undef PG8_STAGE
#undef PG8_LDA
#undef PG8_LDB
#undef PG8_MMA
#undef PG8_WAIT_V
#undef PG8_WAIT_L
#undef PG8_BAR
#undef PG8_SCHED
}
}

namespace {
struct InProjF {
    bf16_t* PROJ; const float* bias; float* out;
    __device__ __forceinline__ void operator()(int row, int col, float* v) const {
        const f32x4 b0 = *(const f32x4*)(bias + col), b1 = *(const f32x4*)(bias + col + 4);
        v[0] += b0[0]; v[1] += b0[1]; v[2] += b0[2]; v[3] += b0[3]; v[4] += b1[0]; v[5] += b1[1]; v[6] += b1[2]; v[7] += b1[3];
        store_bf16x8(PROJ + (size_t)row * NIN + col, v);
        if (col >= C_K && col < C_HQ) {
            const int kv = col - C_K, which = kv / 1536, rem = kv % 1536, g = rem >> 9, hd = rem & 511;
            const int W = g == 0 ? 128 : (g == 1 ? 512 : 2048);
            if (row < MP) { const int b = row >> 13, t = row & 8191;
                if (t >= SEQ - W) { float* pw = out + (g == 0 ? O_PW1 : (g == 1 ? O_PW2 : O_PW3)); store_f32x8(pw + (((size_t)b * W + (t - (SEQ - W))) * 2 + which) * 512 + hd, v); } }
            else { const int sb = (row - MP) >> 3, st = (row - MP) & 7; float* sw = out + (g == 0 ? O_SW1 : (g == 1 ? O_SW2 : O_SW3));
                store_f32x8(sw + (((size_t)sb * W + (W - 8 + st)) * 2 + which) * 512 + hd, v); }
        }
    }
};
__device__ __forceinline__ void phase_inproj(const Params& P, unsigned char* lds) {
    float* red = (float*)lds; unsigned char* ws = P.ws;
    const bf16_t* XN = (const bf16_t*)(ws + WS_XN); const bf16_t* WT = (const bf16_t*)(ws + WS_WIN_T);
    const InProjF f{(bf16_t*)(ws + WS_PROJ), P.in[14], P.out};
    {
        pg8::Gemm g{XN, WT, MP, NIN, D}; pg8::StaticOrder S; S.init(MP, NIN, (int)gridDim.x, (int)blockIdx.x);
        const pg8::Epi8<InProjF> E{f};
        pg8::gemm_phase<pg8::Epi8<InProjF>, pg8::StaticOrder, true, true>((PG8_LAS unsigned char*)lds, g, S, E);
    }
    constexpr int NU_S = 4 * (NIN / 64), NU_MEM = 8 * 16;
    for (int u = blockIdx.x; u < NU_S + NU_MEM; u += gridDim.x) {
        if (u < NU_S) { const int tr = 256 + (u & 3), tc = u >> 2; sgemm_unit(XN, D, WT, D, D, tr * 64, tc * 64, red, f); }
        else {
            const int q = u - NU_S, tr = q % 8, tc = q / 8;
            bf16_t* MEMKV = (bf16_t*)(ws + WS_MEMKV); float* out = P.out;
            sgemm_unit((const bf16_t*)(ws + WS_MEMN), D, (const bf16_t*)(ws + WS_WMEM_T), D, D, tr * 64, tc * 64, red, [&](int row, int col, float* v) {
                store_f32x8(out + O_PMEM + (size_t)row * 1024 + col, v); store_bf16x8(MEMKV + (size_t)row * 1024 + col, v); });
        }
    }
}

struct AttnUnit {
    const bf16_t* q; long q_rs; const bf16_t* k; long k_rs; const bf16_t* v; long v_rs; int k_valid_from;
    bf16_t* o; long o_rs; float* lse; long lse_rs; const float* bias;
};
struct AttnRegs { u32x4 kv[8], vv[8]; bf16x8 qa[4]; };
__device__ __forceinline__ void attn_load(const AttnUnit& U, AttnRegs& R) {
    const int tid = threadIdx.x, lane = tid & 63, wave = tid >> 6, fr = lane & 15, fq = lane >> 4;
#pragma unroll
    for (int it = 0; it < 8; ++it) { const int idx = tid + NTHR * it, j = idx >> 4, c = idx & 15;
        R.kv[it] = (u32x4){0u, 0u, 0u, 0u}; R.vv[it] = (u32x4){0u, 0u, 0u, 0u};
        if (j >= U.k_valid_from) { R.kv[it] = *(const u32x4*)(U.k + (long)j * U.k_rs + c * 8); R.vv[it] = *(const u32x4*)(U.v + (long)j * U.v_rs + c * 8); } }
    const bf16_t* qp = U.q + (long)(wave * 16 + fr) * U.q_rs + fq * 8;
#pragma unroll
    for (int kk = 0; kk < 4; ++kk) R.qa[kk] = *(const bf16x8*)(qp + kk * 32);
}
constexpr int ATT_KS = 136, ATT_VS = 144;
constexpr int ATT_VOFF = 256 * ATT_KS * 2, ATT_BOFF = ATT_VOFF + 256 * ATT_VS * 2;
typedef short v4i16_t __attribute__((ext_vector_type(4)));
__device__ __forceinline__ void attn_stage(const AttnRegs& R, const float* bias, unsigned char* lds) {
    bf16_t* Ks = (bf16_t*)lds; bf16_t* Vs = (bf16_t*)(lds + ATT_VOFF); float* btab = (float*)(lds + ATT_BOFF);
    const int tid = threadIdx.x;
#pragma unroll
    for (int it = 0; it < 8; ++it) { const int idx = tid + NTHR * it, j = idx >> 4, c = idx & 15;
        *(u32x4*)(Ks + j * ATT_KS + c * 8) = R.kv[it]; *(u32x4*)(Vs + j * ATT_VS + c * 8) = R.vv[it]; }
    if (bias && tid < 129) btab[tid] = bias[tid];
}
template <class Mid> __device__ __forceinline__ void attn_compute(const AttnUnit& U, const bf16x8 (&qa)[4], unsigned char* lds, const Mid& mid) {
    const bf16_t* Ks = (const bf16_t*)lds; const float* btab = (const float*)(lds + ATT_BOFF);
    const int tid = threadIdx.x, lane = tid & 63, wave = tid >> 6, fr = lane & 15, fq = lane >> 4;
    f32x4 s[16];
#pragma unroll
    for (int kb = 0; kb < 16; ++kb) { s[kb] = (f32x4){0.f, 0.f, 0.f, 0.f};
#pragma unroll
        for (int kk = 0; kk < 4; ++kk) { const bf16x8 kf = *(const bf16x8*)(Ks + (kb * 16 + fr) * ATT_KS + kk * 32 + fq * 8); s[kb] = __builtin_amdgcn_mfma_f32_16x16x32_bf16(kf, qa[kk], s[kb], 0, 0, 0); } }
    const float scale = 0.08838834764831845f;
    const bool banded = U.bias != nullptr; const int vfrom = U.k_valid_from; int qi = wave * 16 + fr;
    asm volatile("" : "+v"(qi));
    float mx = -3.0e38f;
#pragma unroll
    for (int kb = 0; kb < 16; ++kb)
#pragma unroll
        for (int r = 0; r < 4; ++r) { float x = s[kb][r] * scale;
            if (banded) { const int kj = kb * 16 + 4 * fq + r, lag = 128 + qi - kj; const bool ok = lag >= 0 && lag <= 128 && kj >= vfrom; x = ok ? x + btab[ok ? lag : 0] : -1.0e30f; }
            s[kb][r] = x; mx = fmaxf(mx, x); }
    mx = fmaxf(mx, __shfl_xor(mx, 16)); mx = fmaxf(mx, __shfl_xor(mx, 32));
    float sum = 0.f;
#pragma unroll
    for (int kb = 0; kb < 16; ++kb)
#pragma unroll
        for (int r = 0; r < 4; ++r) { const float p = __expf(s[kb][r] - mx); s[kb][r] = p; sum += p; }
    sum += __shfl_xor(sum, 16); sum += __shfl_xor(sum, 32);
    mid();
    f32x4 o[8];
#pragma unroll
    for (int db = 0; db < 8; ++db) o[db] = (f32x4){0.f, 0.f, 0.f, 0.f};
    typedef __attribute__((address_space(3))) v4i16_t* lds_v4;
    unsigned vaddr0 = (unsigned)(uintptr_t)(lds + ATT_VOFF) + (unsigned)((4 * fq + ((lane >> 2) & 3)) * (ATT_VS * 2) + (lane & 3) * 8);
    unsigned vaddr1 = vaddr0 + 4 * 32 * (ATT_VS * 2);
    asm volatile("" : "+v"(vaddr0), "+v"(vaddr1));
#pragma unroll
    for (int ks = 0; ks < 8; ++ks) {
        const unsigned vaddr = (ks < 4 ? vaddr0 : vaddr1) - (unsigned)((ks < 4 ? 0 : 4) * 32 * (ATT_VS * 2));
        u32x4 pw; pw.x = pk2(s[2 * ks][0], s[2 * ks][1]); pw.y = pk2(s[2 * ks][2], s[2 * ks][3]); pw.z = pk2(s[2 * ks + 1][0], s[2 * ks + 1][1]); pw.w = pk2(s[2 * ks + 1][2], s[2 * ks + 1][3]);
        const bf16x8 pf = __builtin_bit_cast(bf16x8, pw);
#pragma unroll
        for (int db = 0; db < 8; ++db) {
            const v4i16_t lo = __builtin_amdgcn_ds_read_tr16_b64_v4i16((lds_v4)(uintptr_t)(vaddr + ks * 32 * (ATT_VS * 2) + db * 32));
            const v4i16_t hi = __builtin_amdgcn_ds_read_tr16_b64_v4i16((lds_v4)(uintptr_t)(vaddr + (ks * 32 + 16) * (ATT_VS * 2) + db * 32));
            const bf16x8 vf = (bf16x8){lo[0], lo[1], lo[2], lo[3], hi[0], hi[1], hi[2], hi[3]};
            o[db] = __builtin_amdgcn_mfma_f32_16x16x32_bf16(pf, vf, o[db], 0, 0, 0); } }
#pragma unroll
    for (int r = 0; r < 4; ++r) { const float inv = 1.0f / __shfl(sum, 4 * fq + r); bf16_t* op = U.o + (long)(wave * 16 + 4 * fq + r) * U.o_rs + fr;
#pragma unroll
        for (int db = 0; db < 8; ++db) op[db * 16] = (bf16_t)f2bf(o[db][r] * inv); }
    if (U.lse && lane < 16) U.lse[(long)qi * U.lse_rs] = mx + __logf(sum);
}
__device__ __forceinline__ void attn_make_unit(const Params& P, int r, AttnUnit& U) {
    unsigned char* ws = P.ws; bf16_t* PROJ = (bf16_t*)(ws + WS_PROJ); const float* BT = (const float*)(ws + WS_TAB);
    constexpr int N_DIL = 3 * 2 * 4 * 64;
    if (r < N_DIL) {
        const int g = r / 512, b = (r >> 8) & 1, h = (r >> 6) & 3, rb = r & 63;
        const int dil = g == 0 ? 1 : (g == 1 ? 4 : 16); const int nbper = 64 / dil; const int res = rb / nbper, n = rb % nbper;
        const long base = (long)b * SEQ + (long)n * 128 * dil + res; const long kbase = base - (long)128 * dil;
        U.q = PROJ + base * NIN + C_Q + g * 512 + h * 128; U.q_rs = (long)dil * NIN;
        U.k = PROJ + kbase * NIN + C_K + g * 512 + h * 128; U.k_rs = (long)dil * NIN; U.v = PROJ + kbase * NIN + C_V + g * 512 + h * 128; U.v_rs = (long)dil * NIN;
        U.k_valid_from = n == 0 ? 128 : 0;
        U.o = (bf16_t*)(ws + WS_ATTO) + ((long)g * MT + base) * 512 + h * 128; U.o_rs = (long)dil * 512;
        U.lse = (float*)(ws + WS_LSE) + ((long)g * MT + base) * 4 + h; U.lse_rs = (long)dil * 4; U.bias = BT + (g * 4 + h) * 132;
    } else {
        const int q = r - N_DIL; const int b = q >> 8, h = (q >> 6) & 3, n = q & 63; const long base = (long)b * SEQ + (long)n * 128;
        const bf16_t* MEMKV = (const bf16_t*)(ws + WS_MEMKV);
        U.q = PROJ + base * NIN + C_MQ + h * 128; U.q_rs = NIN; U.k = MEMKV + (long)b * 256 * 1024 + h * 128; U.k_rs = 1024; U.v = U.k + 512; U.v_rs = 1024; U.k_valid_from = 0;
        U.o = (bf16_t*)(ws + WS_ABR) + ((long)2 * MT + base) * 512 + h * 128; U.o_rs = 512; U.lse = nullptr; U.lse_rs = 0; U.bias = nullptr;
    }
}
__device__ __forceinline__ void attn_units(const Params& P, unsigned char* lds) {
    constexpr int NU = 3 * 2 * 4 * 64 + 2 * 4 * 64;
    int it = blockIdx.x; if (it >= NU) return;
    AttnUnit U; AttnRegs R; attn_make_unit(P, it, U); attn_load(U, R);
    for (;;) {
        __syncthreads();
        attn_stage(R, U.bias, lds);
        bf16x8 qa[4];
#pragma unroll
        for (int kk = 0; kk < 4; ++kk) qa[kk] = R.qa[kk];
        __syncthreads();
        const int nx = it + gridDim.x;
        attn_compute(U, qa, lds, [&]() { if (nx < NU) { AttnUnit UN; attn_make_unit(P, nx, UN); attn_load(UN, R); } });
        if (nx >= NU) break;
        attn_make_unit(P, nx, U); it = nx;
    }
}

template <class KeyPtr>
__device__ __forceinline__ void sample_attn_item(const bf16_t* qrow0  , int nk, const float* biastab  , KeyPtr kptr,
                                                 bf16_t* orow0, long o_rs, float* lse0, long lse_rs, unsigned char* lds) {
    float* qs = (float*)lds;
    float* ps = qs + 1024;
    float* st = ps + 8 * 272;
    const int tid = threadIdx.x, lane = tid & 63, wave = tid >> 6, sub = lane >> 4, l16 = lane & 15;
    __syncthreads();
    for (int idx = tid; idx < 1024; idx += NTHR) { const int t = idx >> 7, d = idx & 127; qs[idx] = bf2f(qrow0[(long)t * NIN + d]) * 0.08838834764831845f; }
    __syncthreads();
    const int npair = 8 * nk;
    for (int p0 = wave * 4 + sub; p0 < npair; p0 += 32 * 4) {
        f32x4 ka[4], kb[4]; int tt[4], jj[4];
#pragma unroll
        for (int u = 0; u < 4; ++u) { int p = p0 + 32 * u; if (p >= npair) p = npair - 1; const int t = p / nk, j = p - t * nk; tt[u] = t; jj[u] = j;
            const f32x4* kp = (const f32x4*)kptr(t, j) + l16 * 2; ka[u] = kp[0]; kb[u] = kp[1]; }
#pragma unroll
        for (int u = 0; u < 4; ++u) { const f32x4* qp = (const f32x4*)(qs + tt[u] * 128) + l16 * 2; const f32x4 qa = qp[0], qb = qp[1];
            float acc = (ka[u].x * qa.x + ka[u].y * qa.y) + (ka[u].z * qa.z + ka[u].w * qa.w) + (kb[u].x * qb.x + kb[u].y * qb.y) + (kb[u].z * qb.z + kb[u].w * qb.w);
            acc += __shfl_xor(acc, 1); acc += __shfl_xor(acc, 2); acc += __shfl_xor(acc, 4); acc += __shfl_xor(acc, 8);
            if (l16 == 0 && p0 + 32 * u < npair) ps[tt[u] * 272 + jj[u]] = acc + (biastab ? biastab[jj[u]] : 0.f); }
    }
    __syncthreads();
    { const int t = wave; float m = -3.0e38f;
      for (int j = lane; j < nk; j += 64) m = fmaxf(m, ps[t * 272 + j]);
#pragma unroll
      for (int o = 1; o < 64; o <<= 1) m = fmaxf(m, __shfl_xor(m, o));
      float s = 0.f;
      for (int j = lane; j < nk; j += 64) { const float p = __expf(ps[t * 272 + j] - m); ps[t * 272 + j] = p; s += p; }
      s = wave_sum(s);
      if (lane == 0) { st[t] = 1.0f / s; if (lse0) lse0[(long)t * lse_rs] = m + __logf(s); }
      if (lane < 16) ps[t * 272 + nk + lane] = 0.f;
    }
    __syncthreads();
    { const int t = wave; f32x2 acc = (f32x2){0.f, 0.f};
      for (int j0 = 0; j0 < nk; j0 += 16) {
          f32x2 vv[16];
#pragma unroll
          for (int u = 0; u < 16; ++u) { int j = j0 + u; if (j >= nk) j = nk - 1; vv[u] = ((const f32x2*)(kptr(t, j) + 512))[lane]; }
#pragma unroll
          for (int u = 0; u < 16; ++u) { const float p = ps[t * 272 + j0 + u]; acc.x += p * vv[u].x; acc.y += p * vv[u].y; } }
      const float inv = st[t];
      *(unsigned*)(orow0 + (long)t * o_rs + 2 * lane) = pk2(acc.x * inv, acc.y * inv); }
}

__device__ __forceinline__ void sample_hgrn_item(const Params& P, int sb, int h, unsigned char* lds) {
    float* fs = (float*)lds;
    float* ks = fs + 1024;
    float* qs = ks + 1024;
    float* is_ = qs + 1024;
    float* part = is_ + 1024;
    float* osq = part + 512;
    const int tid = threadIdx.x, lane = tid & 63, wave = tid >> 6;
    const bf16_t* PROJ = (const bf16_t*)(P.ws + WS_PROJ); const float* LB = (const float*)(P.ws + WS_TAB) + 3 * 4 * 132;
    __syncthreads();
    for (int idx = tid; idx < 1024; idx += NTHR) { const int t = idx >> 7, k = idx & 127; const bf16_t* pr = PROJ + (size_t)(MP + sb * 8 + t) * NIN + h * 128 + k;
        const float lb = LB[h * 128 + k]; const float f = lb + (1.0f - lb) * sigmoidf_(bf2f(pr[C_HF]));
        fs[idx] = f; ks[idx] = 1.0f - f; qs[idx] = bf2f(pr[C_HQ]); is_[idx] = bf2f(pr[C_HI]); }
    const int v = tid & 127, kq = tid >> 7;
    const float* s_in = P.in[7] + ((size_t)(sb * 4 + h) * 128) * 128; float* s_out = P.out + O_SHG + ((size_t)(sb * 4 + h) * 128) * 128;
    float S[32];
#pragma unroll
    for (int i = 0; i < 32; ++i) S[i] = s_in[(size_t)(kq * 32 + i) * 128 + v];
    __syncthreads();
    const float gain = P.in[15][v];
    for (int t = 0; t < 8; ++t) {
        const float iv = is_[t * 128 + v]; float po = 0.f;
#pragma unroll
        for (int i = 0; i < 32; ++i) { const int k = kq * 32 + i; S[i] = fs[t * 128 + k] * S[i] + ks[t * 128 + k] * iv; po += S[i] * qs[t * 128 + k]; }
        part[kq * 128 + v] = po;
        __syncthreads();
        if (tid < 128) { const float o = (part[v] + part[128 + v]) + (part[256 + v] + part[384 + v]);
            const float ss = wave_sum(o * o); if (lane == 0) osq[wave] = ss;
            part[v] = o; }
        __syncthreads();
        if (tid < 128) { const float o = part[v]; const float r = rsqrtf((osq[0] + osq[1]) * (1.0f / 128.0f) + EPS);
            const size_t row = (size_t)(MP + sb * 8 + t); const float gate = sigmoidf_(bf2f(PROJ[row * NIN + C_HG + h * 128 + v]));
            ((bf16_t*)(P.ws + WS_ABR))[((size_t)1 * MT + row) * 512 + h * 128 + v] = (bf16_t)f2bf(o * r * gain * gate); }
        __syncthreads();
    }
#pragma unroll
    for (int i = 0; i < 32; ++i) s_out[(size_t)(kq * 32 + i) * 128 + v] = S[i];
}

constexpr int HL_QS = 136, HL_VS = 144;
constexpr int HL_KI = 64 * HL_QS * 2, HL_KT = HL_KI + 160 * HL_QS * 2, HL_VV = HL_KT + 64 * HL_VS * 2, HL_TT = HL_VV + 64 * HL_VS * 2;
typedef __attribute__((address_space(3))) v4i16_t* lds_v4p;
__device__ __forceinline__ bf16x8 tr_pair(unsigned a_lo, unsigned a_hi) {
    const v4i16_t lo = __builtin_amdgcn_ds_read_tr16_b64_v4i16((lds_v4p)(uintptr_t)a_lo), hi = __builtin_amdgcn_ds_read_tr16_b64_v4i16((lds_v4p)(uintptr_t)a_hi);
    return (bf16x8){lo[0], lo[1], lo[2], lo[3], hi[0], hi[1], hi[2], hi[3]};
}
__device__ __forceinline__ void hgrn_local_unit(const Params& P, int bh, int c, unsigned char* lds) {
    bf16_t* QI = (bf16_t*)lds; bf16_t* KI = (bf16_t*)(lds + HL_KI); bf16_t* KT = (bf16_t*)(lds + HL_KT); bf16_t* VV = (bf16_t*)(lds + HL_VV); float* TT = (float*)(lds + HL_TT);
    const int tid = threadIdx.x, lane = tid & 63, wave = tid >> 6, fr = lane & 15, fq = lane >> 4;
    const int b = bh >> 2, h = bh & 3; const size_t row0 = (size_t)b * SEQ + (size_t)c * 64;
    const bf16_t* PROJ = (const bf16_t*)(P.ws + WS_PROJ); const float* LB = (const float*)(P.ws + WS_TAB) + 3 * 4 * 132;
    __syncthreads();
    {
#pragma unroll
        for (int it = 0; it < 2; ++it) { const int idx = tid + NTHR * it, sr = idx >> 4, ch = idx & 15;
            *(u32x4*)(VV + sr * HL_VS + ch * 8) = *(const u32x4*)(PROJ + (row0 + sr) * NIN + C_HI + h * 128 + ch * 8); }
    }
    const int k = tid & 127, I = tid >> 7;
    float Gl[16], qv[16], kk[16];
    {
        const bf16_t* pr = PROJ + (row0 + 16 * I) * NIN + h * 128 + k; const float lb = LB[h * 128 + k]; float run = 0.f;
#pragma unroll
        for (int j = 0; j < 16; ++j) { const float x = bf2f(pr[(size_t)j * NIN + C_HF]); const float f = lb + (1.0f - lb) * sigmoidf_(x); run += __logf(f); Gl[j] = run; kk[j] = 1.0f - f; qv[j] = bf2f(pr[(size_t)j * NIN + C_HQ]); }
        TT[I * 128 + k] = run;
    }
    __syncthreads();
    {
        const float T0 = TT[k], T1 = TT[128 + k], T2 = TT[256 + k], T3 = TT[384 + k];
        const float rI = I == 0 ? 0.f : (I == 1 ? T0 : (I == 2 ? T0 + T1 : T0 + T1 + T2));
        const float TI = I == 0 ? T0 : (I == 1 ? T1 : (I == 2 ? T2 : T3));
        const float gend = (T0 + T1) + (T2 + T3);
        const float eR = __expf(rI);
        const float Tn1 = I == 0 ? T1 : (I == 1 ? T2 : T3), Tn2 = I == 0 ? T2 : T3;
        const float f2 = __expf(Tn1), f3 = __expf(Tn1 + Tn2);
        const float fT = __expf(gend - (rI + TI));
        const int ibase0 = 0, ibase1 = 16, ibase2 = 48, ibase3 = 96;
        const int dbase = I == 0 ? ibase0 : (I == 1 ? ibase1 : (I == 2 ? ibase2 : ibase3));
        bf16_t* HQT = (bf16_t*)(P.ws + WS_HQT) + (row0 + 16 * I) * 512 + h * 128 + k;
#pragma unroll
        for (int j = 0; j < 16; ++j) {
            const int t = 16 * I + j;
            const float qi = qv[j] * __expf(Gl[j]);
            QI[t * HL_QS + k] = (bf16_t)f2bf(qi); HQT[(size_t)j * 512] = (bf16_t)f2bf(qi * eR);
            KI[(dbase + t) * HL_QS + k] = (bf16_t)f2bf(kk[j] * __expf(-Gl[j]));
            const float kh = kk[j] * __expf(TI - Gl[j]);
            if (I == 0) { KI[(ibase1 + t) * HL_QS + k] = (bf16_t)f2bf(kh); KI[(ibase2 + t) * HL_QS + k] = (bf16_t)f2bf(kh * f2); KI[(ibase3 + t) * HL_QS + k] = (bf16_t)f2bf(kh * f3); }
            else if (I == 1) { KI[(ibase2 + t) * HL_QS + k] = (bf16_t)f2bf(kh); KI[(ibase3 + t) * HL_QS + k] = (bf16_t)f2bf(kh * f2); }
            else if (I == 2) { KI[(ibase3 + t) * HL_QS + k] = (bf16_t)f2bf(kh); }
            KT[t * HL_VS + k] = (bf16_t)f2bf(kh * fT);
        }
        if (I == 3) ((float*)(P.ws + WS_DC))[((size_t)bh * 128 + c) * 128 + k] = __expf(gend);
    }
    __syncthreads();
    const unsigned lbase = (unsigned)(uintptr_t)lds;
    const unsigned trow = (unsigned)(4 * fq + ((lane >> 2) & 3)), tcol = (unsigned)((lane & 3) * 8);
    {
        const int I2 = wave >> 1, vh = wave & 1;
        const int ib = I2 == 0 ? 0 : (I2 == 1 ? 16 : (I2 == 2 ? 48 : 96));
        f32x4 sT[4];
#pragma unroll
        for (int J = 0; J < 4; ++J) { sT[J] = (f32x4){0.f, 0.f, 0.f, 0.f};
            if (J <= I2) {
#pragma unroll
                for (int q4 = 0; q4 < 4; ++q4) { const bf16x8 a = *(const bf16x8*)(KI + (ib + 16 * J + fr) * HL_QS + q4 * 32 + fq * 8); const bf16x8 bb = *(const bf16x8*)(QI + (16 * I2 + fr) * HL_QS + q4 * 32 + fq * 8);
                    sT[J] = __builtin_amdgcn_mfma_f32_16x16x32_bf16(a, bb, sT[J], 0, 0, 0); }
                if (J == I2) {
#pragma unroll
                    for (int r = 0; r < 4; ++r) if (4 * fq + r > fr) sT[J][r] = 0.f; }
            } }
        u32x4 p0, p1; p0.x = pk2(sT[0][0], sT[0][1]); p0.y = pk2(sT[0][2], sT[0][3]); p0.z = pk2(sT[1][0], sT[1][1]); p0.w = pk2(sT[1][2], sT[1][3]);
        p1.x = pk2(sT[2][0], sT[2][1]); p1.y = pk2(sT[2][2], sT[2][3]); p1.z = pk2(sT[3][0], sT[3][1]); p1.w = pk2(sT[3][2], sT[3][3]);
        const bf16x8 pa0 = __builtin_bit_cast(bf16x8, p0), pa1 = __builtin_bit_cast(bf16x8, p1);
        float* OI = (float*)(P.ws + WS_OINTRA) + (row0 + 16 * I2 + 4 * fq) * 512 + h * 128 + fr;
#pragma unroll
        for (int vb = 0; vb < 4; ++vb) { const int vblk = vh * 4 + vb;
            const unsigned va = lbase + HL_VV + trow * (HL_VS * 2) + tcol + vblk * 32;
            f32x4 o = (f32x4){0.f, 0.f, 0.f, 0.f};
            o = __builtin_amdgcn_mfma_f32_16x16x32_bf16(pa0, tr_pair(va, va + 16 * (HL_VS * 2)), o, 0, 0, 0);
            if (I2 >= 2) o = __builtin_amdgcn_mfma_f32_16x16x32_bf16(pa1, tr_pair(va + 32 * (HL_VS * 2), va + 48 * (HL_VS * 2)), o, 0, 0, 0);
#pragma unroll
            for (int r = 0; r < 4; ++r) OI[(size_t)r * 512 + vblk * 16] = o[r]; }
    }
    {
        float* Up = (float*)(P.ws + WS_U) + ((size_t)bh * 128 + c) * 16384 + (16 * wave + 4 * fq) * 128 + fr;
        const unsigned ka = lbase + HL_KT + trow * (HL_VS * 2) + tcol + wave * 32;
        const bf16x8 a0 = tr_pair(ka, ka + 16 * (HL_VS * 2)), a1 = tr_pair(ka + 32 * (HL_VS * 2), ka + 48 * (HL_VS * 2));
#pragma unroll
        for (int vblk = 0; vblk < 8; ++vblk) { const unsigned va = lbase + HL_VV + trow * (HL_VS * 2) + tcol + vblk * 32;
            f32x4 u = (f32x4){0.f, 0.f, 0.f, 0.f};
            u = __builtin_amdgcn_mfma_f32_16x16x32_bf16(a0, tr_pair(va, va + 16 * (HL_VS * 2)), u, 0, 0, 0);
            u = __builtin_amdgcn_mfma_f32_16x16x32_bf16(a1, tr_pair(va + 32 * (HL_VS * 2), va + 48 * (HL_VS * 2)), u, 0, 0, 0);
#pragma unroll
            for (int r = 0; r < 4; ++r) Up[(size_t)r * 128 + vblk * 16] = u[r]; }
    }
}

template <int SEL> __device__ __forceinline__ void phase_mix1(const Params& P, unsigned char* lds) {
    unsigned char* ws = P.ws; bf16_t* PROJ = (bf16_t*)(ws + WS_PROJ);
    const float* BT = (const float*)(ws + WS_TAB);
    constexpr int N_DIL = 3 * 2 * 4 * 64, N_MEM = 2 * 4 * 64, N_HL = 8 * 128, N_SA = 32 * 3 * 4, N_SM = 32 * 4, N_SH = 32 * 4;
    constexpr int NTOT = N_HL + N_SA + N_SM + N_SH;
    if (SEL & 1) attn_units(P, lds);
    for (int it = blockIdx.x; it < NTOT; it += gridDim.x) {
        int r = it;
        if (r < N_HL) { if (SEL & 4) hgrn_local_unit(P, r >> 7, r & 127, lds); continue; }
        r -= N_HL;
        if (r < N_SA + N_SM) {
            int sb, g, h;
            if (r < N_SA) { sb = r / 12; g = (r / 4) % 3; h = r & 3; } else { const int q = r - N_SA; sb = q >> 2; g = 3; h = q & 3; }
            const int W = g == 0 ? 128 : (g == 1 ? 512 : (g == 2 ? 2048 : 256)), dil = g == 0 ? 1 : (g == 1 ? 4 : (g == 2 ? 16 : -1));
            const float* cache = (g == 0 ? P.in[3] : (g == 1 ? P.in[4] : (g == 2 ? P.in[5] : P.in[6]))) + (size_t)sb * W * 1024 + h * 128;
            const float* neu = P.out + (g == 0 ? O_SW1 : (g == 1 ? O_SW2 : O_SW3)) + ((size_t)sb * W + (W - 8)) * 1024 + h * 128;
            const long row0 = MP + sb * 8;
            const int tq = g < 3 ? 1 : 0, base_idx = g < 3 ? W : 0;
            auto kp = [&](int t, int j) { const int idx = base_idx + tq * t - dil * j; return idx < W ? cache + (size_t)idx * 1024 : neu + (size_t)(idx - W) * 1024; };
            bf16_t* op = g < 3 ? (bf16_t*)(ws + WS_ATTO) + ((long)g * MT + row0) * 512 + h * 128 : (bf16_t*)(ws + WS_ABR) + ((long)2 * MT + row0) * 512 + h * 128;
            if (SEL & 8) sample_attn_item(PROJ + row0 * NIN + (g < 3 ? C_Q + g * 512 : C_MQ) + h * 128, g < 3 ? 129 : 256, g < 3 ? BT + (g * 4 + h) * 132 : nullptr,
                kp, op, 512, g < 3 ? (float*)(ws + WS_LSE) + ((long)g * MT + row0) * 4 + h : nullptr, 4, lds);
            continue; }
        r -= N_SA;
        r -= N_SM;
        if (SEL & 32) sample_hgrn_item(P, r >> 2, r & 3, lds);
    }
}

__device__ __forceinline__ void phase_scan(const Params& P) {
    const float* __restrict__ U = (const float*)(P.ws + WS_U); const float* __restrict__ DC = (const float*)(P.ws + WS_DC); bf16_t* __restrict__ S0 = (bf16_t*)(P.ws + WS_S0);
    for (int e = blockIdx.x * NTHR + threadIdx.x; e < 8 * 16384; e += gridDim.x * NTHR) {
        const int bh = e >> 14, kv = e & 16383, k = kv >> 7; float S = 0.f;
        const float* up = U + (size_t)bh * 128 * 16384 + kv; const float* dp = DC + (size_t)bh * 128 * 128 + k; bf16_t* sp = S0 + (size_t)bh * 128 * 16384 + kv;
        for (int c0 = 0; c0 < 128; c0 += 16) {
            float u[16], d[16];
#pragma unroll
            for (int i = 0; i < 16; ++i) { u[i] = up[(size_t)(c0 + i) * 16384]; d[i] = dp[(c0 + i) * 128]; }
#pragma unroll
            for (int i = 0; i < 16; ++i) { sp[(size_t)(c0 + i) * 16384] = (bf16_t)f2bf(S); S = d[i] * S + u[i]; }
        }
        P.out[O_PHG + (size_t)bh * 16384 + kv] = S;
    }
}

constexpr int HF_SS = 144, HF_QS = 136, HF_QT = 128 * HF_SS * 2, HF_SSQ = HF_QT + 64 * HF_QS * 2;
__device__ __forceinline__ void hgrn_final_unit(const Params& P, int bh, int c, unsigned char* lds) {
    bf16_t* Ss = (bf16_t*)lds; bf16_t* Qt = (bf16_t*)(lds + HF_QT); float* ssq = (float*)(lds + HF_SSQ);
    const int tid = threadIdx.x, lane = tid & 63, wave = tid >> 6, fr = lane & 15, fq = lane >> 4;
    const int b = bh >> 2, h = bh & 3; const size_t row0 = (size_t)b * SEQ + (size_t)c * 64;
    __syncthreads();
    { const bf16_t* s0 = (const bf16_t*)(P.ws + WS_S0) + ((size_t)bh * 128 + c) * 16384;
#pragma unroll
      for (int it = 0; it < 4; ++it) { const int idx = tid + NTHR * it, kr = idx >> 4, ch = idx & 15; *(u32x4*)(Ss + kr * HF_SS + ch * 8) = *(const u32x4*)(s0 + kr * 128 + ch * 8); }
      const bf16_t* HQT = (const bf16_t*)(P.ws + WS_HQT);
#pragma unroll
      for (int it = 0; it < 2; ++it) { const int idx = tid + NTHR * it, tr = idx >> 4, ch = idx & 15; *(u32x4*)(Qt + tr * HF_QS + ch * 8) = *(const u32x4*)(HQT + (row0 + tr) * 512 + h * 128 + ch * 8); } }
    __syncthreads();
    const int I = wave & 3, vh = wave >> 2;
    const unsigned lbase = (unsigned)(uintptr_t)lds;
    const unsigned trow = (unsigned)(4 * fq + ((lane >> 2) & 3)), tcol = (unsigned)((lane & 3) * 8);
    bf16x8 af[4];
#pragma unroll
    for (int kk = 0; kk < 4; ++kk) { const u32x2 lo = *(const u32x2*)(Qt + (16 * I + fr) * HF_QS + kk * 32 + 4 * fq), hi = *(const u32x2*)(Qt + (16 * I + fr) * HF_QS + kk * 32 + 16 + 4 * fq);
        u32x4 w; w.x = lo.x; w.y = lo.y; w.z = hi.x; w.w = hi.y; af[kk] = __builtin_bit_cast(bf16x8, w); }
    const size_t rowb = row0 + 16 * I + 4 * fq;
    f32x4 o[4]; float part[4] = {0.f, 0.f, 0.f, 0.f};
#pragma unroll
    for (int vb = 0; vb < 4; ++vb) { const int vblk = vh * 4 + vb;
        const float* oi = (const float*)(P.ws + WS_OINTRA) + rowb * 512 + h * 128 + vblk * 16 + fr;
        o[vb] = (f32x4){oi[0], oi[512], oi[1024], oi[1536]};
#pragma unroll
        for (int kk = 0; kk < 4; ++kk) { const unsigned sa = lbase + (trow + 32 * kk) * (HF_SS * 2) + tcol + vblk * 32;
            o[vb] = __builtin_amdgcn_mfma_f32_16x16x32_bf16(af[kk], tr_pair(sa, sa + 16 * (HF_SS * 2)), o[vb], 0, 0, 0); }
#pragma unroll
        for (int r = 0; r < 4; ++r) part[r] += o[vb][r] * o[vb][r]; }
#pragma unroll
    for (int r = 0; r < 4; ++r) { part[r] += __shfl_xor(part[r], 1); part[r] += __shfl_xor(part[r], 2); part[r] += __shfl_xor(part[r], 4); part[r] += __shfl_xor(part[r], 8);
        if (fr == 0) ssq[vh * 64 + 16 * I + 4 * fq + r] = part[r]; }
    __syncthreads();
    const float* gain = P.in[15];
#pragma unroll
    for (int r = 0; r < 4; ++r) { const int t = 16 * I + 4 * fq + r; const float rs = rsqrtf((ssq[t] + ssq[64 + t]) * (1.0f / 128.0f) + EPS);
        const size_t row = row0 + t; const bf16_t* gp = (const bf16_t*)(P.ws + WS_PROJ) + row * NIN + C_HG + h * 128 + fr; bf16_t* op = (bf16_t*)(P.ws + WS_ABR) + ((size_t)1 * MT + row) * 512 + h * 128 + fr;
#pragma unroll
        for (int vb = 0; vb < 4; ++vb) { const int v = (vh * 4 + vb) * 16; op[v] = (bf16_t)f2bf(o[vb][r] * rs * gain[v + fr] * sigmoidf_(bf2f(gp[v]))); } }
}
__device__ __forceinline__ void phase_mix2(const Params& P, unsigned char* lds) {
    for (int it = blockIdx.x; it < 1024; it += gridDim.x) hgrn_final_unit(P, it >> 7, it & 127, lds);
    const int lane = threadIdx.x & 63, wave = threadIdx.x >> 6; const int gw = blockIdx.x * NWAVES + wave, NGW = gridDim.x * NWAVES;
    const bf16_t* ATTO = (const bf16_t*)(P.ws + WS_ATTO); const float* LSE = (const float*)(P.ws + WS_LSE); bf16_t* ABR = (bf16_t*)(P.ws + WS_ABR);
    for (int row = gw; row < MT; row += NGW) {
        const int h = lane >> 4; const float l0 = LSE[((size_t)0 * MT + row) * 4 + h], l1 = LSE[((size_t)1 * MT + row) * 4 + h], l2 = LSE[((size_t)2 * MT + row) * 4 + h];
        const float m = fmaxf(l0, fmaxf(l1, l2)); float w0 = __expf(l0 - m), w1 = __expf(l1 - m), w2 = __expf(l2 - m); const float inv = 1.0f / (w0 + w1 + w2); w0 *= inv; w1 *= inv; w2 *= inv;
        float a[8], b2[8], c2[8], o[8];
        load_bf16x8(ATTO + ((size_t)0 * MT + row) * 512 + lane * 8, a); load_bf16x8(ATTO + ((size_t)1 * MT + row) * 512 + lane * 8, b2); load_bf16x8(ATTO + ((size_t)2 * MT + row) * 512 + lane * 8, c2);
#pragma unroll
        for (int e = 0; e < 8; ++e) o[e] = w0 * a[e] + w1 * b2[e] + w2 * c2[e];
        store_bf16x8(ABR + (size_t)row * 512 + lane * 8, o);
    }
}

struct BranchOrder {
    pg8::StaticOrder so;
    __device__ __forceinline__ bool next(int i, pg8::Unit& u) const { pg8::Unit t; if (!so.next(i / 3, t)) return false; const int br = i % 3; u.pm = br * (MT / 256) + t.pm; u.pn = br * 4 + t.pn; return true; }
    __device__ __forceinline__ void a_ready(const pg8::Unit&) const {}
    __device__ __forceinline__ void done(const pg8::Unit&) const {}
};
struct EpiBranch {
    static constexpr bool PERM = true, AFTER_DRAIN = false; const bf16_t* PROJ; bf16_t* MERGED;
    __device__ __forceinline__ bool keep(const pg8::Unit& u) const { return (u.pn >> 2) < 2; }
    __device__ __forceinline__ void operator()(f32x4 (&acc)[2][2][4][2], const pg8::Unit& u, int wr, int wc, int fr, int fq) const {
        const int br = u.pn >> 2, pn = u.pn & 3, pm = u.pm - br * (MT / 256);
        const int row0 = pm * 256 + wr * 64 + fr, col0 = pn * 256 + wc * 32 + 8 * fq;
        const int gc = br == 0 ? C_GA : (br == 1 ? C_GH : C_GM), gn = br == 0 ? C_GH : C_GM;
#pragma unroll
        for (int ai = 0; ai < 2; ++ai)
#pragma unroll
            for (int m = 0; m < 4; ++m)
#pragma unroll
                for (int bj = 0; bj < 2; ++bj) {
                    const int row = row0 + ai * 128 + m * 16, col = col0 + bj * 128; const bf16_t* pr = PROJ + (size_t)row * NIN + col;
                    float gcur[8], fac[8]; load_bf16x8(pr + gc, gcur);
                    if (br < 2) { float gnx[8]; load_bf16x8(pr + gn, gnx);
#pragma unroll
                        for (int e = 0; e < 8; ++e) fac[e] = (1.0f + __expf(-gnx[e])) / (1.0f + __expf(-gcur[e])); }
                    else {
#pragma unroll
                        for (int e = 0; e < 8; ++e) fac[e] = 1.0f / (1.0f + __expf(-gcur[e])); }
#pragma unroll
                    for (int e = 0; e < 4; ++e) { acc[ai][bj][m][0][e] *= fac[e]; acc[ai][bj][m][1][e] *= fac[4 + e]; }
                    if (br == 2) { const f32x4 a = acc[ai][bj][m][0], b = acc[ai][bj][m][1]; float v[8] = {a[0], a[1], a[2], a[3], b[0], b[1], b[2], b[3]}; store_bf16x8(MERGED + (size_t)row * 1024 + col, v); }
                }
    }
};
__device__ __forceinline__ void phase_branch(const Params& P, unsigned char* lds) {
    float* red = (float*)lds; unsigned char* ws = P.ws;
    const bf16_t* ABR = (const bf16_t*)(ws + WS_ABR); const bf16_t* WBR = (const bf16_t*)(ws + WS_WBR_T); const bf16_t* PROJ = (const bf16_t*)(ws + WS_PROJ); bf16_t* MERGED = (bf16_t*)(ws + WS_MERGED);
    {
        pg8::Gemm g{ABR, WBR, 3 * MT, 3 * 1024, 512}; BranchOrder S; S.so.init(MP, 1024, (int)gridDim.x, (int)blockIdx.x);
        const EpiBranch E{PROJ, MERGED};
        pg8::gemm_phase<EpiBranch, BranchOrder, false, true>((PG8_LAS unsigned char*)lds, g, S, E);
    }
    constexpr int NU = 4 * 16;
    for (int u = blockIdx.x; u < NU; u += gridDim.x) {
        const int tr = 256 + (u & 3), tc = u >> 2;
        float msum[8] = {0.f, 0.f, 0.f, 0.f, 0.f, 0.f, 0.f, 0.f};
#pragma unroll
        for (int br = 0; br < 3; ++br) {
            sgemm_unit(ABR + (size_t)br * MT * 512, 512, WBR + (size_t)br * 1024 * 512, 512, 512, tr * 64, tc * 64, red, [&](int row, int col, float* v) {
                float g[8]; load_bf16x8(PROJ + (size_t)row * NIN + (br == 0 ? C_GA : (br == 1 ? C_GH : C_GM)) + col, g);
#pragma unroll
                for (int e = 0; e < 8; ++e) msum[e] += sigmoidf_(g[e]) * v[e];
                if (br == 2) store_bf16x8(MERGED + (size_t)row * 1024 + col, msum); });
        }
    }
}
struct StoreF32x4 { float* C; __device__ __forceinline__ void operator()(int row, int col, const f32x4& v) const { *(f32x4*)(C + (size_t)row * 1024 + col) = v; } };
struct StoreBf16x8 { bf16_t* C; int ldc; __device__ __forceinline__ void operator()(int row, int col, float* v) const { store_bf16x8(C + (size_t)row * ldc + col, v); } };
__device__ __forceinline__ void phase_gemm_f32(const bf16_t* A, const bf16_t* Bt, int K, float* C, unsigned char* lds) {
    float* red = (float*)lds;
    {
        pg8::Gemm g{A, Bt, MP, 1024, K}; pg8::StaticOrder S; S.init(MP, 1024, (int)gridDim.x, (int)blockIdx.x);
        const pg8::Epi4<StoreF32x4> E{StoreF32x4{C}};
        pg8::gemm_phase<pg8::Epi4<StoreF32x4>, pg8::StaticOrder, false, true>((PG8_LAS unsigned char*)lds, g, S, E);
    }
    constexpr int NU = 4 * 16;
    for (int u = blockIdx.x; u < NU; u += gridDim.x) { const int tr = 256 + (u & 3), tc = u >> 2;
        sgemm_unit(A, K, Bt, K, K, tr * 64, tc * 64, red, [&](int row, int col, float* v) { store_f32x8(C + (size_t)row * 1024 + col, v); }); }
}
constexpr int HB_OFF = 131072;
struct FfnOrder {
    int c;
    __device__ __forceinline__ bool next(int i, pg8::Unit& u) const { if (i >= 8) return false; u.pn = c & 31; u.pm = 8 * (c >> 5) + i; return true; }
    __device__ __forceinline__ void a_ready(const pg8::Unit&) const {}
    __device__ __forceinline__ void done(const pg8::Unit&) const {}
};
#define DPP_MOV(oldv, srcv, ctrl, bc) __builtin_bit_cast(float, __builtin_amdgcn_update_dpp(__builtin_bit_cast(int, (float)(oldv)), __builtin_bit_cast(int, (float)(srcv)), (ctrl), 0xf, 0xf, (bc)))
struct EpiFfn {
    static constexpr bool PERM = true, AFTER_DRAIN = false;
    bf16_t* H; const float* cw; const float* cb; float* pconv; float* hb;
    __device__ __forceinline__ bool keep(const pg8::Unit&) const { return false; }
    __device__ __forceinline__ void operator()(f32x4 (&acc)[2][2][4][2], const pg8::Unit& u, int wr, int wc, int fr, int fq) const {
        const int par = u.pm & 1, lc = wc * 32 + 8 * fq, n0 = u.pn * 128 + lc;
        if (fr >= 14) {
#pragma unroll
            for (int ai = 0; ai < 2; ++ai) { const int bnd = 2 * ai + wr;
                float* dst = hb + ((bnd < 3 ? (par * 4 + bnd + 1) : ((par ^ 1) * 4)) * 2 + (fr - 14)) * 128 + lc;
                *(f32x4*)dst = acc[ai][0][3][0]; *(f32x4*)(dst + 4) = acc[ai][0][3][1]; }
            if ((u.pm & 31) == 31 && wr == 1) { float* pc = pconv + ((size_t)(u.pm >> 5) * 2 + (fr - 14)) * DFF + n0; *(f32x4*)pc = acc[1][0][3][0]; *(f32x4*)(pc + 4) = acc[1][0][3][1]; }
        }
        asm volatile("s_waitcnt lgkmcnt(0)" ::: "memory"); __builtin_amdgcn_s_barrier(); asm volatile("" ::: "memory");
        float w0[8], w1[8], w2[8], cbv[8];
#pragma unroll
        for (int e = 0; e < 8; e += 4) { const f32x4 a = *(const f32x4*)(cw + n0 + e), b = *(const f32x4*)(cw + DFF + n0 + e), c = *(const f32x4*)(cw + 2 * DFF + n0 + e), d = *(const f32x4*)(cb + n0 + e);
#pragma unroll
            for (int i = 0; i < 4; ++i) { w0[e + i] = a[i]; w1[e + i] = b[i]; w2[e + i] = c[i]; cbv[e + i] = d[i]; } }
#pragma unroll
        for (int ai = 0; ai < 2; ++ai) { const int bnd = 2 * ai + wr;
            const float* hp = hb + ((par * 4 + bnd) * 2) * 128 + lc;
            float prev[8];
            { const f32x4 h2a = *(const f32x4*)hp, h2b = *(const f32x4*)(hp + 4), h1a = *(const f32x4*)(hp + 128), h1b = *(const f32x4*)(hp + 132);
#pragma unroll
              for (int i = 0; i < 4; ++i) { prev[i] = fr == 15 ? h1a[i] : h2a[i]; prev[4 + i] = fr == 15 ? h1b[i] : h2b[i]; } }
#pragma unroll
            for (int m = 0; m < 4; ++m) {
                float hv[8];
#pragma unroll
                for (int e = 0; e < 8; ++e) { const float cur = acc[ai][0][m][e >> 2][e & 3];
                    const float x1 = DPP_MOV(0.f, prev[e], 0x10F, true);
                    const float p1 = DPP_MOV(x1, cur, 0x111, false);
                    const float x2 = DPP_MOV(0.f, prev[e], 0x10E, true);
                    const float p2 = DPP_MOV(x2, cur, 0x112, false);
                    const float c = cbv[e] + w0[e] * p2 + w1[e] * p1 + w2[e] * cur;
                    hv[e] = c / (1.0f + __expf(-c)) * acc[ai][1][m][e >> 2][e & 3]; prev[e] = cur; }
                store_bf16x8(H + (size_t)(u.pm * 256 + ai * 128 + wr * 64 + m * 16 + fr) * DFF + n0, hv);
            } }
    }
};
__device__ __forceinline__ void sample_ffn_unit(const Params& P, int tr, int tc, float* red) {
    const bf16_t* __restrict__ A = (const bf16_t*)(P.ws + WS_XN); const bf16_t* __restrict__ Bt = (const bf16_t*)(P.ws + WS_WAB_T);
    const int tid = threadIdx.x, lane = tid & 63, wave = tid >> 6, kq = wave >> 1, ch = wave & 1, fr = lane & 15, fq = lane >> 4;
    const int row0 = MP + tr * 64, n0 = tc * 32, brow = (n0 >> 7) * 256 + (n0 & 127);
    f32x4 acc[4][2];
#pragma unroll
    for (int i = 0; i < 4; ++i)
#pragma unroll
        for (int j = 0; j < 2; ++j) acc[i][j] = (f32x4){0.f, 0.f, 0.f, 0.f};
    const bf16_t* ap = A + (size_t)(row0 + fr) * D + fq * 8 + kq * 256;
    const bf16_t* bp = Bt + (size_t)(brow + ch * 128 + fr) * D + fq * 8 + kq * 256;
#pragma unroll 4
    for (int k = 0; k < 256; k += 32) {
        bf16x8 a[4], b[2];
#pragma unroll
        for (int i = 0; i < 4; ++i) a[i] = *(const bf16x8*)(ap + (size_t)i * 16 * D + k);
#pragma unroll
        for (int j = 0; j < 2; ++j) b[j] = *(const bf16x8*)(bp + (size_t)j * 16 * D + k);
#pragma unroll
        for (int i = 0; i < 4; ++i)
#pragma unroll
            for (int j = 0; j < 2; ++j) acc[i][j] = __builtin_amdgcn_mfma_f32_16x16x32_bf16(a[i], b[j], acc[i][j], 0, 0, 0);
    }
    __syncthreads();
#pragma unroll
    for (int i = 0; i < 4; ++i)
#pragma unroll
        for (int j = 0; j < 2; ++j)
#pragma unroll
            for (int r = 0; r < 4; ++r) red[(kq * 64 + i * 16 + 4 * fq + r) * 65 + ch * 32 + j * 16 + fr] = acc[i][j][r];
    __syncthreads();
    const int row = tid >> 3, lc = (tid & 7) * 4, st = row & 7, sb = (tr * 64 + row) >> 3;
    const float* cw = P.in[26]; const float* cbias = P.in[27]; const float* cbuf = P.in[8] + (size_t)sb * 2 * DFF + n0 + lc;
    float o[4];
#pragma unroll
    for (int e = 0; e < 4; ++e) {
        auto rsum = [&](int rr, int cc) { return (red[(0 * 64 + rr) * 65 + cc] + red[(1 * 64 + rr) * 65 + cc]) + (red[(2 * 64 + rr) * 65 + cc] + red[(3 * 64 + rr) * 65 + cc]); };
        const float a0 = rsum(row, lc + e), b0 = rsum(row, 32 + lc + e);
        const float a1 = st >= 1 ? rsum(row - (st >= 1 ? 1 : 0), lc + e) : cbuf[DFF + e];
        const float a2 = st >= 2 ? rsum(row - (st >= 2 ? 2 : 0), lc + e) : (st == 1 ? cbuf[DFF + e] : cbuf[e]);
        const int n = n0 + lc + e;
        const float c = cbias[n] + a2 * cw[n] + a1 * cw[DFF + n] + a0 * cw[2 * DFF + n];
        o[e] = c / (1.0f + __expf(-c)) * b0;
        if (st >= 6) P.out[O_SCONV + ((size_t)sb * 2 + (st - 6)) * DFF + n] = a0;
    }
    u32x2 w; w.x = pk2(o[0], o[1]); w.y = pk2(o[2], o[3]);
    *(u32x2*)((bf16_t*)(P.ws + WS_H) + (size_t)(row0 + row) * DFF + n0 + lc) = w;
}
__device__ __forceinline__ void phase_ffn_up(const Params& P, unsigned char* lds) {
    float* red = (float*)lds; const bf16_t* XN = (const bf16_t*)(P.ws + WS_XN); const bf16_t* W = (const bf16_t*)(P.ws + WS_WAB_T);
    float* hb = (float*)(lds + HB_OFF);
    const int tid = threadIdx.x, lane = tid & 63, wave = tid >> 6, fr = lane & 15, fq = lane >> 4;
    const int c = (int)blockIdx.x, pn = c & 31, pm0 = 8 * (c >> 5);
    {
        __syncthreads();
        if ((pm0 & 31) != 0) {
            f32x4 acc[8];
#pragma unroll
            for (int j = 0; j < 8; ++j) acc[j] = (f32x4){0.f, 0.f, 0.f, 0.f};
            const bf16_t* ap = XN + (size_t)(pm0 * 256 - 16 + fr) * D + wave * 128 + fq * 8;
            const bf16_t* bp = W + (size_t)(pn * 256 + fr) * D + wave * 128 + fq * 8;
#pragma unroll
            for (int k = 0; k < 128; k += 32) { const bf16x8 a = *(const bf16x8*)(ap + k);
#pragma unroll
                for (int j = 0; j < 8; ++j) { const bf16x8 b = *(const bf16x8*)(bp + (size_t)j * 16 * D + k); acc[j] = __builtin_amdgcn_mfma_f32_16x16x32_bf16(a, b, acc[j], 0, 0, 0); } }
            if (fq == 3) {
#pragma unroll
                for (int j = 0; j < 8; ++j) { red[(wave * 2 + 0) * 128 + j * 16 + fr] = acc[j][2]; red[(wave * 2 + 1) * 128 + j * 16 + fr] = acc[j][3]; } }
            __syncthreads();
            if (tid < 256) { const int rr = tid >> 7, cc = tid & 127; float sum = 0.f;
#pragma unroll
                for (int w = 0; w < 8; ++w) sum += red[(w * 2 + rr) * 128 + cc];
                hb[rr * 128 + cc] = sum; }
        } else { if (tid < 256) hb[tid] = 0.f; }
        __syncthreads();
    }
    {
        pg8::Gemm g{XN, W, MP, 8192, D}; FfnOrder S{c};
        const EpiFfn E{(bf16_t*)(P.ws + WS_H), P.in[26], P.in[27], P.out + O_PCONV, hb};
        pg8::gemm_phase<EpiFfn, FfnOrder, true, true>((PG8_LAS unsigned char*)lds, g, S, E);
    }
    for (int u = blockIdx.x; u < 4 * 128; u += gridDim.x) sample_ffn_unit(P, u & 3, u >> 2, red);
}
__device__ __forceinline__ void phase_mid_norm(const Params& P) {
    const int lane = threadIdx.x & 63, wave = threadIdx.x >> 6; const int gw = blockIdx.x * NWAVES + wave, NGW = gridDim.x * NWAVES;
    const float* MIX = (const float*)(P.ws + WS_MIX); bf16_t* XN = (bf16_t*)(P.ws + WS_XN);
    for (int row = gw; row < MT; row += NGW) {
        const float* xr = row < MP ? P.in[0] + (size_t)row * D : P.in[1] + (size_t)(row - MP) * D; float* yr = P.out + (size_t)row * D;
        f32x4 m[4], x[4]; float s = 0.f;
#pragma unroll
        for (int j = 0; j < 4; ++j) { m[j] = ((const f32x4*)(MIX + (size_t)row * D))[lane + 64 * j]; s += (m[j].x * m[j].x + m[j].y * m[j].y) + (m[j].z * m[j].z + m[j].w * m[j].w); }
        const float r = rsqrtf(wave_sum(s) * (1.0f / 1024.0f) + EPS); float s2 = 0.f;
#pragma unroll
        for (int j = 0; j < 4; ++j) { const f32x4 g = ((const f32x4*)P.in[12])[lane + 64 * j]; x[j] = ((const f32x4*)xr)[lane + 64 * j] + m[j] * r * g; ((f32x4*)yr)[lane + 64 * j] = x[j];
            s2 += (x[j].x * x[j].x + x[j].y * x[j].y) + (x[j].z * x[j].z + x[j].w * x[j].w); }
        const float r2 = rsqrtf(wave_sum(s2) * (1.0f / 1024.0f) + EPS);
#pragma unroll
        for (int j = 0; j < 4; ++j) { const f32x4 g = ((const f32x4*)P.in[22])[lane + 64 * j]; u32x2 o; o.x = pk2(x[j].x * r2 * g.x, x[j].y * r2 * g.y); o.y = pk2(x[j].z * r2 * g.z, x[j].w * r2 * g.w);
            ((u32x2*)(XN + (size_t)row * D))[lane + 64 * j] = o; }
    }
}
__device__ __forceinline__ void phase_final_norm(const Params& P) {
    const int lane = threadIdx.x & 63, wave = threadIdx.x >> 6; const int gw = blockIdx.x * NWAVES + wave, NGW = gridDim.x * NWAVES;
    const float* Fm = (const float*)(P.ws + WS_MIX);
    for (int row = gw; row < MT; row += NGW) {
        float* yr = P.out + (size_t)row * D; f32x4 m[4]; float s = 0.f;
#pragma unroll
        for (int j = 0; j < 4; ++j) { m[j] = ((const f32x4*)(Fm + (size_t)row * D))[lane + 64 * j]; s += (m[j].x * m[j].x + m[j].y * m[j].y) + (m[j].z * m[j].z + m[j].w * m[j].w); }
        const float r = rsqrtf(wave_sum(s) * (1.0f / 1024.0f) + EPS);
#pragma unroll
        for (int j = 0; j < 4; ++j) { const f32x4 g = ((const f32x4*)P.in[23])[lane + 64 * j]; ((f32x4*)yr)[lane + 64 * j] = ((const f32x4*)yr)[lane + 64 * j] + m[j] * r * g; }
    }
}

constexpr int NPHASE = 12;
__global__ void __launch_bounds__(NTHR, 2) mega_fwd(Params P) {
    extern __shared__ __attribute__((aligned(16))) unsigned char lds[];
    volatile unsigned* MISC = (volatile unsigned*)(lds + LDS_BYTES - 64);
    if (threadIdx.x < 16) MISC[threadIdx.x] = 0u;
    __syncthreads();
    XcdBarrier bar; bar.bar = (unsigned*)(P.ws + WS_CTL) + 4096; bar.x = 0; bar.st = nullptr;
    const bool multi = (P.ph_hi - P.ph_lo) > 1;
    if (multi) bar = xcd_barrier_post((unsigned*)(P.ws + WS_CTL) + 4096, MISC);
    const int lo = P.ph_lo, hi = P.ph_hi;
#ifndef ONLY_PHASE
#define ONLY_PHASE (-1)
#endif
#define IN(k) (lo <= (k) && (k) < hi && (ONLY_PHASE < 0 || ONLY_PHASE == (k)))
#define SEAM(k) do { if (IN(k) && IN((k) + 1)) xcd_barrier(bar); } while (0)
    if (IN(0)) phase_prep(P, lds);
#if PROBE_REPEAT == 0
    xcd_barrier(bar); phase_prep(P, lds);
#endif
    SEAM(0);
    if (IN(1)) phase_inproj(P, lds);
    SEAM(1);
    if (IN(2)) phase_mix1<63>(P, lds);
#if PROBE_REPEAT == 2
    xcd_barrier(bar); phase_mix1<PROBE_SEL>(P, lds);
#endif
    SEAM(2);
    if (IN(3)) phase_scan(P);
#if PROBE_REPEAT == 3
    xcd_barrier(bar); phase_scan(P);
#endif
    SEAM(3);
    if (IN(4)) phase_mix2(P, lds);
#if PROBE_REPEAT == 4
    xcd_barrier(bar); phase_mix2(P, lds);
#endif
    SEAM(4);
    if (IN(5)) phase_branch(P, lds);
    SEAM(5);
    if (IN(6)) phase_gemm_f32((const bf16_t*)(P.ws + WS_MERGED), (const bf16_t*)(P.ws + WS_WOUT_T), 1024, (float*)(P.ws + WS_MIX), lds);
    SEAM(6);
    if (IN(7)) phase_mid_norm(P);
    SEAM(7);
    if (IN(8)) phase_ffn_up(P, lds);
    if (IN(8) && IN(10)) xcd_barrier(bar);
    if (IN(10)) phase_gemm_f32((const bf16_t*)(P.ws + WS_H), (const bf16_t*)(P.ws + WS_WD_T), 4096, (float*)(P.ws + WS_MIX), lds);
    SEAM(10);
    if (IN(11)) phase_final_norm(P);
#undef IN
#undef SEAM
}
}

extern "C" void kernel_launch(void* const* d_in, const int* in_sizes, int n_in, void* d_out, int out_size, void* d_ws, size_t ws_size, hipStream_t stream) {
    static int ready = 0;
    if (ready == 0) {
        if (n_in != 29 || (size_t)out_size != O_END || ws_size < WS_END) { fprintf(stderr, "kernel_launch: unexpected shapes (n_in %d out %d ws %zu)\n", n_in, out_size, ws_size); ready = -1; return; }
        if (hipFuncSetAttribute((const void*)mega_fwd, hipFuncAttributeMaxDynamicSharedMemorySize, LDS_BYTES) != hipSuccess) { fprintf(stderr, "kernel_launch: hipFuncSetAttribute failed\n"); ready = -1; return; }
        ready = 1;
    }
    if (ready < 0) return;
    (void)hipMemsetAsync((char*)d_ws + WS_CTL, 0, CTL_BYTES, stream);
    Params p{};
    for (int i = 0; i < 29; ++i) p.in[i] = (const float*)d_in[i];
    p.out = (float*)d_out; p.ws = (unsigned char*)d_ws;
#if MK_ONE_LAUNCH
    p.ph_lo = 0; p.ph_hi = NPHASE;
    hipLaunchKernelGGL(mega_fwd, dim3(256), dim3(NTHR), LDS_BYTES, stream, p);
#else
    for (int ph = 0; ph < NPHASE; ++ph) { p.ph_lo = ph; p.ph_hi = ph + 1; hipLaunchKernelGGL(mega_fwd, dim3(256), dim3(NTHR), LDS_BYTES, stream, p); }
#endif
}
```
